# Optimizing an MI355X kernel written in HIP

```python
import math
import jax, jax.numpy as jnp
from jax import lax
import numpy as np

D_MODEL = 1024
BATCH = 8
SEQ = 4096
DEPTH = 1

D_RNN = D_MODEL
LRU_BLOCK_DIM = 64
LRU_BLOCKS = D_RNN // LRU_BLOCK_DIM
CONV_WIDTH = 4
LRU_C = 8.0
HEAD_DIM = 64
V_DIM = 2 * HEAD_DIM
N_HEADS = D_MODEL // V_DIM
Q_WIDTH = N_HEADS * 2 * HEAD_DIM
ATT_WIDTH = N_HEADS * V_DIM
ROT_DIM = HEAD_DIM // 4
ROPE_THETA = 500000.0
Q_BLOCK = 128
N_EXPERTS = 256
TOP_K = 8
D_EXPERT = 256
D_SHARED = 256
ROUTED_SCALE = 2.5
MOE_BLOCK = 128
EPS = 1e-6
IN_SPLITS = (D_RNN, D_RNN, Q_WIDTH, Q_WIDTH, ATT_WIDTH, D_MODEL, D_MODEL)
IN_WIDTH = 2 * D_RNN + 2 * Q_WIDTH + ATT_WIDTH + 2 * D_MODEL

kernel_name = 'hybrid_rglru_diffattn_moe_adaln'


def _rmsnorm(x, g):
    xf = x.astype(jnp.float32)
    y = xf * lax.rsqrt(jnp.mean(xf * xf, axis=-1, keepdims=True) + EPS)
    return (y * g.astype(jnp.float32)).astype(x.dtype)


def _rotary_partial(x, cos, sin):
    half = ROT_DIM // 2
    cos = cos.astype(x.dtype)
    sin = sin.astype(x.dtype)
    x1 = x[..., :half]
    x2 = x[..., half:ROT_DIM]
    return jnp.concatenate([x1 * cos - x2 * sin, x2 * cos + x1 * sin, x[..., ROT_DIM:]], axis=-1)


def _causal_depthwise_conv(x, w, b):
    y = lax.conv_general_dilated(
        x, w[:, None, :].astype(x.dtype), window_strides=(1,),
        padding=[(CONV_WIDTH - 1, 0)], dimension_numbers=('NWC', 'WIO', 'NWC'),
        feature_group_count=x.shape[-1])
    return y + b.astype(x.dtype)


def _rg_lru(x, w_a, b_a, w_x, b_x, lam):
    B, S, _ = x.shape
    xb = x.reshape(B, S, LRU_BLOCKS, LRU_BLOCK_DIM)
    r = jax.nn.sigmoid((jnp.einsum('bsgi,gij->bsgj', xb, w_a).reshape(B, S, D_RNN) + b_a).astype(jnp.float32))
    i = jax.nn.sigmoid((jnp.einsum('bsgi,gij->bsgj', xb, w_x).reshape(B, S, D_RNN) + b_x).astype(jnp.float32))
    log_a = -LRU_C * r * jax.nn.softplus(-lam.astype(jnp.float32))
    a = jnp.exp(log_a)
    u = jnp.sqrt(-jnp.expm1(2.0 * log_a)) * (i * x.astype(jnp.float32))

    def combine(left, right):
        a1, b1 = left
        a2, b2 = right
        return a1 * a2, a2 * b1 + b2

    _, h = lax.associative_scan(combine, (a, u), axis=1)
    return h.astype(x.dtype)


def _diff_attention(q, k, v, lam):
    B, S = q.shape[0], q.shape[1]
    nb = S // Q_BLOCK
    scale = HEAD_DIM ** -0.5
    kf = k.astype(jnp.float32)
    vf = v.astype(jnp.float32)
    qb = q.astype(jnp.float32).reshape(B, nb, Q_BLOCK, N_HEADS, 2, HEAD_DIM).transpose(1, 0, 2, 3, 4, 5)
    k_idx = jnp.arange(S)

    def block(args):
        q_blk, j = args
        s = jnp.einsum('bqhcd,bkhcd->bhcqk', q_blk, kf) * scale
        q_idx = j * Q_BLOCK + jnp.arange(Q_BLOCK)
        s = jnp.where(k_idx[None, :] <= q_idx[:, None], s, -jnp.inf)
        p = jax.nn.softmax(s, axis=-1)
        w = p[:, :, 0] - lam * p[:, :, 1]
        return jnp.einsum('bhqk,bkhe->bqhe', w, vf)

    o = lax.map(block, (qb, jnp.arange(nb)))
    return o.transpose(1, 0, 2, 3, 4).reshape(B, S, N_HEADS, V_DIM)


def _swiglu(h, w_gate, w_up, w_down):
    return (jax.nn.silu(h @ w_gate) * (h @ w_up)) @ w_down


def _moe_routed(h, w_router, router_bias, we_gate, we_up, we_down):
    T, D = h.shape
    scores = jax.nn.sigmoid(h.astype(jnp.float32) @ w_router.astype(jnp.float32))
    _, idx = lax.top_k(scores + router_bias.astype(jnp.float32), TOP_K)
    s_sel = jnp.take_along_axis(scores, idx, axis=-1)
    gates = s_sel / jnp.sum(s_sel, axis=-1, keepdims=True) * ROUTED_SCALE

    n_slots = T * TOP_K
    flat_e = idx.reshape(-1).astype(jnp.int32)
    flat_g = gates.reshape(-1)
    order = jnp.argsort(flat_e, stable=True)
    e_sorted = flat_e[order]
    tok_sorted = (order // TOP_K).astype(jnp.int32)
    g_sorted = flat_g[order]
    counts = jnp.bincount(flat_e, length=N_EXPERTS)
    padded = (counts + MOE_BLOCK - 1) // MOE_BLOCK * MOE_BLOCK
    starts = jnp.cumsum(counts) - counts
    padded_ends = jnp.cumsum(padded)
    padded_starts = padded_ends - padded
    dest = padded_starts[e_sorted] + jnp.arange(n_slots) - starts[e_sorted]
    cap = n_slots + N_EXPERTS * MOE_BLOCK
    n_blocks = cap // MOE_BLOCK
    buf_tok = jnp.full((cap,), T, jnp.int32).at[dest].set(tok_sorted)
    buf_g = jnp.zeros((cap,), jnp.float32).at[dest].set(g_sorted)
    block_e = jnp.minimum(
        jnp.searchsorted(padded_ends, jnp.arange(n_blocks) * MOE_BLOCK, side='right'),
        N_EXPERTS - 1).astype(jnp.int32)
    h_pad = jnp.concatenate([h, jnp.zeros((1, D), h.dtype)], axis=0)

    def step(acc, blk):
        tok, g, e = blk
        xb = h_pad[tok]
        yb = _swiglu(xb, we_gate[e], we_up[e], we_down[e])
        return acc.at[tok].add(yb.astype(jnp.float32) * g[:, None]), None

    acc, _ = lax.scan(step, jnp.zeros((T + 1, D), jnp.float32),
                      (buf_tok.reshape(n_blocks, MOE_BLOCK), buf_g.reshape(n_blocks, MOE_BLOCK), block_e))
    return acc[:T].astype(h.dtype)


def _layer(x, c, cos, sin, lambda_init, w_ada, b_ada, norm1_g, w_in, conv_w, conv_b,
           lru_wa, lru_ba, lru_wx, lru_bx, lru_lambda, q_norm_g, k_norm_g,
           lam_q1, lam_k1, lam_q2, lam_k2, subln_g, w_o, norm2_g, w_router, router_bias,
           we_gate, we_up, we_down, ws_gate, ws_up, ws_down):
    B, S, D = x.shape
    mod = jax.nn.silu(c) @ w_ada + b_ada
    shift1, scale1, gate1, shift2, scale2, gate2 = jnp.split(mod, 6, axis=-1)

    h = _rmsnorm(x, norm1_g) * (1.0 + scale1[:, None]) + shift1[:, None]
    proj = h @ w_in
    cuts = []
    off = 0
    for size in IN_SPLITS[:-1]:
        off += size
        cuts.append(off)
    x_rnn, g_rnn, q, k, v, g_a, g_b = jnp.split(proj, cuts, axis=-1)

    x_rnn = _causal_depthwise_conv(x_rnn, conv_w, conv_b)
    y_a = _rg_lru(x_rnn, lru_wa, lru_ba, lru_wx, lru_bx, lru_lambda) * jax.nn.gelu(g_rnn)

    q = _rotary_partial(_rmsnorm(q.reshape(B, S, N_HEADS, 2, HEAD_DIM), q_norm_g), cos, sin)
    k = _rotary_partial(_rmsnorm(k.reshape(B, S, N_HEADS, 2, HEAD_DIM), k_norm_g), cos, sin)
    v = v.reshape(B, S, N_HEADS, V_DIM)
    lam = (jnp.exp(jnp.sum(lam_q1.astype(jnp.float32) * lam_k1.astype(jnp.float32)))
           - jnp.exp(jnp.sum(lam_q2.astype(jnp.float32) * lam_k2.astype(jnp.float32)))
           + lambda_init)
    o = _diff_attention(q, k, v, lam)
    y_b = (_rmsnorm(o, subln_g) * (1.0 - lambda_init)).reshape(B, S, ATT_WIDTH).astype(x.dtype)

    mixed = jax.nn.sigmoid(g_a) * y_a + jax.nn.sigmoid(g_b) * y_b
    x = x + gate1[:, None] * (mixed @ w_o)

    h2 = (_rmsnorm(x, norm2_g) * (1.0 + scale2[:, None]) + shift2[:, None]).reshape(B * S, D)
    y = _swiglu(h2, ws_gate, ws_up, ws_down) + _moe_routed(h2, w_router, router_bias, we_gate, we_up, we_down)
    return x + gate2[:, None] * y.reshape(B, S, D)


def setup_inputs(seed: int = 0) -> dict:
    key = jax.random.key(seed)
    ks = jax.random.split(key, 32)
    f32 = jnp.float32
    L = DEPTH
    D = D_MODEL

    def nrm(k, shape, s):
        return jax.random.normal(k, shape, f32) * s

    u = jax.random.uniform(ks[12], (L, D_RNN), f32, 0.9, 0.999)
    base = u ** (1.0 / LRU_C)
    return {
        'x': nrm(ks[0], (BATCH, SEQ, D), 1.0),
        'c': nrm(ks[1], (BATCH, D), 1.0),
        'positions': jnp.tile(jnp.arange(SEQ, dtype=jnp.int32)[None, :], (BATCH, 1)),
        'w_ada': nrm(ks[2], (L, D, 6 * D), 0.5 * D ** -0.5),
        'b_ada': nrm(ks[3], (L, 6 * D), 0.01),
        'norm1_g': 1.0 + nrm(ks[4], (L, D), 0.01),
        'w_in': nrm(ks[5], (L, D, IN_WIDTH), D ** -0.5),
        'conv_w': nrm(ks[6], (L, CONV_WIDTH, D_RNN), CONV_WIDTH ** -0.5),
        'conv_b': nrm(ks[7], (L, D_RNN), 0.01),
        'lru_wa': nrm(ks[8], (L, LRU_BLOCKS, LRU_BLOCK_DIM, LRU_BLOCK_DIM), LRU_BLOCK_DIM ** -0.5),
        'lru_ba': nrm(ks[9], (L, D_RNN), 0.01),
        'lru_wx': nrm(ks[10], (L, LRU_BLOCKS, LRU_BLOCK_DIM, LRU_BLOCK_DIM), LRU_BLOCK_DIM ** -0.5),
        'lru_bx': nrm(ks[11], (L, D_RNN), 0.01),
        'lru_lambda': jnp.log(base) - jnp.log1p(-base),
        'q_norm_g': 1.0 + nrm(ks[13], (L, HEAD_DIM), 0.01),
        'k_norm_g': 1.0 + nrm(ks[14], (L, HEAD_DIM), 0.01),
        'lam_q1': nrm(ks[15], (L, HEAD_DIM), 0.1),
        'lam_k1': nrm(ks[16], (L, HEAD_DIM), 0.1),
        'lam_q2': nrm(ks[17], (L, HEAD_DIM), 0.1),
        'lam_k2': nrm(ks[18], (L, HEAD_DIM), 0.1),
        'subln_g': 1.0 + nrm(ks[19], (L, V_DIM), 0.01),
        'w_o': nrm(ks[20], (L, D, D), D ** -0.5),
        'norm2_g': 1.0 + nrm(ks[21], (L, D), 0.01),
        'w_router': nrm(ks[22], (L, D, N_EXPERTS), D ** -0.5),
        'router_bias': nrm(ks[23], (L, N_EXPERTS), 0.01),
        'we_gate': nrm(ks[24], (L, N_EXPERTS, D, D_EXPERT), D ** -0.5),
        'we_up': nrm(ks[25], (L, N_EXPERTS, D, D_EXPERT), D ** -0.5),
        'we_down': nrm(ks[26], (L, N_EXPERTS, D_EXPERT, D), D_EXPERT ** -0.5),
        'ws_gate': nrm(ks[27], (L, D, D_SHARED), D ** -0.5),
        'ws_up': nrm(ks[28], (L, D, D_SHARED), D ** -0.5),
        'ws_down': nrm(ks[29], (L, D_SHARED, D), D_SHARED ** -0.5),
    }


def reference(x, c, positions, w_ada, b_ada, norm1_g, w_in, conv_w, conv_b,
              lru_wa, lru_ba, lru_wx, lru_bx, lru_lambda, q_norm_g, k_norm_g,
              lam_q1, lam_k1, lam_q2, lam_k2, subln_g, w_o, norm2_g, w_router, router_bias,
              we_gate, we_up, we_down, ws_gate, ws_up, ws_down):
    inv_freq = ROPE_THETA ** (-jnp.arange(0, ROT_DIM, 2, dtype=jnp.float32) / ROT_DIM)
    ang = positions.astype(jnp.float32)[..., None] * inv_freq
    cos = jnp.cos(ang)[:, :, None, None, :]
    sin = jnp.sin(ang)[:, :, None, None, :]
    for l in range(DEPTH):
        lambda_init = 0.8 - 0.6 * math.exp(-0.3 * l)
        x = _layer(x, c, cos, sin, lambda_init, w_ada[l], b_ada[l], norm1_g[l], w_in[l],
                   conv_w[l], conv_b[l], lru_wa[l], lru_ba[l], lru_wx[l], lru_bx[l], lru_lambda[l],
                   q_norm_g[l], k_norm_g[l], lam_q1[l], lam_k1[l], lam_q2[l], lam_k2[l], subln_g[l],
                   w_o[l], norm2_g[l], w_router[l], router_bias[l],
                   we_gate[l], we_up[l], we_down[l], ws_gate[l], ws_up[l], ws_down[l])
    return x
```

```cpp
#include <hip/hip_runtime.h>
#include <hip/hip_bf16.h>
#include <cstdio>
#include <cstdint>
#include <cmath>
namespace pg8 {
#define PG8_LAS __attribute__((address_space(3)))
typedef unsigned short bf16_t;
typedef short bf16x8 __attribute__((ext_vector_type(8)));
typedef float f32x4 __attribute__((ext_vector_type(4)));
typedef float f32x2 __attribute__((ext_vector_type(2)));
typedef unsigned u32x4 __attribute__((ext_vector_type(4)));
constexpr int BM = 256, BK = 64, HALF = 128, HTB = HALF * BK * 2  , STAGE_BYTES = 8 * HTB, NXCD = 8, WGM = 8;

__host__ __device__ __forceinline__ int lds_byte(int r, int c) { const int st = (r >> 4) * 2 + (c >> 5), rr = r & 15, cc = c & 31, ob = rr * 64 + cc * 2; return st * 1024 + (ob ^ (((ob >> 9) & 1) << 5)); }
__host__ __device__ __forceinline__ void stage_rc(int b, int& R, int& C) { const int st = b / 1024, sb = b % 1024, swz = sb ^ (((sb >> 9) & 1) << 5); R = (st >> 1) * 16 + swz / 64; C = (st & 1) * 32 + (swz % 64) / 2; }
__host__ __device__ __forceinline__ int perm32(int rho) { const int n = rho >> 4, i = rho & 15; return 8 * (i >> 2) + 4 * n + (i & 3); }

struct Unit { int pm, pn, row0, nrows, e; };

__device__ __forceinline__ unsigned cvt_pk_bf16(float lo, float hi) { unsigned r; asm volatile("v_cvt_pk_bf16_f32 %0, %1, %2" : "=v"(r) : "v"(lo), "v"(hi)); return r; }
__device__ __forceinline__ float sigmoidf_fast(float v) { return __builtin_amdgcn_rcpf(1.0f + __builtin_amdgcn_exp2f(-1.4426950408889634f * v)); }

struct DenseOrder {
    const bf16_t* A; const bf16_t* Bt; int K;
    int nM, nN, nwg, G, c;
    __device__ void init(const bf16_t* A_, const bf16_t* Bt_, int M, int N, int K_, int G_, int c_) { A = A_; Bt = Bt_; K = K_; nM = M / BM; nN = N / BM; nwg = nM * nN; G = G_; c = c_; }
    __device__ __forceinline__ bool next(int i, Unit& u) const {
        const long L = (long)i * G + c; if (L >= nwg) return false;
        int wgid = (int)L; { const int q = nwg / NXCD, r = nwg % NXCD, xcd = wgid % NXCD, off = wgid / NXCD; wgid = (xcd < r ? xcd * (q + 1) : r * (q + 1) + (xcd - r) * q) + off; }
        const int nig = WGM * nN, gid = wgid / nig, fm = gid * WGM, gsz = (nM - fm) < WGM ? (nM - fm) : WGM;
        u.pm = fm + ((wgid % nig) % gsz); u.pn = (wgid % nig) / gsz; u.row0 = u.pm * BM; u.nrows = BM; u.e = 0; return true;
    }
    __device__ __forceinline__ const char* a_base(const Unit& u) const { return (const char*)A + (size_t)u.pm * BM * K * 2; }
    __device__ __forceinline__ const char* b_base(const Unit& u) const { return (const char*)Bt + (size_t)u.pn * BM * K * 2; }
    __device__ __forceinline__ void a_voff(const Unit&, int, const int (&R)[2], const int (&C)[2], unsigned (&v)[2][2]) const {
#pragma unroll
        for (int h = 0; h < 2; ++h)
#pragma unroll
            for (int i = 0; i < 2; ++i) v[h][i] = (unsigned)((h * HALF + R[i]) * K + C[i]) * 2u;
    }
    __device__ __forceinline__ void a_ready(const Unit&) const {}
    __device__ __forceinline__ void done(const Unit&) const {}
};

template <class Epi, class Sched, bool ALIGN_EPI>
__device__ __forceinline__ void gemm_phase(PG8_LAS unsigned char* lds, const int K, const Sched& S, const Epi& E) {
    const int tid = threadIdx.x, wid = __builtin_amdgcn_readfirstlane(tid >> 6), lane = tid & 63, wr = wid >> 2, wc = wid & 3, fr = lane & 15, fq = lane >> 4;
    const int nt = K / BK;
    int Rs[2], Cs[2]; unsigned voffB[2];
#pragma unroll
    for (int i = 0; i < 2; ++i) { stage_rc(tid * 16 + i * 8192, Rs[i], Cs[i]); const int Rb = Epi::PERM ? ((Rs[i] & ~31) + perm32(Rs[i] & 31)) : Rs[i];
        voffB[i] = (unsigned)(Rb * K + Cs[i]) * 2u; }
    const size_t kstep = (size_t)(BK * 2);
    const size_t hstep = (size_t)HALF * K * 2;
    const unsigned ldsw = (unsigned)wid * 1024u;
    const int aoff = lds_byte(wr * 64 + fr, fq * 8), boff = lds_byte(wc * 32 + fr, fq * 8);
#define PG8_SA(b, h) (((b) * 2 + (h)) * HTB)
#define PG8_SB(b, h) ((4 + (b) * 2 + (h)) * HTB)
#define PG8_STAGE(bufoff, gbase, voff) do { _Pragma("unroll") for (int _i = 0; _i < 2; ++_i) \
        __builtin_amdgcn_global_load_lds((const unsigned*)((const char*)(gbase) + (voff)[_i]), (PG8_LAS unsigned*)(lds + (bufoff) + ldsw + _i * 8192), 16, 0, 0); } while (0)
#define PG8_LDA(dst, b, h) do { _Pragma("unroll") for (int m = 0; m < 4; ++m) _Pragma("unroll") for (int k = 0; k < 2; ++k) dst[m][k] = *(const PG8_LAS bf16x8*)(lds + PG8_SA(b, h) + aoff + m * 2048 + k * 1024); } while (0)
#define PG8_LDB(dst, b, h) do { _Pragma("unroll") for (int n = 0; n < 2; ++n) _Pragma("unroll") for (int k = 0; k < 2; ++k) dst[n][k] = *(const PG8_LAS bf16x8*)(lds + PG8_SB(b, h) + boff + n * 2048 + k * 1024); } while (0)
#define PG8_MMA(ai, bj, At, Bt) do { __builtin_amdgcn_s_setprio(1); _Pragma("unroll") for (int m = 0; m < 4; ++m) _Pragma("unroll") for (int n = 0; n < 2; ++n) _Pragma("unroll") for (int k = 0; k < 2; ++k) \
        acc[ai][bj][m][n] = __builtin_amdgcn_mfma_f32_16x16x32_bf16(Bt[n][k], At[m][k], acc[ai][bj][m][n], 0, 0, 0); __builtin_amdgcn_s_setprio(0); } while (0)
#define PG8_WAIT_V(n) asm volatile("s_waitcnt vmcnt(" #n ")" ::: "memory")
#define PG8_WAIT_L(n) asm volatile("s_waitcnt lgkmcnt(" #n ")" ::: "memory")
#define PG8_BAR __builtin_amdgcn_s_barrier()
#define PG8_SCHED __builtin_amdgcn_sched_barrier(0)
    Unit cur, nxt; int ui = 0;
    if (!S.next(0, cur)) return;
    f32x4 acc[2][2][4][2];
#pragma unroll
    for (int a = 0; a < 2; ++a)
#pragma unroll
        for (int b = 0; b < 2; ++b)
#pragma unroll
            for (int m = 0; m < 4; ++m)
#pragma unroll
                for (int n = 0; n < 2; ++n) acc[a][b][m][n] = (f32x4){0.f, 0.f, 0.f, 0.f};
    bf16x8 At[4][2], B0[2][2], B1[2][2];
    unsigned vA[2][2], vN[2][2];
    S.a_voff(cur, 0, Rs, Cs, vA);
    const char* cA = S.a_base(cur); const char* cB = S.b_base(cur);
    S.a_ready(cur);
    PG8_STAGE(PG8_SB(0, 0), cB, voffB); PG8_STAGE(PG8_SB(0, 1), cB + hstep, voffB); PG8_STAGE(PG8_SA(0, 0), cA, vA[0]); PG8_STAGE(PG8_SA(0, 1), cA, vA[1]);
    if (wr == 1) PG8_BAR;
    PG8_WAIT_V(2); PG8_BAR;
    PG8_STAGE(PG8_SB(1, 0), cB + kstep, voffB); PG8_STAGE(PG8_SA(1, 0), cA + kstep, vA[0]); PG8_STAGE(PG8_SB(1, 1), cB + hstep + kstep, voffB);
    PG8_WAIT_V(6); PG8_BAR;
    for (;;) {
        const bool has_next = S.next(ui + 1, nxt);
        const char* nA = cA; const char* nB = cB;
#pragma unroll
        for (int h = 0; h < 2; ++h)
#pragma unroll
            for (int i = 0; i < 2; ++i) vN[h][i] = vA[h][i];
        if (has_next) { nA = S.a_base(nxt); nB = S.b_base(nxt); S.a_voff(nxt, ui + 1, Rs, Cs, vN); }
#pragma unroll 1
        for (int t = 0; t < nt; t += 2) {
            const bool last = (t == nt - 2);
            const char* a1 = cA + (size_t)(t + 1) * kstep;
            const char* a2 = last ? nA : cA + (size_t)(t + 2) * kstep; const char* b2 = last ? nB : cB + (size_t)(t + 2) * kstep;
            const char* a3 = a2 + kstep; const char* b3 = b2 + kstep;
            unsigned v2[2][2];
#pragma unroll
            for (int h = 0; h < 2; ++h)
#pragma unroll
                for (int i = 0; i < 2; ++i) v2[h][i] = last ? vN[h][i] : vA[h][i];
            if (last && has_next) S.a_ready(nxt);
            PG8_LDB(B0, 0, 0); PG8_LDB(B1, 0, 1); PG8_SCHED; PG8_LDA(At, 0, 0); PG8_STAGE(PG8_SA(1, 1), a1, vA[1]);
            PG8_WAIT_V(8); PG8_WAIT_L(0); PG8_BAR; PG8_MMA(0, 0, At, B0); PG8_MMA(0, 1, At, B1); PG8_BAR; PG8_SCHED;
            PG8_LDA(At, 0, 1); PG8_STAGE(PG8_SB(0, 0), b2, voffB); PG8_STAGE(PG8_SB(0, 1), b2 + hstep, voffB); PG8_STAGE(PG8_SA(0, 0), a2, v2[0]);
            PG8_WAIT_V(8); PG8_WAIT_L(0); PG8_BAR; PG8_MMA(1, 0, At, B0); PG8_MMA(1, 1, At, B1); PG8_BAR; PG8_SCHED;
            PG8_LDB(B0, 1, 0); PG8_LDB(B1, 1, 1); PG8_SCHED; PG8_LDA(At, 1, 0); PG8_STAGE(PG8_SA(0, 1), a2, v2[1]);
            PG8_WAIT_V(8); PG8_WAIT_L(0); PG8_BAR; PG8_MMA(0, 0, At, B0); PG8_MMA(0, 1, At, B1); PG8_BAR; PG8_SCHED;
            PG8_LDA(At, 1, 1); PG8_STAGE(PG8_SB(1, 0), b3, voffB); PG8_STAGE(PG8_SB(1, 1), b3 + hstep, voffB); PG8_STAGE(PG8_SA(1, 0), a3, v2[0]);
            PG8_WAIT_V(8); PG8_WAIT_L(0); PG8_BAR; PG8_MMA(1, 0, At, B0); PG8_MMA(1, 1, At, B1); PG8_BAR; PG8_SCHED;
        }
        if constexpr (ALIGN_EPI) { if (wr == 0) PG8_BAR; }
        E(acc, cur, wr, wc, fr, fq); S.done(cur);
        if (!has_next) break;
#pragma unroll
        for (int a = 0; a < 2; ++a)
#pragma unroll
            for (int b = 0; b < 2; ++b)
#pragma unroll
                for (int m = 0; m < 4; ++m)
#pragma unroll
                    for (int n = 0; n < 2; ++n) acc[a][b][m][n] = (f32x4){0.f, 0.f, 0.f, 0.f};
        cur = nxt; cA = nA; cB = nB; ++ui;
#pragma unroll
        for (int h = 0; h < 2; ++h)
#pragma unroll
            for (int i = 0; i < 2; ++i) vA[h][i] = vN[h][i];
        if constexpr (ALIGN_EPI) { if (wr == 1) PG8_BAR; }
    }
    PG8_WAIT_V(0);
    if constexpr (!ALIGN_EPI) { if (wr == 0) PG8_BAR; }
    PG8_BAR;
#undef PG8_SA
#undef PG8_SB
#undef PG8_STAGE
#undef PG8_LDA
#undef PG8_LDB
#undef PG8_MMA
#undef PG8_WAIT_V
#undef PG8_WAIT_L
#undef PG8_BAR
#undef PG8_SCHED
}
}
namespace epi {
using pg8::f32x4; using pg8::f32x2; using pg8::u32x4; using pg8::Unit; using pg8::bf16_t; using pg8::cvt_pk_bf16; using pg8::sigmoidf_fast;
constexpr int HALF = 128;
__device__ __forceinline__ float gelu_tanh(float x) { const float z = 1.5957691216057308f * (x + 0.044715f * x * x * x); return x * sigmoidf_fast(z); }
__device__ __forceinline__ u32x4 pack8(const f32x4 a, const f32x4 b) { u32x4 w; w.x = cvt_pk_bf16(a[0], a[1]); w.y = cvt_pk_bf16(a[2], a[3]); w.z = cvt_pk_bf16(b[0], b[1]); w.w = cvt_pk_bf16(b[2], b[3]); return w; }

struct EpiInProj {
    static constexpr bool PERM = true;
    bf16_t *XR, *GAR, *Q, *Kb, *V, *GB; const float* qg; const float* kg; const float* cstab; float c2;
    __device__ __forceinline__ void operator()(const f32x4 (&acc)[2][2][4][2], const Unit& u, int wr, int wc, int fr, int fq) const {
        const int pn = u.pn; const int rowb = u.pm * 256 + wr * 64 + fr;
        if (pn < 4 || (pn >= 20 && pn < 24) || pn >= 24) {
            bf16_t* base; int colt; const bool sig = pn >= 24;
            if (pn < 4) { base = XR; colt = pn * 256; } else if (pn < 24) { base = V; colt = (pn - 20) * 256; } else { base = GB; colt = (pn - 24) * 256; }
            const int col0 = colt + wc * 32 + 8 * fq;
#pragma unroll
            for (int ai = 0; ai < 2; ++ai)
#pragma unroll
                for (int m = 0; m < 4; ++m) { bf16_t* rowp = base + (size_t)(rowb + ai * HALF + m * 16) * 1024 + col0;
#pragma unroll
                    for (int bj = 0; bj < 2; ++bj) { f32x4 v0 = acc[ai][bj][m][0], v1 = acc[ai][bj][m][1];
                        if (sig) {
#pragma unroll
                            for (int i = 0; i < 4; ++i) { v0[i] = sigmoidf_fast(v0[i]); v1[i] = sigmoidf_fast(v1[i]); } }
                        *(u32x4*)(rowp + bj * HALF) = pack8(v0, v1); } }
        } else if (pn < 12) {
            const int col0 = (pn - 4) * 128 + wc * 32 + 8 * fq;
#pragma unroll
            for (int ai = 0; ai < 2; ++ai)
#pragma unroll
                for (int m = 0; m < 4; ++m) { f32x4 o[2];
#pragma unroll
                    for (int n = 0; n < 2; ++n)
#pragma unroll
                        for (int i = 0; i < 4; ++i) o[n][i] = gelu_tanh(acc[ai][0][m][n][i]) * sigmoidf_fast(acc[ai][1][m][n][i]);
                    *(u32x4*)(GAR + (size_t)(rowb + ai * HALF + m * 16) * 1024 + col0) = pack8(o[0], o[1]); }
        } else {
            const bool isq = pn < 16; const int j = isq ? pn - 12 : pn - 16; bf16_t* base = isq ? Q : Kb; const float* gg = isq ? qg : kg; const float sc = isq ? c2 : 1.0f;
            f32x4 gv[2][2];
#pragma unroll
            for (int bj = 0; bj < 2; ++bj)
#pragma unroll
                for (int n = 0; n < 2; ++n) gv[bj][n] = *(const f32x4*)(gg + 32 * bj + 8 * fq + 4 * n);
#pragma unroll
            for (int ai = 0; ai < 2; ++ai)
#pragma unroll
                for (int m = 0; m < 4; ++m) { const int row = rowb + ai * HALF + m * 16;
                    float ss = 0.f;
#pragma unroll
                    for (int bj = 0; bj < 2; ++bj)
#pragma unroll
                        for (int n = 0; n < 2; ++n) { const f32x4 x = acc[ai][bj][m][n]; ss += (x[0] * x[0] + x[1] * x[1]) + (x[2] * x[2] + x[3] * x[3]); }
                    ss += __shfl_xor(ss, 16); ss += __shfl_xor(ss, 32);
                    const float rstd = 1.0f / sqrtf(ss * (1.0f / 64.0f) + 1e-6f);
                    f32x4 y[2][2];
#pragma unroll
                    for (int bj = 0; bj < 2; ++bj)
#pragma unroll
                        for (int n = 0; n < 2; ++n) y[bj][n] = acc[ai][bj][m][n] * rstd * gv[bj][n];
                    const f32x4 c0 = *(const f32x4*)(cstab + (size_t)row * 16), c1 = *(const f32x4*)(cstab + (size_t)row * 16 + 4);
                    const f32x4 s0 = *(const f32x4*)(cstab + (size_t)row * 16 + 8), s1 = *(const f32x4*)(cstab + (size_t)row * 16 + 12);
                    f32x4 p0, p1;
#pragma unroll
                    for (int i = 0; i < 4; ++i) { p0[i] = __shfl_xor(y[0][0][i], 16); p1[i] = __shfl_xor(y[0][1][i], 16); }
                    { const float sgn = fq == 0 ? -1.0f : 1.0f; const f32x4 r0 = y[0][0] * c0 + (p0 * s0) * sgn, r1 = y[0][1] * c1 + (p1 * s1) * sgn;
#pragma unroll
                      for (int i = 0; i < 4; ++i) { y[0][0][i] = fq < 2 ? r0[i] : y[0][0][i]; y[0][1][i] = fq < 2 ? r1[i] : y[0][1][i]; } }
                    bf16_t* rowp = base + (size_t)row * 1024 + j * 256 + wc * 64 + 8 * fq;
#pragma unroll
                    for (int bj = 0; bj < 2; ++bj) *(u32x4*)(rowp + 32 * bj) = pack8(y[bj][0] * sc, y[bj][1] * sc); }
        }
    }
};

struct EpiWo {
    static constexpr bool PERM = false;
    const float* x; float* out; const float* gate;
    __device__ __forceinline__ void operator()(const f32x4 (&acc)[2][2][4][2], const Unit& u, int wr, int wc, int fr, int fq) const {
        const int rowb = u.pm * 256 + wr * 64 + fr; const int col0 = u.pn * 256 + wc * 32 + 4 * fq; const float* gp = gate + (size_t)(u.pm >> 4) * 6144;
        f32x4 gv[2][2];
#pragma unroll
        for (int bj = 0; bj < 2; ++bj)
#pragma unroll
            for (int n = 0; n < 2; ++n) gv[bj][n] = *(const f32x4*)(gp + col0 + bj * HALF + n * 16);
#pragma unroll
        for (int ai = 0; ai < 2; ++ai)
#pragma unroll
            for (int m = 0; m < 4; ++m) { const size_t off = (size_t)(rowb + ai * HALF + m * 16) * 1024 + col0;
#pragma unroll
                for (int bj = 0; bj < 2; ++bj)
#pragma unroll
                    for (int n = 0; n < 2; ++n) { const f32x4 xv = *(const f32x4*)(x + off + bj * HALF + n * 16); *(f32x4*)(out + off + bj * HALF + n * 16) = xv + gv[bj][n] * acc[ai][bj][m][n]; }
                if (m & 1) asm volatile("" ::: "memory"); }
    }
};
struct EpiF32 {
    static constexpr bool PERM = false;
    float* out;
    __device__ __forceinline__ void operator()(const f32x4 (&acc)[2][2][4][2], const Unit& u, int wr, int wc, int fr, int fq) const {
        const int rowb = u.pm * 256 + wr * 64 + fr; const int col0 = wc * 32 + 4 * fq;
#pragma unroll
        for (int ai = 0; ai < 2; ++ai)
#pragma unroll
            for (int m = 0; m < 4; ++m) { float* rowp = out + (size_t)(rowb + ai * HALF + m * 16) * 256 + col0;
#pragma unroll
                for (int bj = 0; bj < 2; ++bj)
#pragma unroll
                    for (int n = 0; n < 2; ++n) *(f32x4*)(rowp + bj * HALF + n * 16) = acc[ai][bj][m][n]; }
    }
};
struct EpiGateUp {
    static constexpr bool PERM = true;
    bf16_t* act;
    __device__ __forceinline__ void operator()(const f32x4 (&acc)[2][2][4][2], const Unit& u, int wr, int wc, int fr, int fq) const {
        const int col0 = u.pn * 128 + wc * 32 + 8 * fq;
#pragma unroll
        for (int ai = 0; ai < 2; ++ai)
#pragma unroll
            for (int m = 0; m < 4; ++m) { const int rt = ai * HALF + wr * 64 + m * 16 + fr; f32x4 o[2];
#pragma unroll
                for (int n = 0; n < 2; ++n)
#pragma unroll
                    for (int i = 0; i < 4; ++i) { const float g = acc[ai][0][m][n][i]; o[n][i] = g * sigmoidf_fast(g) * acc[ai][1][m][n][i]; }
                if (rt < u.nrows) *(u32x4*)(act + (size_t)(u.row0 + rt) * 256 + col0) = pack8(o[0], o[1]); }
    }
};
struct EpiDown {
    static constexpr bool PERM = true;
    bf16_t* ys; const int* slot_of_pos; const float* gate_of_pos;
    __device__ __forceinline__ void operator()(const f32x4 (&acc)[2][2][4][2], const Unit& u, int wr, int wc, int fr, int fq) const {
        const int col0 = u.pn * 256 + wc * 32 + 8 * fq;
#pragma unroll
        for (int ai = 0; ai < 2; ++ai) {
            int sl[4]; float gt[4];
#pragma unroll
            for (int m = 0; m < 4; ++m) { const int rt = ai * HALF + wr * 64 + m * 16 + fr; const bool ok = rt < u.nrows; const int p = u.row0 + (ok ? rt : 0);
                sl[m] = ok ? slot_of_pos[p] : -1; gt[m] = gate_of_pos[p]; }
#pragma unroll
            for (int m = 0; m < 4; ++m) if (sl[m] >= 0) { bf16_t* rowp = ys + (size_t)sl[m] * 1024 + col0;
#pragma unroll
                for (int bj = 0; bj < 2; ++bj) *(u32x4*)(rowp + bj * HALF) = pack8(acc[ai][bj][m][0] * gt[m], acc[ai][bj][m][1] * gt[m]); }
        }
    }
};
}
namespace attn_body {
using bf16=__hip_bfloat16;
using bf16x8=__attribute__((ext_vector_type(8)))short;
using s16x4=__attribute__((ext_vector_type(4)))short;
using f32x16=__attribute__((ext_vector_type(16)))float;
using u32x4=__attribute__((ext_vector_type(4)))unsigned;
constexpr int BATCH=8,NHEAD=16,SEQ=4096,D=64,DM=NHEAD*D;
constexpr int NW=8,QBLK=32,QB=QBLK*NW,KVBLK=64,NQB=SEQ/QB;
constexpr int ATTN_PITCH=DM, ATTN_UNIT_ROWS=QB;
__device__ __forceinline__ int crow(int r,int hi){return (r&3)+8*(r>>2)+4*hi;}
#define SBAR() __builtin_amdgcn_sched_barrier(0)
__device__ __forceinline__ void cmask(f32x16&p0,f32x16&p1,int jb,int qrel,int hi){
  const float NEG=-INFINITY; int kb=64*jb+4*hi;
  #pragma unroll
  for(int r=0;r<16;++r){int kv=kb+(r&3)+8*(r>>2); if(kv>qrel)p0[r]=NEG; if(kv+32>qrel)p1[r]=NEG;}
}

constexpr int NSLOT=3, SLOTB=8192;
constexpr int LDS_K=0, LDS_V=NSLOT*SLOTB, LDS_WS=2*NSLOT*SLOTB, LDS_OST=LDS_WS+NW*64*4, LDS_BYTES=LDS_OST+NW*4096;
constexpr float C2=0.125f*1.4426950408889634f;
__device__ __forceinline__ void glds16(const void*gsrc,unsigned lds_dst){unsigned keep;
  asm volatile("s_mov_b32 %0, m0\n\ts_mov_b32 m0, %2\n\ts_nop 0\n\tglobal_load_lds_dwordx4 %1, off\n\ts_mov_b32 m0, %0":"=&s"(keep):"v"(gsrc),"s"(lds_dst):"memory");}
__device__ __forceinline__ float max3f(float a,float b,float c){float r;asm("v_max3_f32 %0, %1, %2, %3":"=v"(r):"v"(a),"v"(b),"v"(c));return r;}
__device__ __forceinline__ float max2f(float a,float b){float r;asm("v_max_f32_e32 %0, %1, %2":"=v"(r):"v"(a),"v"(b));return r;}
__device__ __forceinline__ float fadd_s(float a,float b){float r;asm("v_add_f32_e32 %0, %1, %2":"=v"(r):"v"(a),"v"(b));return r;}
__device__ __forceinline__ float fsub_s(float a,float b){float r;asm("v_sub_f32_e32 %0, %1, %2":"=v"(r):"v"(a),"v"(b));return r;}
typedef float f32x2_t __attribute__((ext_vector_type(2))); typedef __bf16 bf16x2_t __attribute__((ext_vector_type(2)));
__device__ __forceinline__ unsigned cvtpk_s(float lo,float hi){f32x2_t v={lo,hi};bf16x2_t b=__builtin_convertvector(v,bf16x2_t);return __builtin_bit_cast(unsigned,b);}
#define WAIT_BAR(N) asm volatile("s_waitcnt vmcnt(" #N ") lgkmcnt(0)\n\ts_barrier":::"memory")

__device__ __forceinline__ void qkt(f32x16&p0,f32x16&p1,const char*Kslot,const bf16x8*qr,const f32x16&negm,int r32,int hi){
  const char*kb=Kslot+hi*1024+r32*16;
  #pragma unroll
  for(int d0=0;d0<4;++d0){
    const bf16x8 b0=*reinterpret_cast<const bf16x8*>(kb+d0*2048);
    const bf16x8 b1=*reinterpret_cast<const bf16x8*>(kb+d0*2048+512);
    if(d0==0){p0=__builtin_amdgcn_mfma_f32_32x32x16_bf16(b0,qr[0],negm,0,0,0);p1=__builtin_amdgcn_mfma_f32_32x32x16_bf16(b1,qr[0],negm,0,0,0);}
    else{p0=__builtin_amdgcn_mfma_f32_32x32x16_bf16(b0,qr[d0],p0,0,0,0);p1=__builtin_amdgcn_mfma_f32_32x32x16_bf16(b1,qr[d0],p1,0,0,0);}}
}
typedef __attribute__((address_space(3))) const char* lds_cptr;
typedef short v4i16_t __attribute__((ext_vector_type(4)));
__device__ __forceinline__ void kload8(bf16x8*kf,lds_cptr kp){
  kf[0]=*(const __attribute__((address_space(3))) bf16x8*)(kp);      kf[1]=*(const __attribute__((address_space(3))) bf16x8*)(kp+512);
  kf[2]=*(const __attribute__((address_space(3))) bf16x8*)(kp+2048); kf[3]=*(const __attribute__((address_space(3))) bf16x8*)(kp+2560);
  kf[4]=*(const __attribute__((address_space(3))) bf16x8*)(kp+4096); kf[5]=*(const __attribute__((address_space(3))) bf16x8*)(kp+4608);
  kf[6]=*(const __attribute__((address_space(3))) bf16x8*)(kp+6144); kf[7]=*(const __attribute__((address_space(3))) bf16x8*)(kp+6656);
}
__device__ __forceinline__ void kload2(bf16x8*kf,lds_cptr kp,int j){ kf[2*j]=*(const __attribute__((address_space(3))) bf16x8*)(kp+j*2048); kf[2*j+1]=*(const __attribute__((address_space(3))) bf16x8*)(kp+j*2048+512); }
__device__ __forceinline__ s16x4 vtr(lds_cptr p){ return __builtin_bit_cast(s16x4,__builtin_amdgcn_ds_read_tr16_b64_v4i16((__attribute__((address_space(3))) v4i16_t*)p)); }
__device__ __forceinline__ float rowmax(const f32x16&p0,const f32x16&p1){
  float a=max3f(p0[0],p0[1],p1[0]),b=max3f(p0[2],p0[3],p1[1]);a=max3f(a,p1[2],p1[3]);
  #pragma unroll
  for(int r=4;r<16;r+=4){a=max3f(a,p0[r],p0[r+1]);b=max3f(b,p0[r+2],p0[r+3]);a=max3f(a,p1[r],p1[r+1]);b=max3f(b,p1[r+2],p1[r+3]);}
  const float m=max2f(a,b);
  auto rr=__builtin_amdgcn_permlane32_swap(__float_as_uint(m),__float_as_uint(m),false,false);
  return max2f(__uint_as_float(rr[0]),__uint_as_float(rr[1]));
}
__device__ __forceinline__ void pv(f32x16*o,int vb,bf16x8 pa0,bf16x8 pa1,bf16x8 pa2,bf16x8 pa3){
  #pragma unroll
  for(int d0=0;d0<2;++d0){s16x4 lo[4],hi[4];
    #pragma unroll
    for(int ks=0;ks<4;++ks){
      asm volatile("ds_read_b64_tr_b16 %0,%1 offset:%c2":"=&v"(lo[ks]):"v"(vb),"i"(d0*4096+ks*1024):"memory");
      asm volatile("ds_read_b64_tr_b16 %0,%1 offset:%c2":"=&v"(hi[ks]):"v"(vb),"i"(d0*4096+ks*1024+512):"memory");}
    asm volatile("s_waitcnt lgkmcnt(0)":::"memory");SBAR();
    #define PK(k) (bf16x8){lo[k][0],lo[k][1],lo[k][2],lo[k][3],hi[k][0],hi[k][1],hi[k][2],hi[k][3]}
    o[d0]=__builtin_amdgcn_mfma_f32_32x32x16_bf16(pa0,PK(0),o[d0],0,0,0);
    o[d0]=__builtin_amdgcn_mfma_f32_32x32x16_bf16(pa1,PK(1),o[d0],0,0,0);
    o[d0]=__builtin_amdgcn_mfma_f32_32x32x16_bf16(pa2,PK(2),o[d0],0,0,0);
    o[d0]=__builtin_amdgcn_mfma_f32_32x32x16_bf16(pa3,PK(3),o[d0],0,0,0);
    #undef PK
  }
}

#ifndef ATTN_STORE16
#define ATTN_STORE16(p,v) (*(u32x4*)(p)=(v))
#endif
template<int THRL> __device__ __forceinline__ void attn_unit(int b,int hq,int hv,int qb,const bf16*Q,const bf16*K,const bf16*V,bf16*O,char*shm){
  const int tid=threadIdx.x,lane=tid&63,r32=lane&31,hi=lane>>5; const int wid=__builtin_amdgcn_readfirstlane(tid>>6);
  const long rowbase=(long)b*SEQ; const int q0=qb*QB;
  const bf16*Qw=Q+(rowbase+q0+wid*QBLK)*DM+hq*D;
  const bf16*Kh=K+rowbase*DM+hq*D,*Vh=V+rowbase*DM+hv*D;
  const unsigned lds0=(unsigned)(uintptr_t)shm;
  float*wsf=(float*)(shm+LDS_WS)+wid*64;
  const bf16*ksrc=Kh+(long)lane*DM+wid*8;
  const bf16*vsrc=Vh+(long)(16*(wid&3)+(lane>>2))*DM+(wid>>2)*32+(lane&3)*8;
  const unsigned kdst=lds0+LDS_K+wid*1024, vdst=lds0+LDS_V+wid*1024;
  #define DMA_K(t,slot) glds16(ksrc+(long)(t)*KVBLK*DM,(unsigned)__builtin_amdgcn_readfirstlane(kdst+(slot)))
  #define DMA_V(t,slot) glds16(vsrc+(long)(t)*KVBLK*DM,(unsigned)__builtin_amdgcn_readfirstlane(vdst+(slot)))
  const int vb0=(int)(lds0+LDS_V)+((lane>>4)&1)*32+(lane&3)*8+(4*hi+((lane&15)>>2))*64;
  const char*Kbase=shm+LDS_K; bf16x8 kf[8];
  const lds_cptr shm3=(lds_cptr)shm; const lds_cptr kp0=shm3+LDS_K+hi*1024+r32*16; const lds_cptr vp0=shm3+LDS_V+((lane>>4)&1)*32+(lane&3)*8+(4*hi+((lane&15)>>2))*64;
  const int NT=(q0+QB)/KVBLK;
  DMA_K(0,0);DMA_V(0,0);DMA_K(1,SLOTB);
  bf16x8 qr[4];
  #pragma unroll
  for(int d0=0;d0<4;++d0)qr[d0]=*reinterpret_cast<const bf16x8*>(&Qw[(long)r32*DM+d0*16+hi*8]);
  float mhat=0.f,l_reg=0.f;f32x16 o[2];o[0]=f32x16{};o[1]=f32x16{};f32x16 negm=f32x16{};asm volatile("":"+v"(negm));
  const int qrel=wid*QBLK+r32;
  #define CMASK(P0,P1,t) do{int jb_=(t)-(NT-4); if(jb_>=0)cmask(P0,P1,jb_,qrel,hi);}while(0)
  bool resc=false;
  #define START(P0,P1) do{ const float rm=rowmax(P0,P1); resc=false; \
    { const float dl=rm; mhat=fadd_s(mhat,dl); \
      _Pragma("unroll") for(int r=0;r<16;++r){P0[r]=fsub_s(P0[r],dl);P1[r]=fsub_s(P1[r],dl);} \
      _Pragma("unroll") for(int r=0;r<16;++r)negm[r]=-mhat; asm volatile("":"+v"(negm)); } \
    _Pragma("unroll") for(int r=0;r<16;++r)P0[r]=__builtin_amdgcn_exp2f(P0[r]); }while(0)
  #define RESC() do{ if(resc){ asm volatile("s_waitcnt lgkmcnt(0)":::"memory"); \
      _Pragma("unroll") for(int d_=0;d_<2;++d_) _Pragma("unroll") for(int r=0;r<16;++r)o[d_][r]*=wsf[crow(r,hi)]; } }while(0)
  f32x16 pA0,pA1,pB0,pB1;
  int sl_prev=0,sl_cur=0,sl_next=SLOTB;
  #define ROT() do{sl_prev=sl_cur;sl_cur=sl_next;sl_next=(sl_next==(NSLOT-1)*SLOTB)?0:sl_next+SLOTB;}while(0)
  DMA_K(2,2*SLOTB);
  WAIT_BAR(3);
  qkt(pA0,pA1,Kbase,qr,negm,r32,hi);asm volatile("s_nop 15\n\ts_nop 7":"+v"(pA0),"+v"(pA1));CMASK(pA0,pA1,0);
  START(pA0,pA1);
  _Pragma("unroll") for(int r=0;r<16;++r)pA1[r]=__builtin_amdgcn_exp2f(pA1[r]);
  WAIT_BAR(0);
  DMA_K(3,0);DMA_V(1,SLOTB);
  ROT();
  kload8(kf,kp0+sl_cur);
  WAIT_BAR(2);
  s16x4 vlo[8],vhi[8]; u32x4 pw0,pw1,pw2,pw3;
  #define PKW(P,B) cvtpk_s(P[B],P[B+1])
  #define PAF(k) __builtin_bit_cast(bf16x8,pw##k)
  #define VFR(i) (bf16x8){vlo[i][0],vlo[i][1],vlo[i][2],vlo[i][3],vhi[i][0],vhi[i][1],vhi[i][2],vhi[i][3]}
  #define PIN(x) asm volatile("":"+v"(x))
  #define MX3(a,b,c) __builtin_fmaxf(__builtin_fmaxf((a),(b)),(c))
  #define GAPA(MF,A0,A1,A2,A3,W0,W1,PW) do{ MF; sacc+=A0; sacc+=A1; sacc+=A2; sacc+=A3; PIN(sacc); W0; W1; PIN(PW); SBAR(); }while(0)
  #define EX(v) __builtin_amdgcn_exp2f(v)
  #define GAPB(MF,X,B) do{ MF; X[B]=EX(X[B]); X[B+1]=EX(X[B+1]); X[B+2]=EX(X[B+2]); X[B+3]=EX(X[B+3]); PIN(X); SBAR(); }while(0)
  #define VRD(i) do{ vlo[i]=vtr(vp_+(((i)>>2)*4096+((i)&3)*1024)); vhi[i]=vtr(vp_+(((i)>>2)*4096+((i)&3)*1024+512)); }while(0)
  #define KRD(G,j) do{ if(G){ kload2(kf,kp0+sl_next,j); SBAR(); } }while(0)
  #define STEP(C0,C1,P0,P1,t,GK,GV,GL) do{ SBAR(); \
    const lds_cptr vp_=vp0+sl_prev; \
    VRD(0); SBAR(); float sacc=(P0[0]+P0[1]); \
    GAPA(C0=__builtin_amdgcn_mfma_f32_32x32x16_bf16(kf[0],qr[0],negm,0,0,0), P0[2],P0[3],P0[4],P0[5],     pw0[0]=PKW(P0,0), pw0[1]=PKW(P0,2), pw0); \
    VRD(4); SBAR(); GAPA(C1=__builtin_amdgcn_mfma_f32_32x32x16_bf16(kf[1],qr[0],negm,0,0,0), P0[6],P0[7],P0[8],P0[9],     pw0[2]=PKW(P0,4), pw0[3]=PKW(P0,6), pw0); \
    VRD(1); SBAR(); GAPA(C0=__builtin_amdgcn_mfma_f32_32x32x16_bf16(kf[2],qr[1],C0,0,0,0),   P0[10],P0[11],P0[12],P0[13], pw1[0]=PKW(P0,8), pw1[1]=PKW(P0,10), pw1); \
    VRD(5); SBAR(); GAPA(C1=__builtin_amdgcn_mfma_f32_32x32x16_bf16(kf[3],qr[1],C1,0,0,0),   P0[14],P0[15],P1[0],P1[1],   pw1[2]=PKW(P0,12),pw1[3]=PKW(P0,14), pw1); \
    VRD(2); SBAR(); GAPA(C0=__builtin_amdgcn_mfma_f32_32x32x16_bf16(kf[4],qr[2],C0,0,0,0),   P1[2],P1[3],P1[4],P1[5],     pw2[0]=PKW(P1,0), pw2[1]=PKW(P1,2), pw2); \
    VRD(6); SBAR(); GAPA(C1=__builtin_amdgcn_mfma_f32_32x32x16_bf16(kf[5],qr[2],C1,0,0,0),   P1[6],P1[7],P1[8],P1[9],     pw2[2]=PKW(P1,4), pw2[3]=PKW(P1,6), pw2); \
    VRD(3); SBAR(); GAPA(C0=__builtin_amdgcn_mfma_f32_32x32x16_bf16(kf[6],qr[3],C0,0,0,0),   P1[10],P1[11],P1[12],P1[13], pw3[0]=PKW(P1,8), pw3[1]=PKW(P1,10), pw3); \
    VRD(7); SBAR(); GAPA(C1=__builtin_amdgcn_mfma_f32_32x32x16_bf16(kf[7],qr[3],C1,0,0,0),   P1[14],P1[15],0.f,0.f,       pw3[2]=PKW(P1,12),pw3[3]=PKW(P1,14), pw3); \
    l_reg+=sacc; \
    if(GK){DMA_K((t)+3,sl_cur);} if(GV){DMA_V((t)+1,sl_next);} \
    CMASK(C0,C1,t); \
    { float a=MX3(C0[0],C0[1],C1[0]),b=MX3(C0[2],C0[3],C1[1]); a=MX3(a,C1[2],C1[3]); \
      _Pragma("unroll") for(int r=4;r<16;r+=4){a=MX3(a,C0[r],C0[r+1]);b=MX3(b,C0[r+2],C0[r+3]);a=MX3(a,C1[r],C1[r+1]);b=MX3(b,C1[r+2],C1[r+3]);} \
      float rm=__builtin_fmaxf(a,b); { auto rr=__builtin_amdgcn_permlane32_swap(__float_as_uint(rm),__float_as_uint(rm),false,false); rm=__builtin_fmaxf(__uint_as_float(rr[0]),__uint_as_float(rr[1])); } \
      resc=false; \
      if(__builtin_expect(__any(rm>(float)THRL),0)){ const float dl=__builtin_fmaxf(rm,0.f); mhat+=dl; \
        _Pragma("unroll") for(int r=0;r<16;++r){C0[r]-=dl;C1[r]-=dl;} \
        _Pragma("unroll") for(int r=0;r<16;++r)negm[r]=-mhat; asm volatile("":"+v"(negm)); \
        const float f=__builtin_amdgcn_exp2f(-dl); l_reg*=f; if(hi==0)wsf[r32]=f; resc=true; } } \
    SBAR(); \
    GAPB(o[0]=__builtin_amdgcn_mfma_f32_32x32x16_bf16(PAF(0),VFR(0),o[0],0,0,0), C0,0); \
    GAPB(o[1]=__builtin_amdgcn_mfma_f32_32x32x16_bf16(PAF(0),VFR(4),o[1],0,0,0), C0,4); \
    KRD(GL,0); GAPB(o[0]=__builtin_amdgcn_mfma_f32_32x32x16_bf16(PAF(1),VFR(1),o[0],0,0,0), C0,8); \
    KRD(GL,1); GAPB(o[1]=__builtin_amdgcn_mfma_f32_32x32x16_bf16(PAF(1),VFR(5),o[1],0,0,0), C0,12); \
    KRD(GL,2); GAPB(o[0]=__builtin_amdgcn_mfma_f32_32x32x16_bf16(PAF(2),VFR(2),o[0],0,0,0), C1,0); \
    KRD(GL,3); GAPB(o[1]=__builtin_amdgcn_mfma_f32_32x32x16_bf16(PAF(2),VFR(6),o[1],0,0,0), C1,4); \
    GAPB(o[0]=__builtin_amdgcn_mfma_f32_32x32x16_bf16(PAF(3),VFR(3),o[0],0,0,0), C1,8); \
    GAPB(o[1]=__builtin_amdgcn_mfma_f32_32x32x16_bf16(PAF(3),VFR(7),o[1],0,0,0), C1,12); \
    }while(0)
  int t=1;
  #undef CMASK
  #define CMASK(P0,P1,t) do{}while(0)
  for(;t+5<NT;t+=2){
    STEP(pB0,pB1,pA0,pA1,t,true,true,true);     WAIT_BAR(2); RESC(); ROT();
    STEP(pA0,pA1,pB0,pB1,t+1,true,true,true);   WAIT_BAR(2); RESC(); ROT();
  }
  #undef CMASK
  #define CMASK(P0,P1,t) do{int jb_=(t)-(NT-4); if(jb_>=0)cmask(P0,P1,jb_,qrel,hi);}while(0)
  #define ENDW(tt) do{ if((tt)+3<NT){WAIT_BAR(2);} else if((tt)+2<NT){WAIT_BAR(1);} else {WAIT_BAR(0);} }while(0)
  for(;t+1<NT;t+=2){
    STEP(pB0,pB1,pA0,pA1,t,(t+3<NT),(t+1<NT),(t+1<NT));       ENDW(t);   RESC(); ROT();
    STEP(pA0,pA1,pB0,pB1,t+1,(t+4<NT),(t+2<NT),(t+2<NT));     ENDW(t+1); RESC(); ROT();
  }
  STEP(pB0,pB1,pA0,pA1,NT-1,false,false,false); RESC();
  { float sacc=pB0[0]+pB0[1]; _Pragma("unroll") for(int r=2;r<16;++r)sacc+=pB0[r]; _Pragma("unroll") for(int r=0;r<16;++r)sacc+=pB1[r]; l_reg+=sacc;
    pw0=(u32x4){PKW(pB0,0),PKW(pB0,2),PKW(pB0,4),PKW(pB0,6)};pw1=(u32x4){PKW(pB0,8),PKW(pB0,10),PKW(pB0,12),PKW(pB0,14)};pw2=(u32x4){PKW(pB1,0),PKW(pB1,2),PKW(pB1,4),PKW(pB1,6)};pw3=(u32x4){PKW(pB1,8),PKW(pB1,10),PKW(pB1,12),PKW(pB1,14)};
    SBAR(); pv(o,vb0+sl_cur,PAF(0),PAF(1),PAF(2),PAF(3)); }
  #undef PKW
  #undef PAF
  #undef VFR
  #undef PIN
  #undef MX3
  #undef GAPA
  #undef GAPB
  #undef EX
  #undef VRD
  #undef KRD
  #undef STEP
  #undef ENDW
  {auto rr=__builtin_amdgcn_permlane32_swap(__float_as_uint(l_reg),__float_as_uint(l_reg),false,false);l_reg=__uint_as_float(rr[0])+__uint_as_float(rr[1]);}
  if(hi==0)wsf[32+r32]=l_reg;asm volatile("s_waitcnt lgkmcnt(0)":::"memory");
  float rli[16];
  #pragma unroll
  for(int r=0;r<16;++r)rli[r]=__builtin_amdgcn_rcpf(wsf[32+crow(r,hi)]);
  bf16*Ow=O+(rowbase+q0+wid*QBLK)*DM+hv*D;
  { bf16*stg=(bf16*)(shm+LDS_OST)+wid*2048;
    #pragma unroll
    for(int r=0;r<16;++r){const int orow=crow(r,hi);
      #pragma unroll
      for(int d0=0;d0<2;++d0)stg[orow*64+d0*32+r32]=__float2bfloat16(o[d0][r]*rli[r]);}
    asm volatile("s_waitcnt lgkmcnt(0)":::"memory");
    #pragma unroll
    for(int i=0;i<4;++i){const int row=i*8+(lane>>3),ch=lane&7; const u32x4 v=*(const u32x4*)(stg+row*64+ch*8); ATTN_STORE16(Ow+(long)row*DM+ch*8,v);} }
  asm volatile("s_waitcnt lgkmcnt(0)\n\ts_barrier":::"memory");
  #undef DMA_K
  #undef DMA_V
  #undef CMASK
  #undef START
  #undef RESC
  #undef ROT
}
constexpr int ATTN_LDS_BYTES=LDS_BYTES;
struct AttnTensors { const bf16* Q; const bf16* K; const bf16* V; bf16* O0; bf16* O1; };
struct AttnUnit { int b, hq, hv, c, qb; };
struct PairOrder {
  int vcu, G;
  __device__ __forceinline__ PairOrder(int grid,int vcu_):vcu(vcu_),G(grid){}
  __device__ __forceinline__ bool next(int i,AttnUnit&u)const{ const int p=(i>>1)*G+vcu; if(p>=2048)return false; const int s=p&7, cv=(p&31)>>3, bh=((p&255)>>5)*8+(p>>8);
    u.b=bh>>3; const int h=bh&7; u.c=cv>>1; u.hq=2*h+(cv>>1); u.hv=2*h+(cv&1); u.qb=(i&1)?s:15-s; return true; }
  __device__ __forceinline__ void a_ready(const AttnUnit&)const{}
  __device__ __forceinline__ void done(const AttnUnit&)const{}
};
template<class Sched,int THRL=8> __device__ __forceinline__ void attn_phase(char*lds,const AttnTensors&T,const Sched&S){
  AttnUnit u;
  for(int i=0;S.next(i,u);++i){ S.a_ready(u); attn_unit<THRL>(u.b,u.hq,u.hv,u.qb,T.Q,T.K,T.V,u.c?T.O1:T.O0,lds); S.done(u); }
}
#undef SBAR
#undef WAIT_BAR
}
#define GAS __attribute__((address_space(1)))
#define LAS __attribute__((address_space(3)))
typedef unsigned short bf16;
typedef unsigned v4u __attribute__((ext_vector_type(4)));
typedef float f32x4 __attribute__((ext_vector_type(4)));
typedef short bf16x8 __attribute__((ext_vector_type(8)));
typedef GAS unsigned gu32;
typedef GAS unsigned long long gu64;
#define RLX_AGENT __ATOMIC_RELAXED, __HIP_MEMORY_SCOPE_AGENT
#define LDS_WAIT() asm volatile("s_waitcnt lgkmcnt(0)" ::: "memory")
#define VM_WAIT() asm volatile("s_waitcnt vmcnt(0)" ::: "memory")
__device__ __forceinline__ unsigned long long rt() { return __builtin_amdgcn_s_memrealtime(); }
__device__ __forceinline__ unsigned f2bf(float f) { unsigned u = __builtin_bit_cast(unsigned, f); return (u + 0x7fffu + ((u >> 16) & 1u)) >> 16; }
__device__ __forceinline__ unsigned pk2(float lo, float hi) { return f2bf(lo) | (f2bf(hi) << 16); }

#define XB_TMO      128
#define XB_XCNT(j)  (256  + 64 * (j))
#define XB_XSUB(j)  (1280 + 64 * (j))
#define XB_XGEN(j)  (2304 + 64 * (j))
#define XB_TOP      3328
#define XB_TOPGEN   3392
#define XCD_BAR_WORDS 3456
#define XB_SPIN_CAP (1u << 18)

__device__ __forceinline__ unsigned xb_ld(unsigned* p)              { return __hip_atomic_load(p, __ATOMIC_RELAXED, __HIP_MEMORY_SCOPE_AGENT); }
__device__ __forceinline__ unsigned xb_add(unsigned* p, unsigned v) { return __hip_atomic_fetch_add(p, v, __ATOMIC_RELAXED, __HIP_MEMORY_SCOPE_AGENT); }
__device__ __forceinline__ unsigned xb_xcc_id() { return (unsigned)__builtin_amdgcn_s_getreg((3 << 11) | 20) & 0xFu; }
#define XB_SPIN(cond, bar) do { unsigned _sp = 0; while (cond) { __builtin_amdgcn_s_sleep(1); \
    if ((++_sp & 255u) == 0u) { if (xb_ld(&(bar)[XB_TMO])) break; if (_sp > XB_SPIN_CAP) { atomicAdd(&(bar)[XB_TMO], 1u); break; } } } } while (0)

struct XcdBarrier {
    unsigned* bar; unsigned x;
    volatile LAS unsigned* st;
};

__device__ __forceinline__ XcdBarrier xcd_barrier_post(unsigned* bar, volatile LAS unsigned* st) {
    XcdBarrier b; b.bar = bar; b.x = xb_xcc_id(); b.st = st;
    if (threadIdx.x == 0) (void)xb_add(&bar[XB_XCNT(b.x)], 1u);
    return b;
}
__device__ __forceinline__ void xcd_barrier_complete(unsigned* bar, unsigned x, unsigned& nloc, unsigned& nx) {
    const unsigned G = gridDim.x * gridDim.y * gridDim.z;
    unsigned sum, cnt, mine, sp = 0u;
    for (;;) {
        sum = 0u; cnt = 0u; mine = 0u;
#pragma unroll
        for (unsigned j = 0; j < 16; ++j) { const unsigned c = xb_ld(&bar[XB_XCNT(j)]); sum += c; cnt += (c > 0u) ? 1u : 0u; mine = (j == x) ? c : mine; }
        if (sum == G) break;
        __builtin_amdgcn_s_sleep(1);
        if ((++sp & 255u) == 0u) { if (xb_ld(&bar[XB_TMO])) break; if (sp > XB_SPIN_CAP) { atomicAdd(&bar[XB_TMO], 1u); break; } }
    }
    nloc = mine > 0u ? mine : 1u; nx = cnt > 0u ? cnt : 1u;
}

__device__ __forceinline__ void xcd_barrier(const XcdBarrier& b) {
    asm volatile("s_waitcnt vmcnt(0)" ::: "memory");
    __syncthreads();
    if (threadIdx.x == 0) {
        unsigned* bar = b.bar;
        __builtin_amdgcn_s_waitcnt(0);
        unsigned nloc = b.st[0], nx = b.st[1];
        if (nloc == 0u) { xcd_barrier_complete(bar, b.x, nloc, nx); b.st[0] = nloc; b.st[1] = nx; }
        const unsigned old = xb_add(&bar[XB_XSUB(b.x)], 1u);
        const unsigned gen = old / nloc;
        if (old + 1u == (gen + 1u) * nloc) {
            __builtin_amdgcn_fence(__ATOMIC_RELEASE, "agent");
            asm volatile("s_waitcnt vmcnt(0)" ::: "memory");
            const unsigned og = xb_add(&bar[XB_TOP], 1u);
            const unsigned tg = og / nx;
            if (og + 1u == (tg + 1u) * nx) xb_add(&bar[XB_TOPGEN], 1u);
            else XB_SPIN(xb_ld(&bar[XB_TOPGEN]) == tg, bar);
            __builtin_amdgcn_fence(__ATOMIC_ACQUIRE, "agent");
            xb_add(&bar[XB_XGEN(b.x)], 1u);
            asm volatile("s_waitcnt vmcnt(0)" ::: "memory");
        } else {
            XB_SPIN(xb_ld(&bar[XB_XGEN(b.x)]) == gen, bar);
            __builtin_amdgcn_fence(__ATOMIC_ACQUIRE, "agent");
            asm volatile("s_waitcnt vmcnt(0)" ::: "memory");
        }
    }
    __syncthreads();
}
constexpr int NWAVES = 8;
constexpr int BATCH = 8, SEQ = 4096, T = BATCH * SEQ, D = 1024, NEXP = 256, TOPK = 8, DEXP = 256, NSLOT = TOPK + 1  ;
constexpr int INW = 7168;
constexpr int NPOS = T * NSLOT;
constexpr int MAXTILES = 1408;
constexpr float EPS = 1e-6f;

constexpr size_t MiB = 1u << 20;
constexpr size_t WS_CTL = 0, CTL_ZERO_BYTES = 1 * MiB;
constexpr size_t WS_MOD = 1 * MiB;
constexpr size_t WS_C8SP = 1 * MiB + 256 * 1024;
constexpr size_t WS_CST = 1 * MiB + 512 * 1024;
constexpr size_t WS_WIN = 4 * MiB, WS_WO = 18 * MiB, WS_WR = 20 * MiB, WS_WLRU = 20 * MiB + 512 * 1024;
constexpr size_t WS_TOPE = 21 * MiB, WS_TOPG = 22 * MiB, WS_POSE = 23 * MiB;
constexpr size_t WS_TOKP = 24 * MiB, WS_SLOTP = 26 * MiB, WS_GATEP = 28 * MiB, WS_TILES = 30 * MiB;
constexpr size_t WS_WED = 32 * MiB;
constexpr size_t WS_WEGU = 161 * MiB;
constexpr size_t WS_XR = 418 * MiB, WS_GAR = 482 * MiB, WS_Q = 546 * MiB, WS_K = 610 * MiB, WS_V = 674 * MiB, WS_GB = 738 * MiB, WS_MIX = 802 * MiB;
constexpr size_t WS_LOGIT = 738 * MiB;
constexpr size_t WS_H2 = 418 * MiB;
constexpr size_t WS_ACT = 802 * MiB;
constexpr size_t WS_YS = 161 * MiB;
constexpr size_t WS_END = 948 * MiB;
static_assert(WS_YS + (size_t)NPOS * 2048 <= WS_LOGIT && WS_ACT + (size_t)(NPOS + 256) * 512 <= WS_END && WS_WED + (size_t)257 * 1024 * 256 * 2 <= WS_WEGU && WS_WEGU + (size_t)257 * 512 * 1024 * 2 <= WS_XR, "d_ws map");
constexpr int CW_TMO = 0, CW_CODE = 1, CW_NTILES = 64, CW_CNT = 1024, CW_BAR = 4096;

constexpr int RING_OFF = 0, RING_BYTES = 131072;
constexpr int LDSCTL_OFF = RING_BYTES, MISC_OFF = LDSCTL_OFF + 320;
constexpr int UT_OFF = LDSCTL_OFF + 512;
constexpr int TOK_OFF = LDSCTL_OFF + 2048;
constexpr int LDS_BYTES = 147456;
constexpr int MAXU_TOK = 14, MAXU = 64;
struct Frame {
    LAS unsigned char* lds;
    volatile LAS unsigned* MISC;
    gu32* ctl;
    int tid, lane, wave;
    int vcu, G;
};
#define LBAR() asm volatile("s_waitcnt lgkmcnt(0)\n\ts_barrier" ::: "memory")
__device__ __forceinline__ float wave_sum(float v) {
#pragma unroll
    for (int o = 1; o < 64; o <<= 1) v += __shfl_xor(v, o);
    return v;
}
__device__ __forceinline__ float bf2f(unsigned short h) { return __builtin_bit_cast(float, (unsigned)h << 16); }
__device__ __forceinline__ float bflo(unsigned w) { return __builtin_bit_cast(float, w << 16); }
__device__ __forceinline__ float bfhi(unsigned w) { return __builtin_bit_cast(float, w & 0xffff0000u); }
__device__ __forceinline__ float sigm(float v) { return __builtin_amdgcn_rcpf(1.0f + __builtin_amdgcn_exp2f(-1.4426950408889634f * v)); }

__device__ __forceinline__ void transpose_item(const float* W, int ldn, bf16* WT, int ldk, int k0, int n0, int drow0, LAS float* scr, int lane) {
    float v[32];
#pragma unroll
    for (int i = 0; i < 32; ++i) { const int kk = 2 * i + (lane >> 5); v[i] = W[(size_t)(k0 + kk) * ldn + n0 + (lane & 31)]; }
#pragma unroll
    for (int i = 0; i < 32; ++i) { const int kk = 2 * i + (lane >> 5); scr[kk * 33 + (lane & 31)] = v[i]; }
    LDS_WAIT(); asm volatile("" ::: "memory");
    const int c = lane & 7;
#pragma unroll
    for (int j = 0; j < 4; ++j) { const int n = (lane >> 3) + 8 * j; const LAS float* s = scr + (8 * c) * 33 + n;
        v4u o; o.x = pk2(s[0 * 33], s[1 * 33]); o.y = pk2(s[2 * 33], s[3 * 33]); o.z = pk2(s[4 * 33], s[5 * 33]); o.w = pk2(s[6 * 33], s[7 * 33]);
        *(GAS v4u*)(WT + (size_t)(drow0 + n) * ldk + k0 + 8 * c) = o; }
    LDS_WAIT(); asm volatile("" ::: "memory");
}
__device__ __forceinline__ int rowmap_in(int n0) {
    const int seg = n0 >> 10, o = n0 & 1023;
    if (seg == 0) return o;
    if (seg == 1) return 1024 + 256 * (o >> 7) + (o & 127);
    if (seg == 2 || seg == 3) { const int j = o >> 8, r = o & 255; return (seg == 2 ? 3072 : 4096) + 256 * j + 128 * ((r >> 5) & 1) + 32 * (r >> 6) + (r & 31); }
    if (seg == 4) return 5120 + o;
    if (seg == 5) return 1024 + 256 * (o >> 7) + 128 + (o & 127);
    return 6144 + o;
}
struct P0Args { const float *c, *w_ada, *b_ada, *w_in, *w_o, *w_router, *we_gate, *we_up, *we_down, *ws_gate, *ws_up, *ws_down, *lru_wa, *lru_wx, *lru_lambda; const int* positions; };
__device__ __forceinline__ void p0_prologue(Frame& F, const P0Args& a, unsigned char* ws) {
    float* mod = (float*)(ws + WS_MOD);
    for (int u = F.vcu; u < 96; u += F.G) {
        LAS float* sc = (LAS float*)F.lds; LAS float* red = (LAS float*)(F.lds + 32768);
        for (int i = F.tid; i < 8192; i += 512) { const float v = a.c[i]; sc[i] = v * sigm(v); }
        __syncthreads();
        const int cl = F.tid & 63, ks = F.wave, col = u * 64 + cl;
        float acc[8];
#pragma unroll
        for (int b = 0; b < 8; ++b) acc[b] = 0.f;
#pragma unroll 8
        for (int k = ks * 128; k < ks * 128 + 128; ++k) { const float w = a.w_ada[(size_t)k * 6144 + col];
#pragma unroll
            for (int b = 0; b < 8; ++b) acc[b] += sc[b * 1024 + k] * w; }
#pragma unroll
        for (int b = 0; b < 8; ++b) red[(ks * 8 + b) * 64 + cl] = acc[b];
        __syncthreads();
        { const int b = F.tid >> 6; float s = a.b_ada[col];
#pragma unroll
          for (int k2 = 0; k2 < 8; ++k2) s += red[(k2 * 8 + b) * 64 + cl];
          mod[b * 6144 + col] = s; }
        __syncthreads();
    }
    const int gt = F.vcu * 512 + F.tid, NT_ = F.G * 512;
    if (gt < 1024) { const double z = -(double)a.lru_lambda[gt]; const double sp = (z > 0.0 ? z : 0.0) + log1p(exp(-(z > 0.0 ? z : -z))); ((float*)(ws + WS_C8SP))[gt] = (float)(8.0 * sp); }
    for (int idx = gt; idx < T * 8; idx += NT_) { const int tok = idx >> 3, i = idx & 7;
        const float inv = exp2f(-(float)i * 0.125f * 18.931568569324174f);
        const float ang = (float)a.positions[tok] * inv;
        double rev = (double)ang * 0.15915494309189535; rev -= floor(rev); const float fr = (float)rev;
        float* cs = (float*)(ws + WS_CST) + (size_t)tok * 16;
        cs[i] = __builtin_amdgcn_cosf(fr); cs[8 + i] = __builtin_amdgcn_sinf(fr); }
    LAS float* scr = (LAS float*)(F.lds + RING_OFF + F.wave * 16384);
    const int gw = F.vcu * NWAVES + F.wave, NGW = F.G * NWAVES;
    bf16* Win_t = (bf16*)(ws + WS_WIN); bf16* Wo_t = (bf16*)(ws + WS_WO); bf16* Wr_t = (bf16*)(ws + WS_WR); bf16* Wlru = (bf16*)(ws + WS_WLRU);
    bf16* Wed = (bf16*)(ws + WS_WED); bf16* Wegu = (bf16*)(ws + WS_WEGU);
    constexpr int I_IN = 16 * 224, I_O = 16 * 32, I_R = 16 * 8, I_E = 384 * 257, I_L = 64;
    constexpr int NITEMS = I_E + I_IN + I_O + I_R + I_L;
    for (int it = gw; it < NITEMS; it += NGW) {
        int r = it;
        if (r < I_E) { const int e = r / 384, q = r % 384, which = q >> 7, ii = q & 127;
            if (which < 2) { const float* src = (e < 256) ? ((which ? a.we_up : a.we_gate) + (size_t)e * 262144) : (which ? a.ws_up : a.ws_gate);
                const int kb = ii >> 3, nb = ii & 7, n0 = nb * 32;
                transpose_item(src, 256, Wegu + (size_t)e * 524288, 1024, kb * 64, n0, 256 * (n0 >> 7) + (which ? 128 : 0) + (n0 & 127), scr, F.lane);
            } else { const float* src = (e < 256) ? (a.we_down + (size_t)e * 262144) : a.ws_down;
                const int kb = ii >> 5, nb = ii & 31;
                transpose_item(src, 1024, Wed + (size_t)e * 262144, 256, kb * 64, nb * 32, nb * 32, scr, F.lane); }
            continue; }
        r -= I_E;
        if (r < I_IN) { const int kb = r / 224, nb = r % 224; transpose_item(a.w_in, INW, Win_t, 1024, kb * 64, nb * 32, rowmap_in(nb * 32), scr, F.lane); continue; }
        r -= I_IN;
        if (r < I_O) { const int kb = r >> 5, nb = r & 31; transpose_item(a.w_o, 1024, Wo_t, 1024, kb * 64, nb * 32, nb * 32, scr, F.lane); continue; }
        r -= I_O;
        if (r < I_R) { const int kb = r >> 3, nb = r & 7; transpose_item(a.w_router, 256, Wr_t, 1024, kb * 64, nb * 32, nb * 32, scr, F.lane); continue; }
        r -= I_R;
        { const int g = r >> 2, wx = (r >> 1) & 1, hf = r & 1;
          transpose_item((wx ? a.lru_wx : a.lru_wa) + (size_t)g * 4096, 64, Wlru, 64, 0, hf * 32, (g * 2 + hf) * 64 + (wx ? 32 : 0), scr, F.lane); }
    }
}

__device__ __forceinline__ void norm_mod_phase(Frame& F, const float* src, const float* gvec, const float* mod, int off_shift, int off_scale, bf16* dst) {
    const int gw = F.vcu * NWAVES + F.wave, NGW = F.G * NWAVES;
    for (int blk = gw; blk < T / 16; blk += NGW) {
        const int row0 = blk * 16, b = row0 >> 12; const float* mp = mod + (size_t)b * 6144;
        f32x4 g[4], sc[4], sh[4];
#pragma unroll
        for (int j = 0; j < 4; ++j) { const int col = 4 * F.lane + 256 * j; g[j] = *(const GAS f32x4*)(gvec + col); sc[j] = *(const GAS f32x4*)(mp + off_scale + col) + 1.0f; sh[j] = *(const GAS f32x4*)(mp + off_shift + col); }
        for (int r = 0; r < 16; ++r) {
            const GAS f32x4* xr = (const GAS f32x4*)(src + (size_t)(row0 + r) * D) + F.lane;
            f32x4 v[4]; float s = 0.f;
#pragma unroll
            for (int j = 0; j < 4; ++j) { v[j] = xr[64 * j]; s += (v[j].x * v[j].x + v[j].y * v[j].y) + (v[j].z * v[j].z + v[j].w * v[j].w); }
            const float rstd = 1.0f / sqrtf(wave_sum(s) * (1.0f / D) + EPS);
            GAS unsigned long long* o8 = (GAS unsigned long long*)(dst + (size_t)(row0 + r) * D) + F.lane;
#pragma unroll
            for (int j = 0; j < 4; ++j) { const f32x4 y = (v[j] * rstd * g[j]) * sc[j] + sh[j];
                o8[64 * j] = (unsigned long long)pk2(y.x, y.y) | ((unsigned long long)pk2(y.z, y.w) << 32); }
        }
    }
}

struct LruArgs { const bf16* XR; const bf16* GAR; bf16* MIX; const bf16* Wlru; const float *conv_w, *conv_b, *lru_ba, *lru_bx, *c8sp; };
__device__ __forceinline__ float neg_expm1(float x) {
    const float p = x * (1.0f + x * (0.5f + x * (0.16666667f + x * (0.041666668f + x * (0.008333334f + x * 0.0013888889f)))));
    return x > -0.25f ? -p : 1.0f - __expf(x);
}
__device__ __forceinline__ void lru_phase(Frame& F, const LruArgs& a) {
    typedef short bf16x8v __attribute__((ext_vector_type(8)));
    LAS unsigned char* L = F.lds;
    LAS unsigned char* At = L;
    LAS float* AGG = (LAS float*)(L + 18432);
    LAS unsigned char* HT = L + 20480;
    const int tid = F.tid, lane = F.lane, w = F.wave, fr = lane & 15, fq = lane >> 4, cp = tid & 31, sub = tid >> 5;
    for (int u = F.vcu; u < 256; u += F.G) {
        const int b = u >> 5, g = (u >> 1) & 15, hf = u & 1;
        bf16x8v bfr[4][2];
        { const bf16* wl = a.Wlru + (size_t)((g * 2 + hf) * 64) * 64;
#pragma unroll
          for (int nb = 0; nb < 4; ++nb)
#pragma unroll
              for (int kk = 0; kk < 2; ++kk) bfr[nb][kk] = *(const GAS bf16x8v*)(wl + (nb * 16 + fr) * 64 + kk * 32 + fq * 8); }
        const int chc = g * 64 + 2 * cp;
        float cw[4][2], cb[2];
#pragma unroll
        for (int tp = 0; tp < 4; ++tp) { cw[tp][0] = a.conv_w[tp * 1024 + chc]; cw[tp][1] = a.conv_w[tp * 1024 + chc + 1]; }
        cb[0] = a.conv_b[chc]; cb[1] = a.conv_b[chc + 1];
        float ba2[2], bx2[2], c8[2];
#pragma unroll
        for (int nbp = 0; nbp < 2; ++nbp) { const int ch = g * 64 + hf * 32 + 16 * nbp + fr; ba2[nbp] = a.lru_ba[ch]; bx2[nbp] = a.lru_bx[ch]; c8[nbp] = a.c8sp[ch]; }
        float carry[2] = {0.f, 0.f};
        const bf16* xr = a.XR + (size_t)b * SEQ * D + chc;
        unsigned xraw[11];
#pragma unroll
        for (int j = 0; j < 11; ++j) { const int t = 8 * sub - 3 + j; xraw[j] = (t >= 0) ? *(const GAS unsigned*)(xr + (size_t)t * D) : 0u; }
        const int tk_o = tid >> 2, part = tid & 3;
        for (int it = 0; it < 32; ++it) {
            const int t0 = it * 128;
            float xv[11][2];
#pragma unroll
            for (int j = 0; j < 11; ++j) { xv[j][0] = bflo(xraw[j]); xv[j][1] = bfhi(xraw[j]); }
#pragma unroll
            for (int j = 0; j < 8; ++j) {
                const float y0 = cb[0] + cw[0][0] * xv[j][0] + cw[1][0] * xv[j + 1][0] + cw[2][0] * xv[j + 2][0] + cw[3][0] * xv[j + 3][0];
                const float y1 = cb[1] + cw[0][1] * xv[j][1] + cw[1][1] * xv[j + 1][1] + cw[2][1] * xv[j + 2][1] + cw[3][1] * xv[j + 3][1];
                *(LAS unsigned*)(At + (8 * sub + j) * 144 + 4 * cp) = pk2(y0, y1); }
            if (it + 1 < 32) {
#pragma unroll
                for (int j = 0; j < 11; ++j) { const int t = t0 + 128 + 8 * sub - 3 + j; xraw[j] = *(const GAS unsigned*)(xr + (size_t)t * D); } }
            const v4u garv = *(const GAS v4u*)(a.GAR + (size_t)(b * SEQ + t0 + tk_o) * D + g * 64 + hf * 32 + part * 8);
            LBAR();
            f32x4 acc[4];
            { const bf16x8v a0 = *(const LAS bf16x8v*)(At + (16 * w + fr) * 144 + fq * 16), a1 = *(const LAS bf16x8v*)(At + (16 * w + fr) * 144 + 64 + fq * 16);
#pragma unroll
              for (int nb = 0; nb < 4; ++nb) { acc[nb] = __builtin_amdgcn_mfma_f32_16x16x32_bf16(a0, bfr[nb][0], (f32x4){0.f, 0.f, 0.f, 0.f}, 0, 0, 0);
                  acc[nb] = __builtin_amdgcn_mfma_f32_16x16x32_bf16(a1, bfr[nb][1], acc[nb], 0, 0, 0); } }
            float hl[2][4], pl[2][4], P[2], H[2], Pe[2], He[2];
#pragma unroll
            for (int nbp = 0; nbp < 2; ++nbp) { float h = 0.f, p = 1.f;
#pragma unroll
                for (int rg = 0; rg < 4; ++rg) { const int tk = 16 * w + 4 * fq + rg;
                    const float xcv = bf2f(*(const LAS unsigned short*)(At + tk * 144 + (hf * 32 + 16 * nbp + fr) * 2));
                    const float r = sigm(acc[nbp][rg] + ba2[nbp]), ig = sigm(acc[2 + nbp][rg] + bx2[nbp]);
                    const float la = -r * c8[nbp], av = __expf(la), mu = sqrtf(neg_expm1(2.0f * la)), uu = mu * ig * xcv;
                    h = av * h + uu; p = p * av; hl[nbp][rg] = h; pl[nbp][rg] = p; }
                float Pp = __shfl(p, lane - 16), Hp = __shfl(h, lane - 16);
                if (fq >= 1) { h = p * Hp + h; p = p * Pp; }
                Pp = __shfl(p, lane - 32); Hp = __shfl(h, lane - 32);
                if (fq >= 2) { h = p * Hp + h; p = p * Pp; }
                P[nbp] = p; H[nbp] = h;
                Pp = __shfl(p, lane - 16); Hp = __shfl(h, lane - 16);
                Pe[nbp] = fq >= 1 ? Pp : 1.f; He[nbp] = fq >= 1 ? Hp : 0.f;
                if (fq == 3) { AGG[(w * 32 + 16 * nbp + fr) * 2] = p; AGG[(w * 32 + 16 * nbp + fr) * 2 + 1] = h; } }
            LBAR();
#pragma unroll
            for (int nbp = 0; nbp < 2; ++nbp) { float c = carry[nbp], cwv = 0.f;
#pragma unroll
                for (int w2 = 0; w2 < 8; ++w2) { const float Pw = AGG[(w2 * 32 + 16 * nbp + fr) * 2], Hw = AGG[(w2 * 32 + 16 * nbp + fr) * 2 + 1]; if (w2 == w) cwv = c; c = Pw * c + Hw; }
                carry[nbp] = c;
                const float hent = He[nbp] + Pe[nbp] * cwv;
#pragma unroll
                for (int rg = 0; rg < 4; ++rg) { const float hf_ = hl[nbp][rg] + pl[nbp][rg] * hent;
                    *(LAS unsigned short*)(HT + (16 * w + 4 * fq + rg) * 80 + (16 * nbp + fr) * 2) = (unsigned short)f2bf(hf_); } }
            LBAR();
            { const v4u hv = *(const LAS v4u*)(HT + tk_o * 80 + part * 16); v4u o;
              o.x = pk2(bflo(hv.x) * bflo(garv.x), bfhi(hv.x) * bfhi(garv.x)); o.y = pk2(bflo(hv.y) * bflo(garv.y), bfhi(hv.y) * bfhi(garv.y));
              o.z = pk2(bflo(hv.z) * bflo(garv.z), bfhi(hv.z) * bfhi(garv.z)); o.w = pk2(bflo(hv.w) * bflo(garv.w), bfhi(hv.w) * bfhi(garv.w));
              *(GAS v4u*)(a.MIX + (size_t)(b * SEQ + t0 + tk_o) * D + g * 64 + hf * 32 + part * 8) = o; }
        }
        LBAR();
    }
}

struct MixArgs { const bf16 *O0, *O1, *GB; bf16* MIX; const float *lq1, *lk1, *lq2, *lk2, *subln_g; };
__device__ __forceinline__ void mix_phase(Frame& F, const MixArgs& a) {
    const int gw = F.vcu * NWAVES + F.wave, NGW = F.G * NWAVES, lane = F.lane;
    const float lam = __expf(wave_sum(a.lq1[lane] * a.lk1[lane])) - __expf(wave_sum(a.lq2[lane] * a.lk2[lane])) + 0.2f;
    float sg[16];
#pragma unroll
    for (int i = 0; i < 16; ++i) sg[i] = a.subln_g[16 * (lane & 7) + i] * 0.8f;
    for (int blk = gw; blk < T / 16; blk += NGW) {
        for (int r = 0; r < 16; ++r) {
            const size_t off = (size_t)(blk * 16 + r) * D + 16 * lane;
            v4u o0[2], o1[2], gb[2], mx[2];
#pragma unroll
            for (int q = 0; q < 2; ++q) { o0[q] = *(const GAS v4u*)(a.O0 + off + 8 * q); o1[q] = *(const GAS v4u*)(a.O1 + off + 8 * q); gb[q] = *(const GAS v4u*)(a.GB + off + 8 * q); mx[q] = *(const GAS v4u*)(a.MIX + off + 8 * q); }
            float o[16]; float ss = 0.f;
#pragma unroll
            for (int q = 0; q < 2; ++q)
#pragma unroll
                for (int k = 0; k < 4; ++k) { const float lo = bflo(o0[q][k]) - lam * bflo(o1[q][k]), hi = bfhi(o0[q][k]) - lam * bfhi(o1[q][k]); o[8 * q + 2 * k] = lo; o[8 * q + 2 * k + 1] = hi; ss += lo * lo + hi * hi; }
            ss += __shfl_xor(ss, 1); ss += __shfl_xor(ss, 2); ss += __shfl_xor(ss, 4);
            const float rstd = 1.0f / sqrtf(ss * (1.0f / 128.0f) + EPS);
            v4u out[2];
#pragma unroll
            for (int q = 0; q < 2; ++q)
#pragma unroll
                for (int k = 0; k < 4; ++k) { const int i0 = 8 * q + 2 * k;
                    const float lo = bflo(mx[q][k]) + bflo(gb[q][k]) * (o[i0] * rstd * sg[i0]), hi = bfhi(mx[q][k]) + bfhi(gb[q][k]) * (o[i0 + 1] * rstd * sg[i0 + 1]);
                    out[q][k] = pk2(lo, hi); }
#pragma unroll
            for (int q = 0; q < 2; ++q) *(GAS v4u*)(a.MIX + off + 8 * q) = out[q];
        }
    }
}

__device__ __forceinline__ void topk_phase(Frame& F, const float* logits, const float* rbias, int* tope, float* topg, int* pose, gu32* cnt) {
    LAS unsigned* hist = (LAS unsigned*)F.lds;
    LAS unsigned* baseL = hist + 256;
    LAS int* ek = (LAS int*)(hist + 512);
    LAS int* rk = ek + 1024;
    const int lane = F.lane;
    const f32x4 bias = *(const GAS f32x4*)(rbias + 4 * lane);
    for (int tb = F.vcu; tb < T / 128; tb += F.G) {
        for (int i = F.tid; i < 256; i += 512) hist[i] = 0u;
        __syncthreads();
        for (int tl = F.wave * 16; tl < F.wave * 16 + 16; ++tl) {
            const int tok = tb * 128 + tl;
            const f32x4 lg = *(const GAS f32x4*)(logits + (size_t)tok * 256 + 4 * lane);
            float s0 = sigm(lg.x), s1 = sigm(lg.y), s2 = sigm(lg.z), s3 = sigm(lg.w);
            float v0 = s0 + bias.x, v1 = s1 + bias.y, v2 = s2 + bias.z, v3 = s3 + bias.w;
            int my_e = 0; float my_s = 0.f, ssum = 0.f;
#pragma unroll
            for (int k = 0; k < 8; ++k) {
                float bv = v0; int bi = 0;
                if (v1 > bv) { bv = v1; bi = 1; } if (v2 > bv) { bv = v2; bi = 2; } if (v3 > bv) { bv = v3; bi = 3; }
                int bidx = 4 * lane + bi;
#pragma unroll
                for (int o = 32; o >= 1; o >>= 1) { const float ov = __shfl_xor(bv, o); const int oi = __shfl_xor(bidx, o); if (ov > bv || (ov == bv && oi < bidx)) { bv = ov; bidx = oi; } }
                const int own = bidx >> 2, j = bidx & 3;
                const float sj = j == 0 ? s0 : j == 1 ? s1 : j == 2 ? s2 : s3;
                const float sv = __shfl(sj, own);
                if (lane == own) { if (j == 0) v0 = -INFINITY; else if (j == 1) v1 = -INFINITY; else if (j == 2) v2 = -INFINITY; else v3 = -INFINITY; }
                ssum += sv;
                if (lane == k) { my_e = bidx; my_s = sv; }
            }
            if (lane < 8) { const float gte = my_s / ssum * 2.5f; tope[(size_t)tok * 8 + lane] = my_e; topg[(size_t)tok * 8 + lane] = gte;
                const unsigned rank = __hip_atomic_fetch_add(&hist[my_e], 1u, __ATOMIC_RELAXED, __HIP_MEMORY_SCOPE_WORKGROUP); ek[tl * 8 + lane] = my_e; rk[tl * 8 + lane] = (int)rank; }
        }
        __syncthreads();
        if (F.tid < 256) { const unsigned h = hist[F.tid]; baseL[F.tid] = h ? __hip_atomic_fetch_add(cnt + F.tid, h, RLX_AGENT) : 0u; }
        __syncthreads();
        for (int i = F.tid; i < 1024; i += 512) pose[(size_t)tb * 1024 + i] = (int)baseL[ek[i]] + rk[i];
        __syncthreads();
    }
}
__device__ __forceinline__ void scatter_phase(Frame& F, const int* tope, const float* topg, const int* pose, gu32* cnt, int* tokp, int* slotp, float* gatep, int* tiles, gu32* ntiles_w) {
    LAS int* cntL = (LAS int*)F.lds; LAS int* startL = cntL + 320;
    if (F.tid < 256) cntL[F.tid] = (int)__hip_atomic_load(cnt + F.tid, RLX_AGENT);
    __syncthreads();
    if (F.tid < 257) { int s = 0; for (int e = 0; e < F.tid; ++e) s += cntL[e]; startL[F.tid] = s; }
    __syncthreads();
    if (blockIdx.x == 0 && F.tid < 257) { const int e = F.tid; int ts = 0; for (int q = 0; q < e; ++q) ts += (cntL[q] + 255) >> 8;
        const int n = e < 256 ? cntL[e] : T, st = startL[e], nt = (n + 255) >> 8;
        for (int j = 0; j < nt; ++j) { int* tl = tiles + (size_t)(ts + j) * 4; tl[0] = e; tl[1] = st + 256 * j; tl[2] = (n - 256 * j) < 256 ? (n - 256 * j) : 256; tl[3] = 0; }
        if (e == 256) __hip_atomic_store(ntiles_w, (unsigned)(ts + nt), RLX_AGENT); }
    for (int tb = F.vcu; tb < T / 128; tb += F.G) {
        for (int i = F.tid; i < 1024; i += 512) { const size_t q = (size_t)tb * 1024 + i; const int tok = (int)(q >> 3), k = (int)(q & 7); const int p = startL[tope[q]] + pose[q];
            tokp[p] = tok; slotp[p] = tok * NSLOT + k; gatep[p] = topg[q]; }
        if (F.tid < 128) { const int tok = tb * 128 + F.tid, p = T * TOPK + tok; tokp[p] = tok; slotp[p] = tok * NSLOT + TOPK; gatep[p] = 1.0f; }
    }
    if (blockIdx.x == 0 && F.tid < 256) { tokp[NPOS + F.tid] = 0; slotp[NPOS + F.tid] = 0; gatep[NPOS + F.tid] = 0.f; }
}

template <bool GATHER> struct MoeOrder {
    const pg8::bf16_t* A; const pg8::bf16_t* Bt; int K; int rowsB;
    const LAS int* utab; const LAS int* toktab; int nun;
    __device__ __forceinline__ bool next(int i, pg8::Unit& u) const {
        if (i >= nun) return false;
        u.e = __builtin_amdgcn_readfirstlane(utab[4 * i]); u.row0 = __builtin_amdgcn_readfirstlane(utab[4 * i + 1]); u.nrows = __builtin_amdgcn_readfirstlane(utab[4 * i + 2]); u.pn = __builtin_amdgcn_readfirstlane(utab[4 * i + 3]); u.pm = 0; return true; }
    __device__ __forceinline__ const char* a_base(const pg8::Unit& u) const { return GATHER ? (const char*)A : (const char*)A + (size_t)u.row0 * K * 2; }
    __device__ __forceinline__ const char* b_base(const pg8::Unit& u) const { return (const char*)Bt + ((size_t)u.e * rowsB + (size_t)u.pn * 256) * K * 2; }
    __device__ __forceinline__ void a_voff(const pg8::Unit&, int ui, const int (&R)[2], const int (&C)[2], unsigned (&v)[2][2]) const {
#pragma unroll
        for (int h = 0; h < 2; ++h)
#pragma unroll
            for (int i = 0; i < 2; ++i) v[h][i] = GATHER ? (unsigned)toktab[ui * 256 + h * 128 + R[i]] * (unsigned)(K * 2) + (unsigned)(C[i] * 2) : (unsigned)((h * 128 + R[i]) * K + C[i]) * 2u;
    }
    __device__ __forceinline__ void a_ready(const pg8::Unit&) const {}
    __device__ __forceinline__ void done(const pg8::Unit&) const {}
};
template <bool GATHER> __device__ __forceinline__ int moe_tables(Frame& F, const int* tiles, gu32* ntiles_w, const int* tokp, int shift) {
    LAS int* utab = (LAS int*)(F.lds + UT_OFF); LAS int* toktab = (LAS int*)(F.lds + TOK_OFF);
    const int total = (int)__builtin_amdgcn_readfirstlane(__hip_atomic_load(ntiles_w, RLX_AGENT)) << shift;
    int nun = total > F.vcu ? (total - F.vcu + F.G - 1) / F.G : 0;
    const int cap = GATHER ? MAXU_TOK : MAXU; if (nun > cap) nun = cap;
    __syncthreads();
    if (F.tid < nun) { const int Lu = F.tid * F.G + F.vcu, t = Lu >> shift; const GAS int* tl = (const GAS int*)tiles + (size_t)t * 4;
        utab[4 * F.tid] = tl[0]; utab[4 * F.tid + 1] = tl[1]; utab[4 * F.tid + 2] = tl[2]; utab[4 * F.tid + 3] = Lu & ((1 << shift) - 1); }
    __syncthreads();
    if (GATHER) { for (int idx = F.tid; idx < nun * 256; idx += 512) { const int i = idx >> 8, r = idx & 255, row0 = utab[4 * i + 1], nr = utab[4 * i + 2]; toktab[idx] = ((const GAS int*)tokp)[row0 + (r < nr ? r : nr - 1)]; }
        __syncthreads(); }
    return nun;
}

__device__ __forceinline__ void combine_phase(Frame& F, const bf16* ys, const float* mod, float* out) {
    const int gw = F.vcu * NWAVES + F.wave, NGW = F.G * NWAVES, lane = F.lane;
    for (int blk = gw; blk < T / 16; blk += NGW) {
        const int b = (blk * 16) >> 12; const float* gp = mod + (size_t)b * 6144 + 5120;
        f32x4 g2[2][2];
#pragma unroll
        for (int j = 0; j < 2; ++j)
#pragma unroll
            for (int q = 0; q < 2; ++q) g2[j][q] = *(const GAS f32x4*)(gp + 512 * j + 8 * lane + 4 * q);
        for (int r = 0; r < 16; ++r) { const int tok = blk * 16 + r;
            float acc[2][8];
#pragma unroll
            for (int j = 0; j < 2; ++j)
#pragma unroll
                for (int i = 0; i < 8; ++i) acc[j][i] = 0.f;
#pragma unroll
            for (int s = 0; s < NSLOT; ++s)
#pragma unroll
                for (int j = 0; j < 2; ++j) { const v4u v = *(const GAS v4u*)(ys + ((size_t)tok * NSLOT + s) * D + 512 * j + 8 * lane);
#pragma unroll
                    for (int k = 0; k < 4; ++k) { acc[j][2 * k] += bflo(v[k]); acc[j][2 * k + 1] += bfhi(v[k]); } }
            float* orow = out + (size_t)tok * D;
#pragma unroll
            for (int j = 0; j < 2; ++j)
#pragma unroll
                for (int q = 0; q < 2; ++q) { GAS f32x4* p = (GAS f32x4*)(orow + 512 * j + 8 * lane + 4 * q); const f32x4 x1 = *p;
                    const f32x4 av = {acc[j][4 * q], acc[j][4 * q + 1], acc[j][4 * q + 2], acc[j][4 * q + 3]}; *p = x1 + g2[j][q] * av; }
        }
    }
}
#ifndef MK_N_LAUNCHES
#define MK_N_LAUNCHES 1
#endif
constexpr int NPH = 14;
constexpr int N_LAUNCHES = MK_N_LAUNCHES;
struct Args { const void* in[31]; float* out; unsigned char* ws; int ph_lo, ph_hi; };
__global__ void __launch_bounds__(NWAVES * 64, 2) fwd_kernel(Args args) {
    extern __shared__ __attribute__((aligned(16))) unsigned char lds[];
    Frame F;
    F.lds = (LAS unsigned char*)lds;
    F.MISC = (volatile LAS unsigned*)(F.lds + MISC_OFF);
    F.tid = threadIdx.x; F.lane = F.tid & 63; F.wave = __builtin_amdgcn_readfirstlane(F.tid >> 6);
    F.G = gridDim.x; { const int bx = blockIdx.x; F.vcu = (F.G % 8 == 0) ? (bx % 8) * (F.G / 8) + bx / 8 : bx; }
    unsigned char* ws = args.ws;
    F.ctl = (gu32*)(ws + WS_CTL);
    for (int u = F.tid; u < (LDS_BYTES - LDSCTL_OFF) / 4; u += NWAVES * 64) ((LAS unsigned*)(F.lds + LDSCTL_OFF))[u] = 0u;
    __syncthreads();
    XcdBarrier bar; bar.bar = (unsigned*)(F.ctl + CW_BAR); bar.x = 0; bar.st = nullptr;
    if (N_LAUNCHES == 1) bar = xcd_barrier_post((unsigned*)(F.ctl + CW_BAR), F.MISC + 8);
#define GRID_BAR() do { if (N_LAUNCHES == 1) { xcd_barrier(bar); } } while (0)
    const int lo = args.ph_lo, hi = args.ph_hi;
#ifndef PHMASK
#define PHMASK 0xFFFF
#endif
#define IN(k) (((PHMASK >> (k)) & 1) && lo <= (k) && (k) < hi)
#define BOTH(k) (IN(k) && IN((k) + 1))
    const float* x = (const float*)args.in[0];
    float* out = args.out;
    float* mod = (float*)(ws + WS_MOD);
    bf16* Hb = (bf16*)out;
    bf16* O0 = (bf16*)out; bf16* O1 = (bf16*)out + (size_t)T * D;
    bf16 *XR = (bf16*)(ws + WS_XR), *GAR = (bf16*)(ws + WS_GAR), *Qb = (bf16*)(ws + WS_Q), *Kb = (bf16*)(ws + WS_K), *Vb = (bf16*)(ws + WS_V), *GB = (bf16*)(ws + WS_GB), *MIX = (bf16*)(ws + WS_MIX);
    bf16 *H2 = (bf16*)(ws + WS_H2), *ACT = (bf16*)(ws + WS_ACT), *YS = (bf16*)(ws + WS_YS);
    float* LOGIT = (float*)(ws + WS_LOGIT);
    int *TOPE = (int*)(ws + WS_TOPE), *POSE = (int*)(ws + WS_POSE), *TOKP = (int*)(ws + WS_TOKP), *SLOTP = (int*)(ws + WS_SLOTP), *TILES = (int*)(ws + WS_TILES);
    float *TOPG = (float*)(ws + WS_TOPG), *GATEP = (float*)(ws + WS_GATEP);

    if (IN(0)) {
        P0Args a{(const float*)args.in[1], (const float*)args.in[3], (const float*)args.in[4], (const float*)args.in[6], (const float*)args.in[21], (const float*)args.in[23],
                 (const float*)args.in[25], (const float*)args.in[26], (const float*)args.in[27], (const float*)args.in[28], (const float*)args.in[29], (const float*)args.in[30],
                 (const float*)args.in[9], (const float*)args.in[11], (const float*)args.in[13], (const int*)args.in[2]};
        p0_prologue(F, a, ws);
        if (BOTH(0)) GRID_BAR();
    }
    if (IN(1)) { norm_mod_phase(F, x, (const float*)args.in[5], mod, 0, 1024, Hb); if (BOTH(1)) GRID_BAR(); }
    if (IN(2)) {
        pg8::DenseOrder S; S.init(Hb, (const pg8::bf16_t*)(ws + WS_WIN), T, INW, D, F.G, (int)blockIdx.x);
        epi::EpiInProj E{XR, GAR, Qb, Kb, Vb, GB, (const float*)args.in[14], (const float*)args.in[15], (const float*)(ws + WS_CST), 0.125f * 1.4426950408889634f};
        pg8::gemm_phase<epi::EpiInProj, pg8::DenseOrder, true>(F.lds + RING_OFF, D, S, E);
        if (BOTH(2)) GRID_BAR();
    }
    if (IN(3)) {
        LruArgs a{XR, GAR, MIX, (const bf16*)(ws + WS_WLRU), (const float*)args.in[7], (const float*)args.in[8], (const float*)args.in[10], (const float*)args.in[12], (const float*)(ws + WS_C8SP)};
        lru_phase(F, a);
    }
    if (IN(4)) {
        const attn_body::AttnTensors AT{(const attn_body::bf16*)Qb, (const attn_body::bf16*)Kb, (const attn_body::bf16*)Vb, (attn_body::bf16*)O0, (attn_body::bf16*)O1};
        const attn_body::PairOrder S((int)F.G, F.vcu);
        attn_body::attn_phase<attn_body::PairOrder>((char*)lds + RING_OFF, AT, S);
        if (BOTH(4)) GRID_BAR();
    }
    if (IN(5)) {
        MixArgs a{O0, O1, GB, MIX, (const float*)args.in[16], (const float*)args.in[17], (const float*)args.in[18], (const float*)args.in[19], (const float*)args.in[20]};
        mix_phase(F, a);
        if (BOTH(5)) GRID_BAR();
    }
    if (IN(6)) {
        pg8::DenseOrder S; S.init(MIX, (const pg8::bf16_t*)(ws + WS_WO), T, D, D, F.G, (int)blockIdx.x);
        epi::EpiWo E{x, out, mod + 2048};
        pg8::gemm_phase<epi::EpiWo, pg8::DenseOrder, true>(F.lds + RING_OFF, D, S, E);
        if (BOTH(6)) GRID_BAR();
    }
    if (IN(7)) { norm_mod_phase(F, out, (const float*)args.in[22], mod, 3072, 4096, H2); if (BOTH(7)) GRID_BAR(); }
    if (IN(8)) {
        pg8::DenseOrder S; S.init(H2, (const pg8::bf16_t*)(ws + WS_WR), T, NEXP, D, F.G, (int)blockIdx.x);
        epi::EpiF32 E{LOGIT};
        pg8::gemm_phase<epi::EpiF32, pg8::DenseOrder, false>(F.lds + RING_OFF, D, S, E);
        if (BOTH(8)) GRID_BAR();
    }
    if (IN(9)) { topk_phase(F, LOGIT, (const float*)args.in[24], TOPE, TOPG, POSE, F.ctl + CW_CNT); if (BOTH(9)) GRID_BAR(); }
    if (IN(10)) { scatter_phase(F, TOPE, TOPG, POSE, F.ctl + CW_CNT, TOKP, SLOTP, GATEP, TILES, F.ctl + CW_NTILES); if (BOTH(10)) GRID_BAR(); }
    if (IN(11)) {
        const int nun = moe_tables<true>(F, TILES, F.ctl + CW_NTILES, TOKP, 1);
        MoeOrder<true> S{H2, (const pg8::bf16_t*)(ws + WS_WEGU), D, 512, (const LAS int*)(F.lds + UT_OFF), (const LAS int*)(F.lds + TOK_OFF), nun};
        epi::EpiGateUp E{ACT};
        pg8::gemm_phase<epi::EpiGateUp, MoeOrder<true>, true>(F.lds + RING_OFF, D, S, E);
        if (BOTH(11)) GRID_BAR();
    }
    if (IN(12)) {
        const int nun = moe_tables<false>(F, TILES, F.ctl + CW_NTILES, TOKP, 2);
        MoeOrder<false> S{ACT, (const pg8::bf16_t*)(ws + WS_WED), DEXP, 1024, (const LAS int*)(F.lds + UT_OFF), (const LAS int*)(F.lds + TOK_OFF), nun};
        epi::EpiDown E{YS, SLOTP, GATEP};
        pg8::gemm_phase<epi::EpiDown, MoeOrder<false>, true>(F.lds + RING_OFF, DEXP, S, E);
        if (BOTH(12)) GRID_BAR();
    }
    if (IN(13)) { combine_phase(F, YS, mod, out); }
#undef IN
#undef BOTH
}

extern "C" void kernel_launch(void* const* d_in, const int* in_sizes, int n_in, void* d_out, int out_size, void* d_ws, size_t ws_size, hipStream_t stream) {
    static int grid = 0;
    if (grid == 0) {
        if (n_in != 31 || in_sizes[0] != T * D || out_size != T * D || ws_size < WS_END) { fprintf(stderr, "kernel_launch: unexpected shapes: n_in %d in0 %d out %d ws %zu (need %zu); nothing launched\n", n_in, n_in > 0 ? in_sizes[0] : -1, out_size, ws_size, (size_t)WS_END); grid = -1; return; }
        int dev = 0, cus = 0, per_cu = 0;
        if (hipGetDevice(&dev) != hipSuccess || hipDeviceGetAttribute(&cus, hipDeviceAttributeMultiprocessorCount, dev) != hipSuccess) { fprintf(stderr, "kernel_launch: device query failed\n"); grid = -1; return; }
        if (hipFuncSetAttribute((const void*)fwd_kernel, hipFuncAttributeMaxDynamicSharedMemorySize, LDS_BYTES) != hipSuccess) { fprintf(stderr, "kernel_launch: hipFuncSetAttribute failed\n"); grid = -1; return; }
        if (hipOccupancyMaxActiveBlocksPerMultiprocessor(&per_cu, (const void*)fwd_kernel, NWAVES * 64, LDS_BYTES) != hipSuccess || per_cu < 1)
            fprintf(stderr, "kernel_launch: note: occupancy query reports %d workgroups per CU\n", per_cu);
        (void)hipGetLastError();
        grid = cus;
    }
    if (grid < 0) return;
    if (hipMemsetAsync((char*)d_ws + WS_CTL, 0, CTL_ZERO_BYTES, stream) != hipSuccess) { fprintf(stderr, "kernel_launch: hipMemsetAsync failed\n"); return; }
    Args a{};
    for (int i = 0; i < 31; ++i) a.in[i] = d_in[i];
    a.out = (float*)d_out; a.ws = (unsigned char*)d_ws;
    for (int li = 0; li < N_LAUNCHES; ++li) {
        a.ph_lo = (N_LAUNCHES == 1) ? 0 : li; a.ph_hi = (N_LAUNCHES == 1) ? NPH : li + 1;
        hipLaunchKernelGGL(fwd_kernel, dim3(grid), dim3(NWAVES * 64), LDS_BYTES, stream, a);
        const hipError_t le = hipPeekAtLastError();
        if (le != hipSuccess) { fprintf(stderr, "kernel_launch: launch %d failed: %s\n", li, hipGetErrorName(le)); break; }
    }
}
```

```cpp
#define REPMASK 0
#include <hip/hip_runtime.h>
#include <hip/hip_bf16.h>
#include <cstdio>
#include <cstdint>
#include <cmath>
namespace pg8 {
#define PG8_LAS __attribute__((address_space(3)))
typedef unsigned short bf16_t;
typedef short bf16x8 __attribute__((ext_vector_type(8)));
typedef float f32x4 __attribute__((ext_vector_type(4)));
typedef float f32x2 __attribute__((ext_vector_type(2)));
typedef unsigned u32x4 __attribute__((ext_vector_type(4)));
typedef int v4i32_t __attribute__((ext_vector_type(4)));
typedef int v8i32_t __attribute__((ext_vector_type(8)));
constexpr int BM = 256, BK = 64, HALF = 128, HTB = HALF * BK * 2  , STAGE_BYTES = 8 * HTB, NXCD = 8, WGM = 8;

__host__ __device__ __forceinline__ int lds_byte(int r, int c) { const int st = (r >> 4) * 2 + (c >> 5), rr = r & 15, cc = c & 31, ob = rr * 64 + cc * 2; return st * 1024 + (ob ^ (((ob >> 9) & 1) << 5)); }
__host__ __device__ __forceinline__ void stage_rc(int b, int& R, int& C) { const int st = b / 1024, sb = b % 1024, swz = sb ^ (((sb >> 9) & 1) << 5); R = (st >> 1) * 16 + swz / 64; C = (st & 1) * 32 + (swz % 64) / 2; }
__host__ __device__ __forceinline__ int perm32(int rho) { const int n = rho >> 4, i = rho & 15; return 8 * (i >> 2) + 4 * n + (i & 3); }

__host__ __device__ __forceinline__ int perm64(int R) { const int w = R >> 5, n = (R >> 4) & 1, i = R & 15; return 64 * w + 16 * (i >> 2) + 4 * n + (i & 3); }
struct Unit { int pm, pn, row0, nrows, e; };

__device__ __forceinline__ unsigned cvt_pk_bf16(float lo, float hi) { unsigned r; asm volatile("v_cvt_pk_bf16_f32 %0, %1, %2" : "=v"(r) : "v"(lo), "v"(hi)); return r; }
__device__ __forceinline__ float sigmoidf_fast(float v) { return __builtin_amdgcn_rcpf(1.0f + __builtin_amdgcn_exp2f(-1.4426950408889634f * v)); }

struct DenseOrder {
    const void* A; const void* Bt; int Kb;
    int nM, nN, nwg, G, c, nmine, reps;
    __device__ __forceinline__ void init(const void* A_, const void* Bt_, int M, int N, int Kb_, int G_, int c_, int reps_ = 1) { A = A_; Bt = Bt_; Kb = Kb_; nM = M / BM; nN = N / BM; nwg = nM * nN; G = G_; c = c_; nmine = nwg > c ? (nwg - c + G - 1) / G : 0; reps = reps_; }
    __device__ __forceinline__ bool next(int i, Unit& u) const {
        if (i >= nmine * reps) return false; const long L = (long)(i % nmine) * G + c;
        int wgid = (int)L; { const int q = nwg / NXCD, r = nwg % NXCD, xcd = wgid % NXCD, off = wgid / NXCD; wgid = (xcd < r ? xcd * (q + 1) : r * (q + 1) + (xcd - r) * q) + off; }
        const int nig = WGM * nN, gid = wgid / nig, fm = gid * WGM, gsz = (nM - fm) < WGM ? (nM - fm) : WGM;
        u.pm = fm + ((wgid % nig) % gsz); u.pn = (wgid % nig) / gsz; u.row0 = u.pm * BM; u.nrows = BM; u.e = 0; return true;
    }
    __device__ __forceinline__ const char* a_base(const Unit& u) const { return (const char*)A + (size_t)u.pm * BM * Kb; }
    __device__ __forceinline__ const char* b_base(const Unit& u) const { return (const char*)Bt + (size_t)u.pn * BM * Kb; }
    __device__ __forceinline__ void a_voff(const Unit&, int, const int (&R)[2], const int (&C)[2], unsigned (&v)[2][2]) const {
#pragma unroll
        for (int h = 0; h < 2; ++h)
#pragma unroll
            for (int i = 0; i < 2; ++i) v[h][i] = (unsigned)((h * HALF + R[i]) * Kb + C[i] * 2);
    }
    __device__ __forceinline__ void a_ready(const Unit&) const {}
    __device__ __forceinline__ void done(const Unit&) const {}
};

#if defined(PROBE_REGION)
#define PRB_T0(R) unsigned long long prb_t0_##R = 0; if (PROBE_REGION == R && prb) prb_t0_##R = __builtin_amdgcn_s_memrealtime()
#define PRB_T1(R) do { if (PROBE_REGION == R && prb) *prb += __builtin_amdgcn_s_memrealtime() - prb_t0_##R; } while (0)
#else
#define PRB_T0(R) do {} while (0)
#define PRB_T1(R) do {} while (0)
#endif
template <class E, class = void> struct epi_nst { static constexpr int maxv = 0; static __device__ __forceinline__ int get(const E&, const Unit&) { return 0; } };
template <class E> struct epi_nst<E, decltype((void)E::NSTMAX)> { static constexpr int maxv = E::NSTMAX; static __device__ __forceinline__ int get(const E& e, const Unit& u) { return e.nst(u); } };
template <int N> __device__ __forceinline__ void wait_vm() { asm volatile("s_waitcnt vmcnt(%0)" :: "n"(N) : "memory"); }
template <class Epi, class Sched, bool ALIGN_EPI, bool FP8 = false>
__device__ __forceinline__ void gemm_phase(PG8_LAS unsigned char* lds, const int Kb, const Sched& S, const Epi& E, volatile PG8_LAS unsigned long long* prb = nullptr) {
    const int tid = threadIdx.x, wid = __builtin_amdgcn_readfirstlane(tid >> 6), lane = tid & 63, wr = wid >> 2, wc = wid & 3, fr = lane & 15, fq = lane >> 4;
    const int nt = Kb / 128;
    constexpr int NSTMAX = epi_nst<Epi>::maxv; int pnst = 0;
    int Rs[2], Cs[2]; unsigned voffB[2];
#pragma unroll
    for (int i = 0; i < 2; ++i) { stage_rc(tid * 16 + i * 8192, Rs[i], Cs[i]); const int Rb = (int)Epi::PERM == 2 ? perm64(Rs[i]) : Epi::PERM ? ((Rs[i] & ~31) + perm32(Rs[i] & 31)) : Rs[i];
        voffB[i] = (unsigned)(Rb * Kb + Cs[i] * 2); }
    const size_t kstep = (size_t)(BK * 2);
    const size_t hstep = (size_t)((int)Epi::PERM == 2 ? 8 : HALF) * Kb;
    const unsigned ldsw = (unsigned)wid * 1024u;
    const int aoff = FP8 ? lds_byte(wr * 64 + fr, fq * 16) : lds_byte(wr * 64 + fr, fq * 8), boff = FP8 ? lds_byte(wc * 32 + fr, fq * 16) : lds_byte(wc * 32 + fr, fq * 8);
#define PG8_SA(b, h) (((b) * 2 + (h)) * HTB)
#define PG8_SB(b, h) ((4 + (b) * 2 + (h)) * HTB)
#define PG8_STAGE(bufoff, gbase, voff) do { _Pragma("unroll") for (int _i = 0; _i < 2; ++_i) \
        __builtin_amdgcn_global_load_lds((const unsigned*)((const char*)(gbase) + (voff)[_i]), (PG8_LAS unsigned*)(lds + (bufoff) + ldsw + _i * 8192), 16, 0, 0); } while (0)
#define PG8_LDA(dst, b, h) do { _Pragma("unroll") for (int m = 0; m < 4; ++m) _Pragma("unroll") for (int k = 0; k < 2; ++k) dst[m][k] = *(const PG8_LAS bf16x8*)(lds + PG8_SA(b, h) + aoff + m * 2048 + k * (FP8 ? 16 : 1024)); } while (0)
#define PG8_LDB(dst, b, h) do { _Pragma("unroll") for (int n = 0; n < 2; ++n) _Pragma("unroll") for (int k = 0; k < 2; ++k) dst[n][k] = *(const PG8_LAS bf16x8*)(lds + PG8_SB(b, h) + boff + n * 2048 + k * (FP8 ? 16 : 1024)); } while (0)
#define PG8_F8(x) __builtin_shufflevector(__builtin_bit_cast(v4i32_t, x[0]), __builtin_bit_cast(v4i32_t, x[1]), 0, 1, 2, 3, 4, 5, 6, 7)
#define PG8_MFMA8(ACC, A8, B8) asm volatile("v_mfma_f32_16x16x128_f8f6f4 %0, %1, %2, %0" : "+v"(ACC) : "v"(A8), "v"(B8))
#define PG8_MMA(ai, bj, At, Bt) do { __builtin_amdgcn_s_setprio(1); if constexpr (FP8) { _Pragma("unroll") for (int n = 0; n < 2; ++n) { const v8i32_t b8 = PG8_F8(Bt[n]); _Pragma("unroll") for (int m = 0; m < 4; ++m) { const v8i32_t a8 = PG8_F8(At[m]); PG8_MFMA8(acc[ai][bj][m][n], b8, a8); } } } else { \
        _Pragma("unroll") for (int m = 0; m < 4; ++m) _Pragma("unroll") for (int n = 0; n < 2; ++n) _Pragma("unroll") for (int k = 0; k < 2; ++k) \
        acc[ai][bj][m][n] = __builtin_amdgcn_mfma_f32_16x16x32_bf16(Bt[n][k], At[m][k], acc[ai][bj][m][n], 0, 0, 0); } __builtin_amdgcn_s_setprio(0); } while (0)
#define PG8_MFMA8Z(ACC, A8, B8) asm volatile("v_mfma_f32_16x16x128_f8f6f4 %0, %1, %2, 0" : "=&v"(ACC) : "v"(A8), "v"(B8))
#define PG8_MMA0(ai, bj, At, Bt) do { __builtin_amdgcn_s_setprio(1); if constexpr (FP8) { _Pragma("unroll") for (int n = 0; n < 2; ++n) { const v8i32_t b8 = PG8_F8(Bt[n]); _Pragma("unroll") for (int m = 0; m < 4; ++m) { const v8i32_t a8 = PG8_F8(At[m]); PG8_MFMA8Z(acc[ai][bj][m][n], b8, a8); } } } else { \
        _Pragma("unroll") for (int m = 0; m < 4; ++m) _Pragma("unroll") for (int n = 0; n < 2; ++n) { \
        acc[ai][bj][m][n] = __builtin_amdgcn_mfma_f32_16x16x32_bf16(Bt[n][0], At[m][0], (f32x4){0.f, 0.f, 0.f, 0.f}, 0, 0, 0); acc[ai][bj][m][n] = __builtin_amdgcn_mfma_f32_16x16x32_bf16(Bt[n][1], At[m][1], acc[ai][bj][m][n], 0, 0, 0); } } __builtin_amdgcn_s_setprio(0); } while (0)
#define PG8_MFMA_DRAIN do { if constexpr (FP8) { asm volatile("s_nop 15\n\ts_nop 15" ::: "memory"); __builtin_amdgcn_sched_barrier(0); } } while (0)
#define PG8_WAIT_V(n) asm volatile("s_waitcnt vmcnt(" #n ")" ::: "memory")
#define PG8_WAIT_L(n) asm volatile("s_waitcnt lgkmcnt(" #n ")" ::: "memory")
#define PG8_BAR __builtin_amdgcn_s_barrier()
#define PG8_SCHED __builtin_amdgcn_sched_barrier(0)
    Unit cur, nxt; int ui = 0;
    if (!S.next(0, cur)) return;
    f32x4 acc[2][2][4][2];
#pragma unroll
    for (int a = 0; a < 2; ++a)
#pragma unroll
        for (int b = 0; b < 2; ++b)
#pragma unroll
            for (int m = 0; m < 4; ++m)
#pragma unroll
                for (int n = 0; n < 2; ++n) acc[a][b][m][n] = (f32x4){0.f, 0.f, 0.f, 0.f};
    bf16x8 At[4][2], B0[2][2], B1[2][2];
    int sc127 = 0x7F7F7F7F; asm volatile("" : "+v"(sc127));
    unsigned vA[2][2], vN[2][2];
    S.a_voff(cur, 0, Rs, Cs, vA);
    const char* cA = S.a_base(cur); const char* cB = S.b_base(cur);
    typename Epi::Pre pre; E.prefetch(cur, wr, fr, pre);
    S.a_ready(cur);
    PG8_STAGE(PG8_SB(0, 0), cB, voffB); PG8_STAGE(PG8_SB(0, 1), cB + hstep, voffB); PG8_STAGE(PG8_SA(0, 0), cA, vA[0]); PG8_STAGE(PG8_SA(0, 1), cA, vA[1]);
    if (wr == 1) PG8_BAR;
    PG8_WAIT_V(2); PG8_BAR;
    PG8_STAGE(PG8_SB(1, 0), cB + kstep, voffB); PG8_STAGE(PG8_SA(1, 0), cA + kstep, vA[0]); PG8_STAGE(PG8_SB(1, 1), cB + hstep + kstep, voffB); PG8_STAGE(PG8_SA(1, 1), cA + kstep, vA[1]);
    PG8_WAIT_V(8); PG8_BAR;
    for (;;) {
        const bool has_next = S.next(ui + 1, nxt);
        const char* nA = cA; const char* nB = cB;
#pragma unroll
        for (int h = 0; h < 2; ++h)
#pragma unroll
            for (int i = 0; i < 2; ++i) vN[h][i] = vA[h][i];
        if (has_next) { nA = S.a_base(nxt); nB = S.b_base(nxt); S.a_voff(nxt, ui + 1, Rs, Cs, vN); }
        PRB_T0(3);
#pragma unroll 1
        for (int t = 0; t < nt; t += 2) {
            const bool last = (t == nt - 2);
            const int rl = (NSTMAX > 0 && t == 0) ? pnst : 0;
#define PG8_WAIT_R(B) do { if (NSTMAX >= 16 && rl == 16) wait_vm<(B) + 16>(); else if (NSTMAX >= 8 && rl >= 8) wait_vm<(B) + 8>(); else PG8_WAIT_V(8); } while (0)
            const char* a1 = cA + (size_t)(t + 1) * kstep;
            const char* a2 = last ? nA : cA + (size_t)(t + 2) * kstep; const char* b2 = last ? nB : cB + (size_t)(t + 2) * kstep;
            const char* a3 = a2 + kstep; const char* b3 = b2 + kstep;
            unsigned v2[2][2];
#pragma unroll
            for (int h = 0; h < 2; ++h)
#pragma unroll
                for (int i = 0; i < 2; ++i) v2[h][i] = last ? vN[h][i] : vA[h][i];
            if (last && has_next) S.a_ready(nxt);
            PG8_LDB(B0, 0, 0); PG8_LDB(B1, 0, 1); PG8_SCHED; PG8_LDA(At, 0, 0); if (t > 0) { PG8_STAGE(PG8_SA(1, 1), a1, vA[1]); }
            PRB_T0(2); PG8_WAIT_R(10); PG8_WAIT_L(0); PG8_BAR; if (t == 0) PRB_T1(2); if (t == 0) { PG8_MMA0(0, 0, At, B0); PG8_MMA0(0, 1, At, B1); } else { PG8_MMA(0, 0, At, B0); PG8_MMA(0, 1, At, B1); } PG8_BAR; PG8_SCHED;
            PG8_LDA(At, 0, 1); PG8_STAGE(PG8_SB(0, 0), b2, voffB); PG8_STAGE(PG8_SB(0, 1), b2 + hstep, voffB); PG8_STAGE(PG8_SA(0, 0), a2, v2[0]);
            PG8_WAIT_R(14); PG8_WAIT_L(0); PG8_BAR; if (t == 0) { PG8_MMA0(1, 0, At, B0); PG8_MMA0(1, 1, At, B1); } else { PG8_MMA(1, 0, At, B0); PG8_MMA(1, 1, At, B1); } PG8_BAR; PG8_SCHED;
            PG8_LDB(B0, 1, 0); PG8_LDB(B1, 1, 1); PG8_SCHED; PG8_LDA(At, 1, 0); PG8_STAGE(PG8_SA(0, 1), a2, v2[1]);
            PG8_WAIT_R(10); PG8_WAIT_L(0); PG8_BAR; PG8_MMA(0, 0, At, B0); PG8_MMA(0, 1, At, B1); PG8_BAR; PG8_SCHED;
            PG8_LDA(At, 1, 1); PG8_STAGE(PG8_SB(1, 0), b3, voffB); PG8_STAGE(PG8_SB(1, 1), b3 + hstep, voffB); PG8_STAGE(PG8_SA(1, 0), a3, v2[0]);
            PG8_WAIT_R(14); PG8_WAIT_L(0); PG8_BAR; PG8_MMA(1, 0, At, B0); PG8_MMA(1, 1, At, B1); PG8_BAR; PG8_SCHED;
        }
        PG8_STAGE(PG8_SA(1, 1), nA + kstep, vN[1]);
        PRB_T1(3); PRB_T0(1);
        if constexpr (ALIGN_EPI) { if (wr == 0) PG8_BAR; }
        PG8_MFMA_DRAIN; E(acc, cur, wr, wc, fr, fq, pre); S.done(cur); pnst = epi_nst<Epi>::get(E, cur);
        if (!has_next) break;
        cur = nxt; cA = nA; cB = nB; ++ui; E.prefetch(cur, wr, fr, pre);
#pragma unroll
        for (int h = 0; h < 2; ++h)
#pragma unroll
            for (int i = 0; i < 2; ++i) vA[h][i] = vN[h][i];
        if constexpr (ALIGN_EPI) { if (wr == 1) PG8_BAR; }
        PRB_T1(1);
    }
    PG8_WAIT_V(0);
    if constexpr (!ALIGN_EPI) { if (wr == 0) PG8_BAR; }
    PG8_BAR;
#undef PG8_SA
#undef PG8_SB
#undef PG8_STAGE
#undef PG8_LDA
#undef PG8_LDB
#undef PG8_MMA
#undef PG8_F8
#undef PG8_MFMA8
#undef PG8_MFMA8Z
#undef PG8_MMA0
#undef PG8_MFMA_DRAIN
#undef PG8_WAIT_V
#undef PG8_WAIT_R
#undef PG8_WAIT_L
#undef PG8_BAR
#undef PG8_SCHED
}
}
namespace epi {
using pg8::f32x4; using pg8::f32x2; using pg8::u32x4; using pg8::Unit; using pg8::bf16_t; using pg8::cvt_pk_bf16; using pg8::sigmoidf_fast;
constexpr int HALF = 128;
__device__ __forceinline__ float gelu_tanh(float x) { const float z = 1.5957691216057308f * (x + 0.044715f * x * x * x); return x * sigmoidf_fast(z); }
__device__ __forceinline__ float clampf8(float v) { return __builtin_amdgcn_fmed3f(v, -448.0f, 448.0f); }
__device__ __forceinline__ unsigned pk4f8(const f32x4 a) { unsigned w = 0u; w = __builtin_amdgcn_cvt_pk_fp8_f32(clampf8(a[0]), clampf8(a[1]), w, false); w = __builtin_amdgcn_cvt_pk_fp8_f32(clampf8(a[2]), clampf8(a[3]), w, true); return w; }
__device__ __forceinline__ u32x4 pack8(const f32x4 a, const f32x4 b) { u32x4 w; w.x = cvt_pk_bf16(a[0], a[1]); w.y = cvt_pk_bf16(a[2], a[3]); w.z = cvt_pk_bf16(b[0], b[1]); w.w = cvt_pk_bf16(b[2], b[3]); return w; }

struct EpiInProj {
    static constexpr bool PERM = true;
    static constexpr int NSTMAX = 16; __device__ __forceinline__ int nst(const Unit& u) const { return (u.pn >= 4 && u.pn < 12) ? 8 : 16; }
    struct Pre {}; __device__ __forceinline__ void prefetch(const Unit&, int, int, Pre&) const {}
    bf16_t *XR, *GAR, *Q, *Kb, *V, *GB; const float* qg; const float* kg; const float* cstab; float c2; float inv;
    __device__ __forceinline__ void operator()(const f32x4 (&acc)[2][2][4][2], const Unit& u, int wr, int wc, int fr, int fq, const Pre& pre) const {
        const int pn = u.pn; const int rowb = u.pm * 256 + wr * 64 + fr;
        if (pn < 4 || (pn >= 20 && pn < 24) || pn >= 24) {
            bf16_t* base; int colt; const bool sig = false;
            if (pn < 4) { base = XR; colt = pn * 256; } else if (pn < 24) { base = V; colt = (pn - 20) * 256; } else { base = GB; colt = (pn - 24) * 256; }
            const int col0 = colt + wc * 32 + 8 * fq;
#pragma unroll
            for (int ai = 0; ai < 2; ++ai)
#pragma unroll
                for (int m = 0; m < 4; ++m) { bf16_t* rowp = base + (size_t)(rowb + ai * HALF + m * 16) * 1024 + col0;
#pragma unroll
                    for (int bj = 0; bj < 2; ++bj) { f32x4 v0 = acc[ai][bj][m][0] * inv, v1 = acc[ai][bj][m][1] * inv;
                        if (sig) {
#pragma unroll
                            for (int i = 0; i < 4; ++i) { v0[i] = sigmoidf_fast(v0[i]); v1[i] = sigmoidf_fast(v1[i]); } }
                        *(u32x4*)(rowp + bj * HALF) = pack8(v0, v1); } }
        } else if (pn < 12) {
            const int col0 = (pn - 4) * 128 + wc * 32 + 8 * fq;
#pragma unroll
            for (int ai = 0; ai < 2; ++ai)
#pragma unroll
                for (int m = 0; m < 4; ++m) { f32x4 o[2];
#pragma unroll
                    for (int n = 0; n < 2; ++n)
#pragma unroll
                        for (int i = 0; i < 4; ++i) { const float x = acc[ai][0][m][n][i] * inv, y = acc[ai][1][m][n][i] * inv, z = 1.5957691216057308f * (x + 0.044715f * x * x * x);
                            o[n][i] = x * __builtin_amdgcn_rcpf((1.0f + __builtin_amdgcn_exp2f(-1.4426950408889634f * z)) * (1.0f + __builtin_amdgcn_exp2f(-1.4426950408889634f * y))); }
                    *(u32x4*)(GAR + (size_t)(rowb + ai * HALF + m * 16) * 1024 + col0) = pack8(o[0], o[1]); }
        } else {
            const bool isq = pn < 16; const int j = isq ? pn - 12 : pn - 16; bf16_t* base = isq ? Q : Kb; const float* gg = isq ? qg : kg; const float sc = isq ? c2 : 1.0f;
            f32x4 gv[2][2];
#pragma unroll
            for (int bj = 0; bj < 2; ++bj)
#pragma unroll
                for (int n = 0; n < 2; ++n) gv[bj][n] = *(const f32x4*)(gg + 32 * bj + 8 * fq + 4 * n);
#pragma unroll
            for (int ai = 0; ai < 2; ++ai)
#pragma unroll
                for (int m = 0; m < 4; ++m) { const int row = rowb + ai * HALF + m * 16;
                    float ss = 0.f;
#pragma unroll
                    for (int bj = 0; bj < 2; ++bj)
#pragma unroll
                        for (int n = 0; n < 2; ++n) { const f32x4 x = acc[ai][bj][m][n]; ss += (x[0] * x[0] + x[1] * x[1]) + (x[2] * x[2] + x[3] * x[3]); }
                    ss += __shfl_xor(ss, 16); ss += __shfl_xor(ss, 32);
                    const float rstd = inv * __builtin_amdgcn_rsqf(ss * (inv * inv * (1.0f / 64.0f)) + 1e-6f);
                    f32x4 y[2][2];
#pragma unroll
                    for (int bj = 0; bj < 2; ++bj)
#pragma unroll
                        for (int n = 0; n < 2; ++n) y[bj][n] = acc[ai][bj][m][n] * rstd * gv[bj][n];
                    const f32x4 c0 = *(const f32x4*)(cstab + (size_t)row * 16), c1 = *(const f32x4*)(cstab + (size_t)row * 16 + 4);
                    const f32x4 s0 = *(const f32x4*)(cstab + (size_t)row * 16 + 8), s1 = *(const f32x4*)(cstab + (size_t)row * 16 + 12);
                    f32x4 p0, p1;
#pragma unroll
                    for (int i = 0; i < 4; ++i) { p0[i] = __shfl_xor(y[0][0][i], 16); p1[i] = __shfl_xor(y[0][1][i], 16); }
                    { const float sgn = fq == 0 ? -1.0f : 1.0f; const f32x4 r0 = y[0][0] * c0 + (p0 * s0) * sgn, r1 = y[0][1] * c1 + (p1 * s1) * sgn;
#pragma unroll
                      for (int i = 0; i < 4; ++i) { y[0][0][i] = fq < 2 ? r0[i] : y[0][0][i]; y[0][1][i] = fq < 2 ? r1[i] : y[0][1][i]; } }
                    bf16_t* rowp = base + (size_t)row * 1024 + j * 256 + wc * 64 + 8 * fq;
#pragma unroll
                    for (int bj = 0; bj < 2; ++bj) *(u32x4*)(rowp + 32 * bj) = pack8(y[bj][0] * sc, y[bj][1] * sc); }
        }
    }
};

struct EpiWo {
    static constexpr bool PERM = false;
    struct Pre {}; __device__ __forceinline__ void prefetch(const Unit&, int, int, Pre&) const {}
    const float* x; float* out; const float* gate;
    __device__ __forceinline__ void operator()(const f32x4 (&acc)[2][2][4][2], const Unit& u, int wr, int wc, int fr, int fq, const Pre& pre) const {
        const int rowb = u.pm * 256 + wr * 64 + fr; const int col0 = u.pn * 256 + wc * 32 + 4 * fq; const float* gp = gate + (size_t)(u.pm >> 4) * 6144;
        f32x4 gv[2][2];
#pragma unroll
        for (int bj = 0; bj < 2; ++bj)
#pragma unroll
            for (int n = 0; n < 2; ++n) gv[bj][n] = *(const f32x4*)(gp + col0 + bj * HALF + n * 16);
#pragma unroll
        for (int ai = 0; ai < 2; ++ai)
#pragma unroll
            for (int m = 0; m < 4; ++m) { const size_t off = (size_t)(rowb + ai * HALF + m * 16) * 1024 + col0;
#pragma unroll
                for (int bj = 0; bj < 2; ++bj)
#pragma unroll
                    for (int n = 0; n < 2; ++n) { const f32x4 xv = *(const f32x4*)(x + off + bj * HALF + n * 16); *(f32x4*)(out + off + bj * HALF + n * 16) = xv + gv[bj][n] * acc[ai][bj][m][n]; }
                if (m & 1) asm volatile("" ::: "memory"); }
    }
};
struct EpiF32 {
    static constexpr bool PERM = false;
    struct Pre {}; __device__ __forceinline__ void prefetch(const Unit&, int, int, Pre&) const {}
    float* out;
    __device__ __forceinline__ void operator()(const f32x4 (&acc)[2][2][4][2], const Unit& u, int wr, int wc, int fr, int fq, const Pre& pre) const {
        const int rowb = u.pm * 256 + wr * 64 + fr; const int col0 = wc * 32 + 4 * fq;
#pragma unroll
        for (int ai = 0; ai < 2; ++ai)
#pragma unroll
            for (int m = 0; m < 4; ++m) { float* rowp = out + (size_t)(rowb + ai * HALF + m * 16) * 256 + col0;
#pragma unroll
                for (int bj = 0; bj < 2; ++bj)
#pragma unroll
                    for (int n = 0; n < 2; ++n) *(f32x4*)(rowp + bj * HALF + n * 16) = acc[ai][bj][m][n]; }
    }
};
struct EpiGateUp {
    static constexpr bool PERM = true;
    struct Pre {}; __device__ __forceinline__ void prefetch(const Unit&, int, int, Pre&) const {}
    unsigned char* act; unsigned char* dump; float inv; float osc;
    __device__ __forceinline__ void operator()(const f32x4 (&acc)[2][2][4][2], const Unit& u, int wr, int wc, int fr, int fq, const Pre& pre) const {
        const int col0 = u.pn * 128 + wc * 32 + 8 * fq; int tdx = threadIdx.x; asm volatile("" : "+v"(tdx)); unsigned char* dmp = dump + ((size_t)(blockIdx.x * 512 + tdx) << 4);
#pragma unroll
        for (int ai = 0; ai < 2; ++ai)
#pragma unroll
            for (int m = 0; m < 4; ++m) { const int rt = ai * HALF + wr * 64 + m * 16 + fr; f32x4 o[2];
#pragma unroll
                for (int n = 0; n < 2; ++n)
#pragma unroll
                    for (int i = 0; i < 4; ++i) { const float g = acc[ai][0][m][n][i] * inv; o[n][i] = g * sigmoidf_fast(g) * (acc[ai][1][m][n][i] * (inv * osc)); }
                { typedef unsigned u32x2e __attribute__((ext_vector_type(2))); u32x2e w; w.x = pk4f8(o[0]); w.y = pk4f8(o[1]); *(u32x2e*)(rt < u.nrows ? act + (size_t)(u.row0 + rt) * 256 + col0 : dmp) = w; } }
    }
};
struct EpiDown {
    static constexpr int PERM = 2;
    static constexpr int NSTMAX = 8; __device__ __forceinline__ int nst(const Unit&) const { return 8; }
    struct Pre {}; __device__ __forceinline__ void prefetch(const Unit&, int, int, Pre&) const {}
    unsigned char* ys; const PG8_LAS unsigned short* gtab; unsigned char* dump; float sc;
    __device__ __forceinline__ void operator()(const f32x4 (&acc)[2][2][4][2], const Unit& u, int wr, int wc, int fr, int fq, const Pre& pre) const {
        int rt0 = wr * 64 + fr, tdx = threadIdx.x; asm volatile("" : "+v"(rt0), "+v"(tdx));
        unsigned char* base = ys + (size_t)u.row0 * 1024 + u.pn * 256 + wc * 64 + 16 * fq + (size_t)rt0 * 1024;
        unsigned char* dmp = dump + ((size_t)(blockIdx.x * 512 + tdx) << 4);
        const PG8_LAS unsigned short* gp = gtab + u.pm * 256 + rt0;
#pragma unroll
        for (int ai = 0; ai < 2; ++ai) {
#pragma unroll
            for (int m = 0; m < 4; ++m) { const int rt = ai * HALF + m * 16 + rt0; const float gt = (float)__builtin_bit_cast(_Float16, gp[ai * HALF + m * 16]) * sc;
                u32x4 w; w.x = pk4f8(acc[ai][0][m][0] * gt); w.y = pk4f8(acc[ai][0][m][1] * gt); w.z = pk4f8(acc[ai][1][m][0] * gt); w.w = pk4f8(acc[ai][1][m][1] * gt);
                unsigned char* dst = rt < u.nrows ? base + (ai * HALF + m * 16) * 1024 : dmp;
                *(u32x4*)dst = w; }
        }
    }
};
}
namespace attn_body {
using bf16=__hip_bfloat16;
using bf16x8=__attribute__((ext_vector_type(8)))short;
using s16x4=__attribute__((ext_vector_type(4)))short;
using f32x16=__attribute__((ext_vector_type(16)))float;
using u32x4=__attribute__((ext_vector_type(4)))unsigned;
constexpr int BATCH=8,NHEAD=16,SEQ=4096,D=64,DM=NHEAD*D;
constexpr int NW=8,QBLK=32,QB=QBLK*NW,KVBLK=64,NQB=SEQ/QB;
constexpr int ATTN_PITCH=DM, ATTN_UNIT_ROWS=QB;
__device__ __forceinline__ int crow(int r,int hi){return (r&3)+8*(r>>2)+4*hi;}
#define SBAR() __builtin_amdgcn_sched_barrier(0)
__device__ __forceinline__ void cmask(f32x16&p0,f32x16&p1,int jb,int qrel,int hi){
  const float NEG=-INFINITY; int kb=64*jb+4*hi;
  #pragma unroll
  for(int r=0;r<16;++r){int kv=kb+(r&3)+8*(r>>2); if(kv>qrel)p0[r]=NEG; if(kv+32>qrel)p1[r]=NEG;}
}

constexpr int NSLOT=3, SLOTB=8192, VSLOTB=2*SLOTB;
constexpr int LDS_K=0, LDS_V=NSLOT*SLOTB, LDS_WS=LDS_V+NSLOT*VSLOTB, LDS_OST=LDS_WS+NW*64*4, LDS_BYTES=LDS_OST+NW*4096;
constexpr int XARGS_OFF=131072+320+64;
constexpr float C2=0.125f*1.4426950408889634f;
__device__ __forceinline__ void glds16(const void*gsrc,unsigned lds_dst){unsigned keep;
  asm volatile("s_mov_b32 %0, m0\n\ts_mov_b32 m0, %2\n\ts_nop 0\n\tglobal_load_lds_dwordx4 %1, off\n\ts_mov_b32 m0, %0":"=&s"(keep):"v"(gsrc),"s"(lds_dst):"memory");}
__device__ __forceinline__ float max3f(float a,float b,float c){float r;asm("v_max3_f32 %0, %1, %2, %3":"=v"(r):"v"(a),"v"(b),"v"(c));return r;}
__device__ __forceinline__ float max2f(float a,float b){float r;asm("v_max_f32_e32 %0, %1, %2":"=v"(r):"v"(a),"v"(b));return r;}
__device__ __forceinline__ float fadd_s(float a,float b){float r;asm("v_add_f32_e32 %0, %1, %2":"=v"(r):"v"(a),"v"(b));return r;}
__device__ __forceinline__ float fsub_s(float a,float b){float r;asm("v_sub_f32_e32 %0, %1, %2":"=v"(r):"v"(a),"v"(b));return r;}
typedef float f32x2_t __attribute__((ext_vector_type(2))); typedef __bf16 bf16x2_t __attribute__((ext_vector_type(2)));
__device__ __forceinline__ unsigned cvtpk_s(float lo,float hi){f32x2_t v={lo,hi};bf16x2_t b=__builtin_convertvector(v,bf16x2_t);return __builtin_bit_cast(unsigned,b);}
#define WAIT_BAR(N) asm volatile("s_waitcnt vmcnt(" #N ") lgkmcnt(0)\n\ts_barrier":::"memory")

__device__ __forceinline__ void qkt(f32x16&p0,f32x16&p1,const char*Kslot,const bf16x8*qr,int r32,int hi){ const f32x16 negm=f32x16{};
  const char*kb=Kslot+hi*1024+r32*16;
  #pragma unroll
  for(int d0=0;d0<4;++d0){
    const bf16x8 b0=*reinterpret_cast<const bf16x8*>(kb+d0*2048);
    const bf16x8 b1=*reinterpret_cast<const bf16x8*>(kb+d0*2048+512);
    if(d0==0){p0=__builtin_amdgcn_mfma_f32_32x32x16_bf16(b0,qr[0],negm,0,0,0);p1=__builtin_amdgcn_mfma_f32_32x32x16_bf16(b1,qr[0],negm,0,0,0);}
    else{p0=__builtin_amdgcn_mfma_f32_32x32x16_bf16(b0,qr[d0],p0,0,0,0);p1=__builtin_amdgcn_mfma_f32_32x32x16_bf16(b1,qr[d0],p1,0,0,0);}}
}
typedef __attribute__((address_space(3))) const char* lds_cptr;
typedef short v4i16_t __attribute__((ext_vector_type(4)));
__device__ __forceinline__ void kload8(bf16x8*kf,lds_cptr kp){
  kf[0]=*(const __attribute__((address_space(3))) bf16x8*)(kp);      kf[1]=*(const __attribute__((address_space(3))) bf16x8*)(kp+512);
  kf[2]=*(const __attribute__((address_space(3))) bf16x8*)(kp+2048); kf[3]=*(const __attribute__((address_space(3))) bf16x8*)(kp+2560);
  kf[4]=*(const __attribute__((address_space(3))) bf16x8*)(kp+4096); kf[5]=*(const __attribute__((address_space(3))) bf16x8*)(kp+4608);
  kf[6]=*(const __attribute__((address_space(3))) bf16x8*)(kp+6144); kf[7]=*(const __attribute__((address_space(3))) bf16x8*)(kp+6656);
}
__device__ __forceinline__ void kload2(bf16x8*kf,lds_cptr kp,int j){ kf[2*j]=*(const __attribute__((address_space(3))) bf16x8*)(kp+j*2048); kf[2*j+1]=*(const __attribute__((address_space(3))) bf16x8*)(kp+j*2048+512); }
__device__ __forceinline__ s16x4 vtr(lds_cptr p){ return __builtin_bit_cast(s16x4,__builtin_amdgcn_ds_read_tr16_b64_v4i16((__attribute__((address_space(3))) v4i16_t*)p)); }
__device__ __forceinline__ float rowmax(const f32x16&p0,const f32x16&p1){
  float a=max3f(p0[0],p0[1],p1[0]),b=max3f(p0[2],p0[3],p1[1]);a=max3f(a,p1[2],p1[3]);
  #pragma unroll
  for(int r=4;r<16;r+=4){a=max3f(a,p0[r],p0[r+1]);b=max3f(b,p0[r+2],p0[r+3]);a=max3f(a,p1[r],p1[r+1]);b=max3f(b,p1[r+2],p1[r+3]);}
  const float m=max2f(a,b);
  auto rr=__builtin_amdgcn_permlane32_swap(__float_as_uint(m),__float_as_uint(m),false,false);
  return max2f(__uint_as_float(rr[0]),__uint_as_float(rr[1]));
}
__device__ __forceinline__ void pv(f32x16*o,int vb,bf16x8 pa0,bf16x8 pa1,bf16x8 pa2,bf16x8 pa3){
  #pragma unroll
  for(int d0=0;d0<4;++d0){s16x4 lo[4],hi[4];
    #pragma unroll
    for(int ks=0;ks<4;++ks){
      asm volatile("ds_read_b64_tr_b16 %0,%1 offset:%c2":"=&v"(lo[ks]):"v"(vb),"i"(d0*4096+ks*1024):"memory");
      asm volatile("ds_read_b64_tr_b16 %0,%1 offset:%c2":"=&v"(hi[ks]):"v"(vb),"i"(d0*4096+ks*1024+512):"memory");}
    asm volatile("s_waitcnt lgkmcnt(0)":::"memory");SBAR();
    #define PK(k) (bf16x8){lo[k][0],lo[k][1],lo[k][2],lo[k][3],hi[k][0],hi[k][1],hi[k][2],hi[k][3]}
    o[d0]=__builtin_amdgcn_mfma_f32_32x32x16_bf16(pa0,PK(0),o[d0],0,0,0);
    o[d0]=__builtin_amdgcn_mfma_f32_32x32x16_bf16(pa1,PK(1),o[d0],0,0,0);
    o[d0]=__builtin_amdgcn_mfma_f32_32x32x16_bf16(pa2,PK(2),o[d0],0,0,0);
    o[d0]=__builtin_amdgcn_mfma_f32_32x32x16_bf16(pa3,PK(3),o[d0],0,0,0);
    #undef PK
  }
}

#ifndef ATTN_STORE16
#define ATTN_STORE16(p,v) (*(u32x4*)(p)=(v))
#endif
template<int THRL> __device__ __forceinline__ void attn_unit(int b,int hq,int vcol,int qb,const bf16*Q,const bf16*K,const bf16*V,bf16*O,char*shm){
  int tid=threadIdx.x; asm volatile("":"+v"(tid));
  const int lane=tid&63,r32=lane&31,hi=lane>>5; const int wid=__builtin_amdgcn_readfirstlane(tid>>6);
  const long rowbase=(long)b*SEQ; const int q0=qb*QB;
  const bf16*Qw=Q+(rowbase+q0+wid*QBLK)*DM+hq*D;
  const bf16*Kh=K+rowbase*DM+hq*D,*Vh=V+rowbase*DM+vcol;
  const unsigned lds0=(unsigned)(uintptr_t)shm;
  float*wsf=(float*)(shm+LDS_WS)+wid*64;
  const bf16*ksrc=Kh+(long)lane*DM+wid*8;
  const bf16*vsrc=Vh+(long)(16*(wid&3)+(lane>>2))*DM+(wid>>2)*32+(lane&3)*8;
  const unsigned kdst=lds0+LDS_K+wid*1024, vdst=lds0+LDS_V+wid*1024;
  #define DMA_K(t,slot) glds16(ksrc+(long)(t)*KVBLK*DM,(unsigned)__builtin_amdgcn_readfirstlane(kdst+(slot)))
  #define DMA_V(t,slot) do{ glds16(vsrc+(long)(t)*KVBLK*DM,(unsigned)__builtin_amdgcn_readfirstlane(vdst+2*(slot))); glds16(vsrc+64+(long)(t)*KVBLK*DM,(unsigned)__builtin_amdgcn_readfirstlane(vdst+8192+2*(slot))); }while(0)
  const int vb0=(int)(lds0+LDS_V)+((lane>>4)&1)*32+(lane&3)*8+(4*hi+((lane&15)>>2))*64;
  const char*Kbase=shm+LDS_K; bf16x8 kf[8];
  const lds_cptr shm3=(lds_cptr)shm; const lds_cptr kp0=shm3+LDS_K+hi*1024+r32*16; const lds_cptr vp0=shm3+LDS_V+((lane>>4)&1)*32+(lane&3)*8+(4*hi+((lane&15)>>2))*64;
  const int NT=(q0+QB)/KVBLK;
  DMA_K(0,0);DMA_V(0,0);DMA_K(1,SLOTB);
  bf16x8 qr[4];
  #pragma unroll
  for(int d0=0;d0<4;++d0)qr[d0]=*reinterpret_cast<const bf16x8*>(&Qw[(long)r32*DM+d0*16+hi*8]);
  float l_reg=0.f;f32x16 o[4];o[0]=f32x16{};o[1]=f32x16{};o[2]=f32x16{};o[3]=f32x16{};
  const int qrel=wid*QBLK+r32;
  #define CMASK(P0,P1,t) do{int jb_=(t)-(NT-4); if(jb_>=0)cmask(P0,P1,jb_,qrel,hi);}while(0)
  #define START(P0,P1) do{ _Pragma("unroll") for(int r=0;r<16;++r){P0[r]=__builtin_amdgcn_exp2f(P0[r]);P1[r]=__builtin_amdgcn_exp2f(P1[r]);} }while(0)
  #define RESC() do{}while(0)
  f32x16 pA0,pA1,pB0,pB1;
  int sl_prev=0,sl_cur=0,sl_next=SLOTB;
  #define ROT() do{sl_prev=sl_cur;sl_cur=sl_next;sl_next=(sl_next==(NSLOT-1)*SLOTB)?0:sl_next+SLOTB;}while(0)
  DMA_K(2,2*SLOTB);
  WAIT_BAR(4);
  qkt(pA0,pA1,Kbase,qr,r32,hi);asm volatile("s_nop 15\n\ts_nop 7":"+v"(pA0),"+v"(pA1));CMASK(pA0,pA1,0);
  START(pA0,pA1);
  WAIT_BAR(0);
  DMA_K(3,0);DMA_V(1,SLOTB);
  ROT();
  kload8(kf,kp0+sl_cur);
  WAIT_BAR(3);
  s16x4 vlo[4],vhi[4]; u32x4 pw0,pw1,pw2,pw3;
  #define PKW(P,B) cvtpk_s(P[B],P[B+1])
  #define PAF(k) __builtin_bit_cast(bf16x8,pw##k)
  #define VFR(i) (bf16x8){vlo[i][0],vlo[i][1],vlo[i][2],vlo[i][3],vhi[i][0],vhi[i][1],vhi[i][2],vhi[i][3]}
  #define PIN(x) asm volatile("":"+v"(x))
  #define MX3(a,b,c) __builtin_fmaxf(__builtin_fmaxf((a),(b)),(c))
  #define GAPA(MF,A0,A1,A2,A3,W0,W1,PW) do{ MF; sacc+=A0; sacc+=A1; sacc+=A2; sacc+=A3; PIN(sacc); W0; W1; PIN(PW); SBAR(); }while(0)
  #define EXS(v) __builtin_amdgcn_exp2f(v)
  #define VOFF(n) ((2*((n)>>3)+((n)&1))*4096+(((n)&7)>>1)*1024)
  #define VRDN(n) do{ vlo[(n)&3]=vtr(vp_+VOFF(n)); vhi[(n)&3]=vtr(vp_+VOFF(n)+512); }while(0)
  #define GAPB(n,PA,OD,X,B) do{ o[OD]=__builtin_amdgcn_mfma_f32_32x32x16_bf16(PA,VFR((n)&3),o[OD],0,0,0); X[B]=EXS(X[B]); X[(B)+1]=EXS(X[(B)+1]); PIN(X); SBAR(); if((n)+4<16){ VRDN((n)+4); SBAR(); } }while(0)
  #define KRD(G,j) do{ if(G){ kload2(kf,kp0+sl_next,j); SBAR(); } }while(0)
  #define STEP(C0,C1,P0,P1,t,GK,GV,GL) do{ SBAR(); \
    const lds_cptr vp_=vp0+2*sl_prev; const f32x16 zc_=f32x16{}; \
    float sacc=(P0[0]+P0[1]); \
    GAPA(C0=__builtin_amdgcn_mfma_f32_32x32x16_bf16(kf[0],qr[0],zc_,0,0,0), P0[2],P0[3],P0[4],P0[5],     pw0[0]=PKW(P0,0), pw0[1]=PKW(P0,2), pw0); \
    GAPA(C1=__builtin_amdgcn_mfma_f32_32x32x16_bf16(kf[1],qr[0],zc_,0,0,0), P0[6],P0[7],P0[8],P0[9],     pw0[2]=PKW(P0,4), pw0[3]=PKW(P0,6), pw0); \
    GAPA(C0=__builtin_amdgcn_mfma_f32_32x32x16_bf16(kf[2],qr[1],C0,0,0,0),   P0[10],P0[11],P0[12],P0[13], pw1[0]=PKW(P0,8), pw1[1]=PKW(P0,10), pw1); \
    GAPA(C1=__builtin_amdgcn_mfma_f32_32x32x16_bf16(kf[3],qr[1],C1,0,0,0),   P0[14],P0[15],P1[0],P1[1],   pw1[2]=PKW(P0,12),pw1[3]=PKW(P0,14), pw1); \
    VRDN(0); SBAR(); GAPA(C0=__builtin_amdgcn_mfma_f32_32x32x16_bf16(kf[4],qr[2],C0,0,0,0),   P1[2],P1[3],P1[4],P1[5],     pw2[0]=PKW(P1,0), pw2[1]=PKW(P1,2), pw2); \
    VRDN(1); SBAR(); GAPA(C1=__builtin_amdgcn_mfma_f32_32x32x16_bf16(kf[5],qr[2],C1,0,0,0),   P1[6],P1[7],P1[8],P1[9],     pw2[2]=PKW(P1,4), pw2[3]=PKW(P1,6), pw2); \
    VRDN(2); SBAR(); GAPA(C0=__builtin_amdgcn_mfma_f32_32x32x16_bf16(kf[6],qr[3],C0,0,0,0),   P1[10],P1[11],P1[12],P1[13], pw3[0]=PKW(P1,8), pw3[1]=PKW(P1,10), pw3); \
    VRDN(3); SBAR(); GAPA(C1=__builtin_amdgcn_mfma_f32_32x32x16_bf16(kf[7],qr[3],C1,0,0,0),   P1[14],P1[15],0.f,0.f,       pw3[2]=PKW(P1,12),pw3[3]=PKW(P1,14), pw3); \
    l_reg+=sacc; \
    if(GK){DMA_K((t)+3,sl_cur);} if(GV){DMA_V((t)+1,sl_next);} \
    CMASK(C0,C1,t); \
    SBAR(); \
    GAPB(0,PAF(0),0,C0,0);  GAPB(1,PAF(0),1,C0,2);  GAPB(2,PAF(1),0,C0,4);  GAPB(3,PAF(1),1,C0,6); \
    GAPB(4,PAF(2),0,C0,8);  GAPB(5,PAF(2),1,C0,10); GAPB(6,PAF(3),0,C0,12); GAPB(7,PAF(3),1,C0,14); \
    GAPB(8,PAF(0),2,C1,0);  GAPB(9,PAF(0),3,C1,2); \
    KRD(GL,0); GAPB(10,PAF(1),2,C1,4); KRD(GL,1); GAPB(11,PAF(1),3,C1,6); \
    KRD(GL,2); GAPB(12,PAF(2),2,C1,8); KRD(GL,3); GAPB(13,PAF(2),3,C1,10); \
    GAPB(14,PAF(3),2,C1,12); GAPB(15,PAF(3),3,C1,14); \
    }while(0)
  int t=1;
  #undef CMASK
  #define CMASK(P0,P1,t) do{}while(0)
  for(;t+5<NT;t+=2){
    STEP(pB0,pB1,pA0,pA1,t,true,true,true);     WAIT_BAR(3); RESC(); ROT();
    STEP(pA0,pA1,pB0,pB1,t+1,true,true,true);   WAIT_BAR(3); RESC(); ROT();
  }
  #undef CMASK
  #define CMASK(P0,P1,t) do{int jb_=(t)-(NT-4); if(jb_>=0)cmask(P0,P1,jb_,qrel,hi);}while(0)
  #define ENDW(tt) do{ if((tt)+3<NT){WAIT_BAR(3);} else if((tt)+2<NT){WAIT_BAR(2);} else {WAIT_BAR(0);} }while(0)
  for(;t+1<NT;t+=2){
    STEP(pB0,pB1,pA0,pA1,t,(t+3<NT),(t+1<NT),(t+1<NT));       ENDW(t);   RESC(); ROT();
    STEP(pA0,pA1,pB0,pB1,t+1,(t+4<NT),(t+2<NT),(t+2<NT));     ENDW(t+1); RESC(); ROT();
  }
  STEP(pB0,pB1,pA0,pA1,NT-1,false,false,false); RESC();
  { float sacc=pB0[0]+pB0[1]; _Pragma("unroll") for(int r=2;r<16;++r)sacc+=pB0[r]; _Pragma("unroll") for(int r=0;r<16;++r)sacc+=pB1[r]; l_reg+=sacc;
    pw0=(u32x4){PKW(pB0,0),PKW(pB0,2),PKW(pB0,4),PKW(pB0,6)};pw1=(u32x4){PKW(pB0,8),PKW(pB0,10),PKW(pB0,12),PKW(pB0,14)};pw2=(u32x4){PKW(pB1,0),PKW(pB1,2),PKW(pB1,4),PKW(pB1,6)};pw3=(u32x4){PKW(pB1,8),PKW(pB1,10),PKW(pB1,12),PKW(pB1,14)};
    SBAR(); pv(o,vb0+2*sl_cur,PAF(0),PAF(1),PAF(2),PAF(3)); }
  #undef PKW
  #undef PAF
  #undef VFR
  #undef PIN
  #undef MX3
  #undef GAPA
  #undef GAPB
  #undef EXS
  #undef VOFF
  #undef VRDN
  #undef KRD
  #undef STEP
  #undef ENDW
  {auto rr=__builtin_amdgcn_permlane32_swap(__float_as_uint(l_reg),__float_as_uint(l_reg),false,false);l_reg=__uint_as_float(rr[0])+__uint_as_float(rr[1]);}
  if(hi==0)wsf[32+r32]=l_reg;asm volatile("s_waitcnt lgkmcnt(0)":::"memory");
  float rli[16];
  #pragma unroll
  for(int r=0;r<16;++r)rli[r]=__builtin_amdgcn_rcpf(wsf[32+crow(r,hi)]);
  bf16*Ow=O+(rowbase+q0+wid*QBLK)*DM+vcol;
  if((hq&1)==0){ bf16*stg=(bf16*)(shm+LDS_OST)+wid*2048; int lane_f=lane; asm volatile("":"+v"(lane_f));
    #pragma unroll
    for(int hh=0;hh<2;++hh){
      #pragma unroll
      for(int r=0;r<16;++r){const int orow=crow(r,hi);
        #pragma unroll
        for(int d0=0;d0<2;++d0)stg[orow*64+d0*32+r32]=__float2bfloat16(o[2*hh+d0][r]*rli[r]);}
      asm volatile("s_waitcnt lgkmcnt(0)":::"memory");
      #pragma unroll
      for(int i=0;i<4;++i){const int row=i*8+(lane_f>>3),ch=lane_f&7; const u32x4 v=*(const u32x4*)(stg+row*64+ch*8); ATTN_STORE16(Ow+(long)row*DM+hh*64+ch*8,v);}
      asm volatile("s_waitcnt lgkmcnt(0)":::"memory"); } }
  else { bf16*stg=(bf16*)(shm+LDS_OST)+wid*2048;
    const volatile __attribute__((address_space(3))) unsigned* xa=(const volatile __attribute__((address_space(3))) unsigned*)((lds_cptr)shm+XARGS_OFF);
    bf16*YB=(bf16*)(__attribute__((address_space(1))) void*)(((unsigned long long)(unsigned)__builtin_amdgcn_readfirstlane(xa[1])<<32)|(unsigned)__builtin_amdgcn_readfirstlane(xa[0]));
    const bf16*GB=(const bf16*)(__attribute__((address_space(1))) void*)(((unsigned long long)(unsigned)__builtin_amdgcn_readfirstlane(xa[3])<<32)|(unsigned)__builtin_amdgcn_readfirstlane(xa[2]));
    const float*sg=(const float*)(__attribute__((address_space(1))) void*)(((unsigned long long)(unsigned)__builtin_amdgcn_readfirstlane(xa[5])<<32)|(unsigned)__builtin_amdgcn_readfirstlane(xa[4]));
    const float lam=__uint_as_float((unsigned)__builtin_amdgcn_readfirstlane(xa[6]));
    int lane_e=lane; asm volatile("":"+v"(lane_e));
    const int rl=lane_e>>3,ch=lane_e&7; const long goff=(rowbase+q0+wid*QBLK)*DM+vcol;
    float x[2][4][8]; float ss[4]={0.f,0.f,0.f,0.f};
    #define BLO(w) __uint_as_float((w)<<16)
    #define BHI(w) __uint_as_float((w)&0xffff0000u)
    #pragma unroll
    for(int hh=0;hh<2;++hh){
      #pragma unroll
      for(int r=0;r<16;++r){const int orow=crow(r,hi);
        #pragma unroll
        for(int d0=0;d0<2;++d0)stg[orow*64+d0*32+r32]=__float2bfloat16(o[2*hh+d0][r]*rli[r]);}
      asm volatile("s_waitcnt lgkmcnt(0)":::"memory");
      #pragma unroll
      for(int i=0;i<4;++i){const int row=i*8+rl; const u32x4 v1=*(const u32x4*)(stg+row*64+ch*8); const u32x4 v0=*(const u32x4*)(O+goff+(long)row*DM+hh*64+ch*8);
        #pragma unroll
        for(int k=0;k<4;++k){const float lo=BLO(v0[k])-lam*BLO(v1[k]),hv=BHI(v0[k])-lam*BHI(v1[k]); x[hh][i][2*k]=lo; x[hh][i][2*k+1]=hv; ss[i]+=lo*lo+hv*hv;}}
      asm volatile("s_waitcnt lgkmcnt(0)":::"memory"); }
    #pragma unroll
    for(int i=0;i<4;++i){ss[i]+=__shfl_xor(ss[i],1);ss[i]+=__shfl_xor(ss[i],2);ss[i]+=__shfl_xor(ss[i],4);ss[i]=__builtin_amdgcn_rsqf(ss[i]*(1.0f/128.0f)+1e-6f);}
    #pragma unroll
    for(int hh=0;hh<2;++hh){ float sgv[8];
      #pragma unroll
      for(int j=0;j<8;++j)sgv[j]=sg[hh*64+ch*8+j]*0.8f;
      #pragma unroll
      for(int i=0;i<4;++i){const int row=i*8+rl; const u32x4 gb=*(const u32x4*)(GB+goff+(long)row*DM+hh*64+ch*8); u32x4 w;
        #pragma unroll
        for(int k=0;k<4;++k){const float g0=__builtin_amdgcn_rcpf(1.0f+__builtin_amdgcn_exp2f(-1.4426950408889634f*BLO(gb[k]))),g1=__builtin_amdgcn_rcpf(1.0f+__builtin_amdgcn_exp2f(-1.4426950408889634f*BHI(gb[k])));
          w[k]=cvtpk_s(g0*(x[hh][i][2*k]*ss[i]*sgv[2*k]),g1*(x[hh][i][2*k+1]*ss[i]*sgv[2*k+1]));}
        ATTN_STORE16(YB+goff+(long)row*DM+hh*64+ch*8,w);}}
    #undef BLO
    #undef BHI
  }
  asm volatile("s_waitcnt lgkmcnt(0)\n\ts_barrier":::"memory");
  #undef DMA_K
  #undef DMA_V
  #undef CMASK
  #undef START
  #undef RESC
  #undef ROT
}
constexpr int ATTN_LDS_BYTES=LDS_BYTES;
struct AttnTensors { const bf16* Q; const bf16* K; const bf16* V; bf16* O0; bf16* YB; const bf16* GB; const float* sg; float lam; };
struct AttnUnit { int b, h, qb; };
struct PairOrder {
  int vcu, G;
  __device__ __forceinline__ PairOrder(int grid,int vcu_):vcu(vcu_),G(grid){}
  __device__ __forceinline__ bool next(int i,AttnUnit&u)const{ const int ug=i*G+vcu; if(ug>=1024)return false; const int w=ug&31, rnd=ug>>8, bh=((ug&255)>>5)*8+2*rnd+(w>>4);
    u.b=bh>>3; u.h=bh&7; u.qb=(rnd&1)?15-(w&15):(w&15); return true; }
  __device__ __forceinline__ void a_ready(const AttnUnit&)const{}
  __device__ __forceinline__ void done(const AttnUnit&)const{}
};
template<class Sched,class Hook,int THRL=8> __device__ __forceinline__ void attn_phase(char*lds,const AttnTensors&T,const Sched&S,const Hook&H,int reps){
  AttnUnit u;
  if(threadIdx.x==0){ volatile __attribute__((address_space(3))) unsigned* xa=(volatile __attribute__((address_space(3))) unsigned*)((lds_cptr)lds+XARGS_OFF);
    const unsigned long long p0=(unsigned long long)T.YB,p1=(unsigned long long)T.GB,p2=(unsigned long long)T.sg;
    xa[0]=(unsigned)p0;xa[1]=(unsigned)(p0>>32);xa[2]=(unsigned)p1;xa[3]=(unsigned)(p1>>32);xa[4]=(unsigned)p2;xa[5]=(unsigned)(p2>>32);xa[6]=__float_as_uint(T.lam); }
  __syncthreads();
  int hs=0;
  for(int rep=0;rep<reps;++rep)
  for(int i=0;S.next(i>>1,u);++i){ S.a_ready(u);
    attn_unit<THRL>(u.b,2*u.h+(i&1),128*u.h,u.qb,T.Q,T.K,T.V,T.O0,lds);
    S.done(u);
    if(hs<Hook::NSLICE){ H(hs); ++hs; } }
  for(;hs<Hook::NSLICE;++hs)H(hs);
}
#undef SBAR
#undef WAIT_BAR
}
#define GAS __attribute__((address_space(1)))
#define LAS __attribute__((address_space(3)))
typedef unsigned short bf16;
typedef unsigned v4u __attribute__((ext_vector_type(4)));
typedef float f32x4 __attribute__((ext_vector_type(4)));
typedef short bf16x8 __attribute__((ext_vector_type(8)));
typedef GAS unsigned gu32;
typedef GAS unsigned long long gu64;
#define RLX_AGENT __ATOMIC_RELAXED, __HIP_MEMORY_SCOPE_AGENT
#define LDS_WAIT() asm volatile("s_waitcnt lgkmcnt(0)" ::: "memory")
#define VM_WAIT() asm volatile("s_waitcnt vmcnt(0)" ::: "memory")
__device__ __forceinline__ unsigned long long rt() { return __builtin_amdgcn_s_memrealtime(); }
typedef float f32x2_cv __attribute__((ext_vector_type(2))); typedef __bf16 bf16x2_cv __attribute__((ext_vector_type(2)));
__device__ __forceinline__ unsigned pk2(float lo, float hi) { const f32x2_cv v = {lo, hi}; return __builtin_bit_cast(unsigned, __builtin_convertvector(v, bf16x2_cv)); }
__device__ __forceinline__ unsigned f2bf(float f) { return pk2(f, f) & 0xffffu; }

#define XB_TMO      128
#define XB_XCNT(j)  (256  + 64 * (j))
#define XB_XSUB(j)  (1280 + 64 * (j))
#define XB_XGEN(j)  (2304 + 64 * (j))
#define XB_TOP      3328
#define XB_TOPGEN   3392
#define XCD_BAR_WORDS 3456
#define XB_SPIN_CAP (1u << 18)

__device__ __forceinline__ unsigned xb_ld(unsigned* p)              { return __hip_atomic_load(p, __ATOMIC_RELAXED, __HIP_MEMORY_SCOPE_AGENT); }
__device__ __forceinline__ unsigned xb_add(unsigned* p, unsigned v) { return __hip_atomic_fetch_add(p, v, __ATOMIC_RELAXED, __HIP_MEMORY_SCOPE_AGENT); }
__device__ __forceinline__ unsigned xb_xcc_id() { return (unsigned)__builtin_amdgcn_s_getreg((3 << 11) | 20) & 0xFu; }
#define XB_SPIN(cond, bar) do { unsigned _sp = 0; while (cond) { __builtin_amdgcn_s_sleep(1); \
    if ((++_sp & 255u) == 0u) { if (xb_ld(&(bar)[XB_TMO])) break; if (_sp > XB_SPIN_CAP) { atomicAdd(&(bar)[XB_TMO], 1u); break; } } } } while (0)

struct XcdBarrier {
    unsigned* bar; unsigned x;
    volatile LAS unsigned* st;
};

__device__ __forceinline__ XcdBarrier xcd_barrier_post(unsigned* bar, volatile LAS unsigned* st) {
    XcdBarrier b; b.bar = bar; b.x = xb_xcc_id(); b.st = st;
    if (threadIdx.x == 0) (void)xb_add(&bar[XB_XCNT(b.x)], 1u);
    return b;
}
__device__ __forceinline__ void xcd_barrier_complete(unsigned* bar, unsigned x, unsigned& nloc, unsigned& nx) {
    const unsigned G = gridDim.x * gridDim.y * gridDim.z;
    unsigned sum, cnt, mine, sp = 0u;
    for (;;) {
        sum = 0u; cnt = 0u; mine = 0u;
#pragma unroll
        for (unsigned j = 0; j < 16; ++j) { const unsigned c = xb_ld(&bar[XB_XCNT(j)]); sum += c; cnt += (c > 0u) ? 1u : 0u; mine = (j == x) ? c : mine; }
        if (sum == G) break;
        __builtin_amdgcn_s_sleep(1);
        if ((++sp & 255u) == 0u) { if (xb_ld(&bar[XB_TMO])) break; if (sp > XB_SPIN_CAP) { atomicAdd(&bar[XB_TMO], 1u); break; } }
    }
    nloc = mine > 0u ? mine : 1u; nx = cnt > 0u ? cnt : 1u;
}

__device__ __forceinline__ void xcd_barrier(const XcdBarrier& b) {
    asm volatile("s_waitcnt vmcnt(0)" ::: "memory");
    __syncthreads();
    if (threadIdx.x == 0) {
        unsigned* bar = b.bar;
        __builtin_amdgcn_s_waitcnt(0);
        unsigned nloc = b.st[0], nx = b.st[1];
        if (nloc == 0u) { xcd_barrier_complete(bar, b.x, nloc, nx); b.st[0] = nloc; b.st[1] = nx; }
        const unsigned old = xb_add(&bar[XB_XSUB(b.x)], 1u);
        const unsigned gen = old / nloc;
        if (old + 1u == (gen + 1u) * nloc) {
            __builtin_amdgcn_fence(__ATOMIC_RELEASE, "agent");
            asm volatile("s_waitcnt vmcnt(0)" ::: "memory");
            const unsigned og = xb_add(&bar[XB_TOP], 1u);
            const unsigned tg = og / nx;
            if (og + 1u == (tg + 1u) * nx) xb_add(&bar[XB_TOPGEN], 1u);
            else XB_SPIN(xb_ld(&bar[XB_TOPGEN]) == tg, bar);
            __builtin_amdgcn_fence(__ATOMIC_ACQUIRE, "agent");
            xb_add(&bar[XB_XGEN(b.x)], 1u);
            asm volatile("s_waitcnt vmcnt(0)" ::: "memory");
        } else {
            XB_SPIN(xb_ld(&bar[XB_XGEN(b.x)]) == gen, bar);
            __builtin_amdgcn_fence(__ATOMIC_ACQUIRE, "agent");
            asm volatile("s_waitcnt vmcnt(0)" ::: "memory");
        }
    }
    __syncthreads();
}
constexpr int NWAVES = 8;
constexpr int BATCH = 8, SEQ = 4096, T = BATCH * SEQ, D = 1024, NEXP = 256, TOPK = 8, DEXP = 256, NSLOT = TOPK + 1  ;
constexpr int INW = 7168;
constexpr int NPOS = T * NSLOT;
constexpr int MAXTILES = 1408;
constexpr float EPS = 1e-6f;

constexpr size_t MiB = 1u << 20;
constexpr size_t WS_CTL = 0, CTL_ZERO_BYTES = 1 * MiB;
constexpr size_t WS_MOD = 1 * MiB;
constexpr size_t WS_C8SP = 1 * MiB + 256 * 1024;
constexpr size_t WS_CST = 1 * MiB + 512 * 1024;
constexpr size_t WS_WIN = 4 * MiB, WS_WO = 18 * MiB, WS_WR = 20 * MiB, WS_WLRU = 20 * MiB + 512 * 1024;
constexpr size_t WS_TOPE = 21 * MiB, WS_TOPG = 22 * MiB, WS_POSE = 23 * MiB;
constexpr size_t WS_REC = 546 * MiB;
constexpr int REC_CAP = T;
constexpr size_t WS_POSM = 12 * MiB;
constexpr size_t WS_DUMP = 13 * MiB;
constexpr size_t WS_H28 = 482 * MiB;
constexpr float SC_H = 4.0f, SC_W = 64.0f, SC_A = 8.0f, SC_Y = 16.0f;
constexpr size_t WS_WED = 32 * MiB;
constexpr size_t WS_WEGU = 161 * MiB;
constexpr size_t WS_XR = 418 * MiB, WS_GAR = 482 * MiB, WS_Q = 546 * MiB, WS_K = 610 * MiB, WS_V = 674 * MiB, WS_GB = 738 * MiB, WS_MIX = 802 * MiB;
constexpr size_t WS_LOGIT = 738 * MiB;
constexpr size_t WS_H2 = 418 * MiB;
constexpr size_t WS_ACT = 802 * MiB;
constexpr size_t WS_YS = 161 * MiB;
constexpr size_t WS_END = 948 * MiB;
static_assert(WS_YS + (size_t)NPOS * 2048 <= WS_LOGIT && WS_ACT + (size_t)(NPOS + 256) * 512 <= WS_END && WS_WED + (size_t)257 * 1024 * 256 * 2 <= WS_WEGU && WS_WEGU + (size_t)257 * 512 * 1024 * 2 <= WS_XR, "d_ws map");
constexpr int CW_TMO = 0, CW_CODE = 1, CW_NTILES = 64, CW_CONV = 128, CW_CNT = 1024, CW_BAR = 4096;

constexpr int RING_OFF = 0, RING_BYTES = 131072;
constexpr int LDSCTL_OFF = RING_BYTES, MISC_OFF = LDSCTL_OFF + 320;
constexpr int UT_OFF = LDSCTL_OFF + 512;
constexpr int TOK_OFF = LDSCTL_OFF + 2048;
constexpr int PFX_OFF = LDSCTL_OFF + 16384;
constexpr int LDS_BYTES = 147456 + 4096;
constexpr int MAXU_TOK = 14, MAXU = 64, MAXU_GT = 28;
struct Frame {
    LAS unsigned char* lds;
    volatile LAS unsigned* MISC;
    gu32* ctl;
    int tid, lane, wave;
    int vcu, G;
};
#define LBAR() asm volatile("s_waitcnt lgkmcnt(0)\n\ts_barrier" ::: "memory")
__device__ __forceinline__ float wave_sum(float v) {
#pragma unroll
    for (int o = 1; o < 64; o <<= 1) v += __shfl_xor(v, o);
    return v;
}
__device__ __forceinline__ float bf2f(unsigned short h) { return __builtin_bit_cast(float, (unsigned)h << 16); }
__device__ __forceinline__ float bflo(unsigned w) { return __builtin_bit_cast(float, w << 16); }
__device__ __forceinline__ float bfhi(unsigned w) { return __builtin_bit_cast(float, w & 0xffff0000u); }
__device__ __forceinline__ float clamp_f8(float v) { return __builtin_amdgcn_fmed3f(v, -448.0f, 448.0f); }
__device__ __forceinline__ unsigned pk4_fp8(float a, float b, float c, float d) { unsigned w = 0u; a = clamp_f8(a); b = clamp_f8(b); c = clamp_f8(c); d = clamp_f8(d); w = __builtin_amdgcn_cvt_pk_fp8_f32(a, b, w, false); w = __builtin_amdgcn_cvt_pk_fp8_f32(c, d, w, true); return w; }
__device__ __forceinline__ float sigm(float v) { return __builtin_amdgcn_rcpf(1.0f + __builtin_amdgcn_exp2f(-1.4426950408889634f * v)); }

__device__ __forceinline__ void transpose_item(const float* W, int ldn, bf16* WT, int ldk, int k0, int n0, int drow0, LAS float* scr, int lane) {
    float v[32];
#pragma unroll
    for (int i = 0; i < 32; ++i) { const int kk = 2 * i + (lane >> 5); v[i] = __builtin_nontemporal_load(W + (size_t)(k0 + kk) * ldn + n0 + (lane & 31)); }
#pragma unroll
    for (int i = 0; i < 32; ++i) { const int kk = 2 * i + (lane >> 5); scr[kk * 33 + (lane & 31)] = v[i]; }
    LDS_WAIT(); asm volatile("" ::: "memory");
    const int c = lane & 7;
#pragma unroll
    for (int j = 0; j < 4; ++j) { const int n = (lane >> 3) + 8 * j; const LAS float* s = scr + (8 * c) * 33 + n;
        v4u o; o.x = pk2(s[0 * 33], s[1 * 33]); o.y = pk2(s[2 * 33], s[3 * 33]); o.z = pk2(s[4 * 33], s[5 * 33]); o.w = pk2(s[6 * 33], s[7 * 33]);
        *(GAS v4u*)(WT + (size_t)(drow0 + n) * ldk + k0 + 8 * c) = o; }
    LDS_WAIT(); asm volatile("" ::: "memory");
}
__device__ __forceinline__ void transpose_item8(const float* W, int ldn, unsigned char* WT, int ldk, int k0, int n0, int drow0, float scale, LAS float* scr, int lane) {
    float v[32];
#pragma unroll
    for (int i = 0; i < 32; ++i) { const int kk = 2 * i + (lane >> 5); v[i] = __builtin_nontemporal_load(W + (size_t)(k0 + kk) * ldn + n0 + (lane & 31)); }
#pragma unroll
    for (int i = 0; i < 32; ++i) { const int kk = 2 * i + (lane >> 5); scr[kk * 33 + (lane & 31)] = v[i] * scale; }
    LDS_WAIT(); asm volatile("" ::: "memory");
    const int c = lane & 3;
#pragma unroll
    for (int j = 0; j < 2; ++j) { const int n = (lane >> 2) + 16 * j; const LAS float* s = scr + (16 * c) * 33 + n;
        v4u o; o.x = pk4_fp8(s[0 * 33], s[1 * 33], s[2 * 33], s[3 * 33]); o.y = pk4_fp8(s[4 * 33], s[5 * 33], s[6 * 33], s[7 * 33]);
        o.z = pk4_fp8(s[8 * 33], s[9 * 33], s[10 * 33], s[11 * 33]); o.w = pk4_fp8(s[12 * 33], s[13 * 33], s[14 * 33], s[15 * 33]);
        *(GAS v4u*)(WT + (size_t)(drow0 + n) * ldk + k0 + 16 * c) = o; }
    LDS_WAIT(); asm volatile("" ::: "memory");
}
__device__ __forceinline__ int rowmap_in(int n0) {
    const int seg = n0 >> 10, o = n0 & 1023;
    if (seg == 0) return o;
    if (seg == 1) return 1024 + 256 * (o >> 7) + (o & 127);
    if (seg == 2 || seg == 3) { const int j = o >> 8, r = o & 255; return (seg == 2 ? 3072 : 4096) + 256 * j + 128 * ((r >> 5) & 1) + 32 * (r >> 6) + (r & 31); }
    if (seg == 4) return 5120 + o;
    if (seg == 5) return 1024 + 256 * (o >> 7) + 128 + (o & 127);
    return 6144 + o;
}
struct P0Args { const float *c, *w_ada, *b_ada, *w_in, *w_o, *w_router, *we_gate, *we_up, *we_down, *ws_gate, *ws_up, *ws_down, *lru_wa, *lru_wx, *lru_lambda; const int* positions; };
__device__ __forceinline__ void p0_prologue(Frame& F, const P0Args& a, unsigned char* ws) {
    float* mod = (float*)(ws + WS_MOD);
    __syncthreads();
    for (int u = F.vcu; u < 192; u += F.G) {
        LAS float* sc = (LAS float*)F.lds; LAS float* red = (LAS float*)(F.lds + 32768);
        for (int i = F.tid; i < 8192; i += 512) { const float v = a.c[i]; sc[i] = v * sigm(v); }
        __syncthreads();
        const int cl = F.tid & 31, ks = F.tid >> 5, col = u * 32 + cl;
        float acc[8];
#pragma unroll
        for (int b = 0; b < 8; ++b) acc[b] = 0.f;
#pragma unroll 16
        for (int k = ks * 64; k < ks * 64 + 64; ++k) { const float w = a.w_ada[(size_t)k * 6144 + col];
#pragma unroll
            for (int b = 0; b < 8; ++b) acc[b] += sc[b * 1024 + k] * w; }
#pragma unroll
        for (int b = 0; b < 8; ++b) red[(ks * 8 + b) * 32 + cl] = acc[b];
        __syncthreads();
        if (F.tid < 256) { const int b = F.tid >> 5; float s = a.b_ada[col];
#pragma unroll
          for (int k2 = 0; k2 < 16; ++k2) s += red[(k2 * 8 + b) * 32 + cl];
          mod[b * 6144 + col] = s; }
        __syncthreads();
    }
    const int gt = F.vcu * 512 + F.tid, NT_ = F.G * 512;
    if (gt < 1024) { const double z = -(double)a.lru_lambda[gt]; const double sp = (z > 0.0 ? z : 0.0) + log1p(exp(-(z > 0.0 ? z : -z))); ((float*)(ws + WS_C8SP))[gt] = (float)(8.0 * sp); }
    for (int idx = gt; idx < T * 8; idx += NT_) { const int tok = idx >> 3, i = idx & 7;
        const float inv = exp2f(-(float)i * 0.125f * 18.931568569324174f);
        const float ang = (float)a.positions[tok] * inv;
        double rev = (double)ang * 0.15915494309189535; rev -= floor(rev); const float fr = (float)rev;
        float* cs = (float*)(ws + WS_CST) + (size_t)tok * 16;
        cs[i] = __builtin_amdgcn_cosf(fr); cs[8 + i] = __builtin_amdgcn_sinf(fr); }
    LAS float* scr = (LAS float*)(F.lds + RING_OFF + F.wave * 16384);
    const int gw = F.vcu * NWAVES + F.wave, NGW = F.G * NWAVES;
    bf16* Wo_t = (bf16*)(ws + WS_WO); bf16* Wr_t = (bf16*)(ws + WS_WR); bf16* Wlru = (bf16*)(ws + WS_WLRU);
    constexpr int I_IN = 16 * 224, I_O = 16 * 32, I_R = 16 * 8, I_E = 384 * 257, I_L = 64;
    constexpr int NITEMS = I_E + I_IN + I_O + I_R + I_L;
    for (int it = gw + I_E; it < NITEMS; it += NGW) {
        int r = it;
        if (r < I_E) { const int e = r / 384, q = r % 384, which = q >> 7, ii = q & 127;
            if (which < 2) { const float* src = (e < 256) ? ((which ? a.we_up : a.we_gate) + (size_t)e * 262144) : (which ? a.ws_up : a.ws_gate);
                const int kb = ii >> 3, nb = ii & 7, n0 = nb * 32;
                transpose_item8(src, 256, ws + WS_WEGU + (size_t)e * 524288, 1024, kb * 64, n0, 256 * (n0 >> 7) + (which ? 128 : 0) + (n0 & 127), SC_W, scr, F.lane);
            } else { const float* src = (e < 256) ? (a.we_down + (size_t)e * 262144) : a.ws_down;
                const int kb = ii >> 5, nb = ii & 31;
                transpose_item8(src, 1024, ws + WS_WED + (size_t)e * 262144, 256, kb * 64, nb * 32, nb * 32, SC_W, scr, F.lane); }
            continue; }
        r -= I_E;
        if (r < I_IN) { const int kb = r / 224, nb = r % 224; transpose_item8(a.w_in, INW, ws + WS_WIN, 1024, kb * 64, nb * 32, rowmap_in(nb * 32), SC_W, scr, F.lane); continue; }
        r -= I_IN;
        if (r < I_O) { const int kb = r >> 5, nb = r & 31; transpose_item(a.w_o, 1024, Wo_t, 1024, kb * 64, nb * 32, nb * 32, scr, F.lane); continue; }
        r -= I_O;
        if (r < I_R) { const int kb = r >> 3, nb = r & 7; transpose_item(a.w_router, 256, Wr_t, 1024, kb * 64, nb * 32, nb * 32, scr, F.lane); continue; }
        r -= I_R;
        { const int g = r >> 2, wx = (r >> 1) & 1, hf = r & 1;
          transpose_item((wx ? a.lru_wx : a.lru_wa) + (size_t)g * 4096, 64, Wlru, 64, 0, hf * 32, (g * 2 + hf) * 64 + (wx ? 32 : 0), scr, F.lane); }
    }
}

struct ExpertConvHook {
    static constexpr int NSLICE = 8;
    LAS unsigned char* lds;
    __device__ __forceinline__ void operator()(int s) const {
        const int G = (int)gridDim.x, bx = (int)blockIdx.x, vcu = (G % 8 == 0) ? (bx % 8) * (G / 8) + bx / 8 : bx;
        int tdx = (int)threadIdx.x; asm volatile("" : "+v"(tdx));
        const int wave = __builtin_amdgcn_readfirstlane(tdx >> 6), lane = tdx & 63;
        LAS float* scr = (LAS float*)(lds + RING_OFF + wave * 16384);
        const volatile LAS unsigned* pt = (const volatile LAS unsigned*)(lds + LDSCTL_OFF + 1536);
#define ECH_PTR(i) ((GAS unsigned char*)(((unsigned long long)(unsigned)__builtin_amdgcn_readfirstlane(pt[2 * (i) + 1]) << 32) | (unsigned)__builtin_amdgcn_readfirstlane(pt[2 * (i)])))
        unsigned char* ws = (unsigned char*)ECH_PTR(32);
        constexpr int I_E = 384 * 257;
        const int gw = vcu * NWAVES + wave, NGW = G * NWAVES, KIT = (I_E + NGW - 1) / NGW;
#define ECH_DEC(r_, S, LDN, Dp, LDK) do { const int e_ = (r_) / 384, q_ = (r_) % 384, wh_ = q_ >> 7, ii_ = q_ & 127; \
            if (wh_ < 2) { const int kb_ = ii_ >> 3, n0_ = (ii_ & 7) * 32; S = ((e_ < 256) ? ((const float*)ECH_PTR(wh_ ? 26 : 25) + (size_t)e_ * 262144) : (const float*)ECH_PTR(wh_ ? 29 : 28)) + (size_t)(kb_ * 64) * 256 + n0_; LDN = 256; \
                Dp = ws + WS_WEGU + (size_t)e_ * 524288 + (size_t)(256 * (n0_ >> 7) + (wh_ ? 128 : 0) + (n0_ & 127)) * 1024 + kb_ * 64; LDK = 1024; } \
            else { const int kb_ = ii_ >> 5, nb_ = ii_ & 31; S = ((e_ < 256) ? ((const float*)ECH_PTR(27) + (size_t)e_ * 262144) : (const float*)ECH_PTR(30)) + (size_t)(kb_ * 64) * 1024 + nb_ * 32; LDN = 1024; \
                Dp = ws + WS_WED + (size_t)e_ * 262144 + (size_t)(nb_ * 32) * 256 + kb_ * 64; LDK = 256; } } while (0)
#define ECH_LOAD(v, S, LDN) do { const unsigned lo_ = (unsigned)((lane >> 5) * LDN + (lane & 31));        \
            _Pragma("unroll") for (int i = 0; i < 32; ++i) v[i] = __builtin_nontemporal_load((const GAS float*)S + (size_t)(2 * i) * (unsigned)LDN + lo_); } while (0)
#define ECH_STORE(v, Dp, LDK) do { _Pragma("unroll") for (int i = 0; i < 32; ++i) { const int kk = 2 * i + (lane >> 5); scr[kk * 33 + (lane & 31)] = v[i] * SC_W; } \
            LDS_WAIT(); asm volatile("" ::: "memory"); \
            { const int c = lane & 3; _Pragma("unroll") for (int j = 0; j < 2; ++j) { const int n = (lane >> 2) + 16 * j; const LAS float* s_ = scr + (16 * c) * 33 + n; v4u o; \
                o.x = pk4_fp8(s_[0 * 33], s_[1 * 33], s_[2 * 33], s_[3 * 33]); o.y = pk4_fp8(s_[4 * 33], s_[5 * 33], s_[6 * 33], s_[7 * 33]); \
                o.z = pk4_fp8(s_[8 * 33], s_[9 * 33], s_[10 * 33], s_[11 * 33]); o.w = pk4_fp8(s_[12 * 33], s_[13 * 33], s_[14 * 33], s_[15 * 33]); \
                *(GAS v4u*)(Dp + (size_t)n * LDK + 16 * c) = o; } } \
            LDS_WAIT(); asm volatile("" ::: "memory"); } while (0)
        int k = KIT * s / NSLICE; const int k1 = KIT * (s + 1) / NSLICE; int nk = 0; while (k + nk < k1 && gw + (k + nk) * NGW < I_E) ++nk;
        float vA[32], vB[32]; const float *sA = nullptr, *sB = nullptr; unsigned char *dA = nullptr, *dB = nullptr; int lnA = 0, lnB = 0, lkA = 0, lkB = 0;
        if (nk > 0) { ECH_DEC(gw + k * NGW, sA, lnA, dA, lkA); ECH_LOAD(vA, sA, lnA); }
        for (int j = 0; j < nk; j += 2) {
            if (j + 1 < nk) { ECH_DEC(gw + (k + j + 1) * NGW, sB, lnB, dB, lkB); ECH_LOAD(vB, sB, lnB); }
            ECH_STORE(vA, dA, lkA);
            if (j + 2 < nk) { ECH_DEC(gw + (k + j + 2) * NGW, sA, lnA, dA, lkA); ECH_LOAD(vA, sA, lnA); }
            if (j + 1 < nk) { ECH_STORE(vB, dB, lkB); } }
#undef ECH_DEC
#undef ECH_LOAD
#undef ECH_STORE
#undef ECH_PTR
        __syncthreads();
    }
};

__device__ __forceinline__ void norm_mod_phase(Frame& F, const float* src, const float* gvec, const float* mod, int off_shift, int off_scale, bf16* dst, unsigned char* dst8) {
    const int gw = F.vcu * NWAVES + F.wave, NGW = F.G * NWAVES;
    for (int blk = gw; blk < T / 16; blk += NGW) {
        const int row0 = blk * 16, b = row0 >> 12; const float* mp = mod + (size_t)b * 6144;
        f32x4 g[4], sc[4], sh[4];
#pragma unroll
        for (int j = 0; j < 4; ++j) { const int col = 4 * F.lane + 256 * j; g[j] = *(const GAS f32x4*)(gvec + col); sc[j] = *(const GAS f32x4*)(mp + off_scale + col) + 1.0f; sh[j] = *(const GAS f32x4*)(mp + off_shift + col); }
        for (int r = 0; r < 16; ++r) {
            const GAS f32x4* xr = (const GAS f32x4*)(src + (size_t)(row0 + r) * D) + F.lane;
            f32x4 v[4]; float s = 0.f;
#pragma unroll
            for (int j = 0; j < 4; ++j) { v[j] = xr[64 * j]; s += (v[j].x * v[j].x + v[j].y * v[j].y) + (v[j].z * v[j].z + v[j].w * v[j].w); }
            const float rstd = 1.0f / sqrtf(wave_sum(s) * (1.0f / D) + EPS);
            GAS unsigned long long* o8 = (GAS unsigned long long*)(dst + (size_t)(row0 + r) * D) + F.lane;
#pragma unroll
            for (int j = 0; j < 4; ++j) { const f32x4 y = (v[j] * rstd * g[j]) * sc[j] + sh[j];
                if (dst) o8[64 * j] = (unsigned long long)pk2(y.x, y.y) | ((unsigned long long)pk2(y.z, y.w) << 32);
                if (dst8) *((GAS unsigned*)(dst8 + (size_t)(row0 + r) * D) + F.lane + 64 * j) = pk4_fp8(y.x * SC_H, y.y * SC_H, y.z * SC_H, y.w * SC_H); }
        }
    }
}

struct LruArgs { const bf16* XR; const bf16* GAR; const bf16* YB; bf16* MIX; const bf16* Wlru;
    const float *conv_w, *conv_b, *lru_ba, *lru_bx, *c8sp; };
__device__ __forceinline__ void lru_phase(Frame& F, const LruArgs& a) {
    typedef short bf16x8v __attribute__((ext_vector_type(8)));
    LAS unsigned char* L = F.lds;
    LAS unsigned char* At = L;
    LAS float* AGG = (LAS float*)(L + 36864);
    LAS unsigned char* HT = L + 38912;
    const int tid = F.tid, lane = F.lane, w = F.wave, fr = lane & 15, fq = lane >> 4, cp = tid & 31, sub = tid >> 5;
    for (int u = F.vcu; u < 256; u += F.G) {
        const int b = u >> 5, g = (u >> 1) & 15, hf = u & 1;
        bf16x8v bfr[4][2];
        { const bf16* wl = a.Wlru + (size_t)((g * 2 + hf) * 64) * 64;
#pragma unroll
          for (int nb = 0; nb < 4; ++nb)
#pragma unroll
              for (int kk = 0; kk < 2; ++kk) bfr[nb][kk] = *(const GAS bf16x8v*)(wl + (nb * 16 + fr) * 64 + kk * 32 + fq * 8); }
        const int chc = g * 64 + 2 * cp;
        float cw[4][2], cb[2];
#pragma unroll
        for (int tp = 0; tp < 4; ++tp) { cw[tp][0] = a.conv_w[tp * 1024 + chc]; cw[tp][1] = a.conv_w[tp * 1024 + chc + 1]; }
        cb[0] = a.conv_b[chc]; cb[1] = a.conv_b[chc + 1];
        float ba2[2], bx2[2], c8[2];
#pragma unroll
        for (int nbp = 0; nbp < 2; ++nbp) { const int ch = g * 64 + hf * 32 + 16 * nbp + fr; ba2[nbp] = a.lru_ba[ch]; bx2[nbp] = a.lru_bx[ch]; c8[nbp] = a.c8sp[ch] * 1.4426950408889634f; }
        float carry[2] = {0.f, 0.f};
        const bf16* xr = a.XR + (size_t)b * SEQ * D + chc;
        unsigned xraw[19];
#pragma unroll
        for (int j = 0; j < 19; ++j) { const int t = 16 * sub - 3 + j; xraw[j] = (t >= 0) ? *(const GAS unsigned*)(xr + (size_t)t * D) : 0u; }
        const int part = tid & 3;
        for (int it = 0; it < 16; ++it) {
            const int t0 = it * 256;
            { float x0[19], x1[19];
#pragma unroll
              for (int j = 0; j < 19; ++j) { x0[j] = bflo(xraw[j]); x1[j] = bfhi(xraw[j]); }
#pragma unroll
              for (int j = 0; j < 16; ++j) {
                  const float y0 = cb[0] + cw[0][0] * x0[j] + cw[1][0] * x0[j + 1] + cw[2][0] * x0[j + 2] + cw[3][0] * x0[j + 3];
                  const float y1 = cb[1] + cw[0][1] * x1[j] + cw[1][1] * x1[j + 1] + cw[2][1] * x1[j + 2] + cw[3][1] * x1[j + 3];
                  *(LAS unsigned*)(At + (16 * sub + j) * 144 + 4 * cp) = pk2(y0, y1); } }
            if (it + 1 < 16) {
#pragma unroll
                for (int j = 0; j < 19; ++j) { const int t = t0 + 256 + 16 * sub - 3 + j; xraw[j] = *(const GAS unsigned*)(xr + (size_t)t * D); } }
            v4u garv[2], ybv[2];
#pragma unroll
            for (int j = 0; j < 2; ++j) { const size_t go = (size_t)(b * SEQ + t0 + (tid >> 2) + 128 * j) * D + g * 64 + hf * 32 + part * 8; garv[j] = *(const GAS v4u*)(a.GAR + go); ybv[j] = *(const GAS v4u*)(a.YB + go); }
            LBAR();
            float hl[2][2][4], pl[2][2][4], Pw[2][2], Hw[2][2], Pe[2][2], He[2][2];
#pragma unroll
            for (int sb = 0; sb < 2; ++sb) {
                f32x4 acc[4];
                { const int row = 32 * w + 16 * sb + fr;
                  const bf16x8v a0 = *(const LAS bf16x8v*)(At + row * 144 + fq * 16), a1 = *(const LAS bf16x8v*)(At + row * 144 + 64 + fq * 16);
#pragma unroll
                  for (int nb = 0; nb < 4; ++nb) { acc[nb] = __builtin_amdgcn_mfma_f32_16x16x32_bf16(a0, bfr[nb][0], (f32x4){0.f, 0.f, 0.f, 0.f}, 0, 0, 0);
                      acc[nb] = __builtin_amdgcn_mfma_f32_16x16x32_bf16(a1, bfr[nb][1], acc[nb], 0, 0, 0); } }
#pragma unroll
                for (int nbp = 0; nbp < 2; ++nbp) { float h = 0.f, p = 1.f;
#pragma unroll
                    for (int rg = 0; rg < 4; ++rg) { const int tk = 32 * w + 16 * sb + 4 * fq + rg;
                        const float xcv = bf2f(*(const LAS unsigned short*)(At + tk * 144 + (hf * 32 + 16 * nbp + fr) * 2));
                        const float r = sigm(acc[nbp][rg] + ba2[nbp]), ig = sigm(acc[2 + nbp][rg] + bx2[nbp]);
                        const float av = __builtin_amdgcn_exp2f(-r * c8[nbp]), mu = __builtin_amdgcn_sqrtf(__builtin_fmaf(-av, av, 1.0f)), uu = mu * ig * xcv;
                        h = av * h + uu; p = p * av; hl[sb][nbp][rg] = h; pl[sb][nbp][rg] = p; }
                    float Pp = __shfl(p, lane - 16), Hp = __shfl(h, lane - 16);
                    if (fq >= 1) { h = p * Hp + h; p = p * Pp; }
                    Pp = __shfl(p, lane - 32); Hp = __shfl(h, lane - 32);
                    if (fq >= 2) { h = p * Hp + h; p = p * Pp; }
                    Pw[sb][nbp] = __shfl(p, 48 + fr); Hw[sb][nbp] = __shfl(h, 48 + fr);
                    Pp = __shfl(p, lane - 16); Hp = __shfl(h, lane - 16);
                    Pe[sb][nbp] = fq >= 1 ? Pp : 1.f; He[sb][nbp] = fq >= 1 ? Hp : 0.f; } }
            if (fq == 3) {
#pragma unroll
                for (int nbp = 0; nbp < 2; ++nbp) { AGG[(w * 32 + 16 * nbp + fr) * 2] = Pw[0][nbp] * Pw[1][nbp]; AGG[(w * 32 + 16 * nbp + fr) * 2 + 1] = Pw[1][nbp] * Hw[0][nbp] + Hw[1][nbp]; } }
            LBAR();
#pragma unroll
            for (int nbp = 0; nbp < 2; ++nbp) { float c = carry[nbp], cwv = 0.f;
#pragma unroll
                for (int w2 = 0; w2 < 8; ++w2) { const float Pa = AGG[(w2 * 32 + 16 * nbp + fr) * 2], Ha = AGG[(w2 * 32 + 16 * nbp + fr) * 2 + 1]; if (w2 == w) cwv = c; c = Pa * c + Ha; }
                carry[nbp] = c;
#pragma unroll
                for (int sb = 0; sb < 2; ++sb) { const float cin = sb == 0 ? cwv : Pw[0][nbp] * cwv + Hw[0][nbp]; const float hent = He[sb][nbp] + Pe[sb][nbp] * cin;
#pragma unroll
                    for (int rg = 0; rg < 4; ++rg) { const float hf_ = hl[sb][nbp][rg] + pl[sb][nbp][rg] * hent;
                        *(LAS unsigned short*)(HT + (32 * w + 16 * sb + 4 * fq + rg) * 80 + (16 * nbp + fr) * 2) = (unsigned short)f2bf(hf_); } } }
            LBAR();
#pragma unroll
            for (int j = 0; j < 2; ++j) { const int tk = (tid >> 2) + 128 * j; const v4u hv = *(const LAS v4u*)(HT + tk * 80 + part * 16); const v4u gv = garv[j], yv = ybv[j]; v4u o;
#pragma unroll
              for (int k = 0; k < 4; ++k) o[k] = pk2(bflo(hv[k]) * bflo(gv[k]) + bflo(yv[k]), bfhi(hv[k]) * bfhi(gv[k]) + bfhi(yv[k]));
              *(GAS v4u*)(a.MIX + (size_t)(b * SEQ + t0 + tk) * D + g * 64 + hf * 32 + part * 8) = o; }
        }
        LBAR();
    }
}

struct MixArgs { const bf16 *O0, *O1, *GB; bf16* MIX; const float *lq1, *lk1, *lq2, *lk2, *subln_g; };
__device__ __forceinline__ void mix_phase(Frame& F, const MixArgs& a) {
    const int gw = F.vcu * NWAVES + F.wave, NGW = F.G * NWAVES, lane = F.lane;
    const float lam = __expf(wave_sum(a.lq1[lane] * a.lk1[lane])) - __expf(wave_sum(a.lq2[lane] * a.lk2[lane])) + 0.2f;
    float sg[16];
#pragma unroll
    for (int i = 0; i < 16; ++i) sg[i] = a.subln_g[16 * (lane & 7) + i] * 0.8f;
    for (int blk = gw; blk < T / 16; blk += NGW) {
        for (int r = 0; r < 16; ++r) {
            const size_t off = (size_t)(blk * 16 + r) * D + 16 * lane;
            v4u o0[2], o1[2], gb[2], mx[2];
#pragma unroll
            for (int q = 0; q < 2; ++q) { o0[q] = *(const GAS v4u*)(a.O0 + off + 8 * q); o1[q] = *(const GAS v4u*)(a.O1 + off + 8 * q); gb[q] = *(const GAS v4u*)(a.GB + off + 8 * q); mx[q] = *(const GAS v4u*)(a.MIX + off + 8 * q); }
            float o[16]; float ss = 0.f;
#pragma unroll
            for (int q = 0; q < 2; ++q)
#pragma unroll
                for (int k = 0; k < 4; ++k) { const float lo = bflo(o0[q][k]) - lam * bflo(o1[q][k]), hi = bfhi(o0[q][k]) - lam * bfhi(o1[q][k]); o[8 * q + 2 * k] = lo; o[8 * q + 2 * k + 1] = hi; ss += lo * lo + hi * hi; }
            ss += __shfl_xor(ss, 1); ss += __shfl_xor(ss, 2); ss += __shfl_xor(ss, 4);
            const float rstd = 1.0f / sqrtf(ss * (1.0f / 128.0f) + EPS);
            v4u out[2];
#pragma unroll
            for (int q = 0; q < 2; ++q)
#pragma unroll
                for (int k = 0; k < 4; ++k) { const int i0 = 8 * q + 2 * k;
                    const float lo = bflo(mx[q][k]) + sigm(bflo(gb[q][k])) * (o[i0] * rstd * sg[i0]), hi = bfhi(mx[q][k]) + sigm(bfhi(gb[q][k])) * (o[i0 + 1] * rstd * sg[i0 + 1]);
                    out[q][k] = pk2(lo, hi); }
#pragma unroll
            for (int q = 0; q < 2; ++q) *(GAS v4u*)(a.MIX + off + 8 * q) = out[q];
        }
    }
}

__device__ __forceinline__ unsigned wave_max_u32(unsigned v) {
    unsigned t;
    t = (unsigned)__builtin_amdgcn_update_dpp(0, (int)v, 0xB1, 0xF, 0xF, false); v = v > t ? v : t;
    t = (unsigned)__builtin_amdgcn_update_dpp(0, (int)v, 0x4E, 0xF, 0xF, false); v = v > t ? v : t;
    t = (unsigned)__builtin_amdgcn_update_dpp(0, (int)v, 0x141, 0xF, 0xF, false); v = v > t ? v : t;
    t = (unsigned)__builtin_amdgcn_update_dpp(0, (int)v, 0x140, 0xF, 0xF, false); v = v > t ? v : t;
    t = (unsigned)__builtin_amdgcn_update_dpp(0, (int)v, 0x142, 0xA, 0xF, false); v = v > t ? v : t;
    t = (unsigned)__builtin_amdgcn_update_dpp(0, (int)v, 0x143, 0xC, 0xF, false); v = v > t ? v : t;
    return (unsigned)__builtin_amdgcn_readlane((int)v, 63);
}
__device__ __forceinline__ void topk_phase(Frame& F, const float* logits, const float* rbias, v4u* rec, int* posm, gu32* cnt) {
    LAS unsigned* hist = (LAS unsigned*)F.lds;
    LAS unsigned* baseL = hist + 256;
    LAS int* ek = (LAS int*)(hist + 512);
    LAS int* rk = ek + 1024;
    LAS float* gk = (LAS float*)(rk + 1024);
    const int lane = F.lane;
    const f32x4 bias = *(const GAS f32x4*)(rbias + 4 * lane);
    for (int tb = F.vcu; tb < T / 128; tb += F.G) {
        for (int i = F.tid; i < 256; i += 512) hist[i] = 0u;
        __syncthreads();
        f32x4 lgn = *(const GAS f32x4*)(logits + (size_t)(tb * 128 + F.wave * 16) * 256 + 4 * lane);
        for (int tl = F.wave * 16; tl < F.wave * 16 + 16; ++tl) {
            const int tok = tb * 128 + tl;
            const f32x4 lg = lgn;
            if (tl + 1 < F.wave * 16 + 16) lgn = *(const GAS f32x4*)(logits + (size_t)(tok + 1) * 256 + 4 * lane);
            const float s0 = sigm(lg.x), s1 = sigm(lg.y), s2 = sigm(lg.z), s3 = sigm(lg.w);
            unsigned k0, k1, k2, k3;
            { const unsigned e0 = 255u - 4u * (unsigned)lane;
#define TK_KEY(S, B, E) ({ const unsigned u_ = __float_as_uint((S) + (B)); (((u_ & 0x80000000u) ? ~u_ : (u_ | 0x80000000u)) & 0xFFFFFF00u) | (E); })
              k0 = TK_KEY(s0, bias.x, e0); k1 = TK_KEY(s1, bias.y, e0 - 1u); k2 = TK_KEY(s2, bias.z, e0 - 2u); k3 = TK_KEY(s3, bias.w, e0 - 3u);
#undef TK_KEY
            }
            int my_e = 0; float my_s = 0.f, ssum = 0.f;
#pragma unroll
            for (int k = 0; k < 8; ++k) {
                const unsigned m01 = k0 > k1 ? k0 : k1, m23 = k2 > k3 ? k2 : k3, ml = m01 > m23 ? m01 : m23;
                const unsigned win = wave_max_u32(ml);
                const int e = 255 - (int)(win & 255u), own = e >> 2, j = e & 3;
                const float sj = j == 0 ? s0 : j == 1 ? s1 : j == 2 ? s2 : s3;
                const float sv = __builtin_bit_cast(float, __builtin_amdgcn_readlane(__builtin_bit_cast(int, sj), own));
                k0 = k0 == win ? 0u : k0; k1 = k1 == win ? 0u : k1; k2 = k2 == win ? 0u : k2; k3 = k3 == win ? 0u : k3;
                ssum += sv;
                if (lane == k) { my_e = e; my_s = sv; }
            }
            if (lane < 8) { const float gte = my_s / ssum * 2.5f; gk[tl * 8 + lane] = gte;
                const unsigned rank = __hip_atomic_fetch_add(&hist[my_e], 1u, __ATOMIC_RELAXED, __HIP_MEMORY_SCOPE_WORKGROUP); ek[tl * 8 + lane] = my_e; rk[tl * 8 + lane] = (int)rank; }
        }
        __syncthreads();
        if (F.tid < 256) { const unsigned h = hist[F.tid]; baseL[F.tid] = h ? __hip_atomic_fetch_add(cnt + F.tid, h, RLX_AGENT) : 0u; }
        __syncthreads();
        for (int i = F.tid; i < 1024; i += 512) { const int e = ek[i], ps = (int)baseL[e] + rk[i], tok = tb * 128 + (i >> 3);
            ((GAS v4u*)rec)[(size_t)e * REC_CAP + ps] = (v4u){0u, __float_as_uint(gk[i]), (unsigned)tok, 0u}; ((GAS int*)posm)[(size_t)tb * 1024 + i] = (e << 16) | ps; }
        if (F.tid < 128) { const int tok = tb * 128 + F.tid; ((GAS v4u*)rec)[(size_t)NEXP * REC_CAP + tok] = (v4u){0u, __float_as_uint(1.0f), (unsigned)tok, 0u}; }
        __syncthreads();
    }
}
__device__ __forceinline__ void expert_prefix(Frame& F, gu32* cnt) {
    LAS int* startL = (LAS int*)(F.lds + PFX_OFF); LAS int* tsL = startL + 258;
    if (__builtin_amdgcn_readfirstlane((int)F.MISC[12]) != 0) return;
    int tid = (int)threadIdx.x; asm volatile("" : "+v"(tid));
    LAS int* cntL = (LAS int*)F.lds; LAS int* segC = cntL + 320; LAS int* segT = segC + 16;
    __syncthreads();
    if (tid < 256) cntL[tid] = (int)__hip_atomic_load(cnt + tid, RLX_AGENT); else if (tid == 256) cntL[256] = T;
    __syncthreads();
    if (tid < 8) { int sc = 0, st = 0; for (int e = 32 * tid; e < 32 * tid + 32; ++e) { sc += cntL[e]; st += (cntL[e] + 255) >> 8; } segC[tid] = sc; segT[tid] = st; }
    __syncthreads();
    if (tid < 258) { const int e = tid, sg = e >> 5; int s = 0, ts = 0;
        for (int w = 0; w < sg && w < 8; ++w) { s += segC[w]; ts += segT[w]; }
        for (int q = (sg < 8 ? sg : 8) * 32; q < e; ++q) { s += cntL[q]; ts += (cntL[q] + 255) >> 8; }
        startL[e] = s; tsL[e] = ts; }
    __syncthreads();
    if (tid == 0) F.MISC[12] = 1u;
    __syncthreads();
}

template <bool GATHER> struct MoeOrder {
    const void* A; const void* Bt; int Kb; int rowsB;
    const LAS int* utab; const LAS int* toktab; int nun, reps;
    __device__ __forceinline__ bool next(int i, pg8::Unit& u) const {
        if (i >= nun * reps) return false; i %= nun;
        u.e = __builtin_amdgcn_readfirstlane(utab[4 * i]); u.row0 = __builtin_amdgcn_readfirstlane(utab[4 * i + 1]); u.nrows = __builtin_amdgcn_readfirstlane(utab[4 * i + 2]); u.pn = __builtin_amdgcn_readfirstlane(utab[4 * i + 3]); u.pm = i; return true; }
    __device__ __forceinline__ const char* a_base(const pg8::Unit& u) const { return GATHER ? (const char*)A : (const char*)A + (size_t)u.row0 * Kb; }
    __device__ __forceinline__ const char* b_base(const pg8::Unit& u) const { return (const char*)Bt + ((size_t)u.e * rowsB + (size_t)u.pn * 256) * Kb; }
    __device__ __forceinline__ void a_voff(const pg8::Unit&, int ui, const int (&R)[2], const int (&C)[2], unsigned (&v)[2][2]) const {
#pragma unroll
        for (int h = 0; h < 2; ++h)
#pragma unroll
            for (int i = 0; i < 2; ++i) v[h][i] = GATHER ? (unsigned)toktab[(ui % nun) * 256 + h * 128 + R[i]] * (unsigned)Kb + (unsigned)(C[i] * 2) : (unsigned)((h * 128 + R[i]) * Kb + C[i] * 2);
    }
    __device__ __forceinline__ void a_ready(const pg8::Unit&) const {}
    __device__ __forceinline__ void done(const pg8::Unit&) const {}
};
struct SharedGU {
    const void* A; const void* Bt; int Kb; int first, stride, n;
    __device__ __forceinline__ bool next(int i, pg8::Unit& u) const { if (i >= n) return false; const int idx = first + i * stride; u.e = NEXP; u.row0 = T * TOPK + 256 * (idx >> 1); u.nrows = 256; u.pn = idx & 1; u.pm = 0; return true; }
    __device__ __forceinline__ const char* a_base(const pg8::Unit& u) const { return (const char*)A + (size_t)(u.row0 - T * TOPK) * Kb; }
    __device__ __forceinline__ const char* b_base(const pg8::Unit& u) const { return (const char*)Bt + ((size_t)NEXP * 512 + (size_t)u.pn * 256) * Kb; }
    __device__ __forceinline__ void a_voff(const pg8::Unit&, int, const int (&R)[2], const int (&C)[2], unsigned (&v)[2][2]) const {
#pragma unroll
        for (int h = 0; h < 2; ++h)
#pragma unroll
            for (int i = 0; i < 2; ++i) v[h][i] = (unsigned)((h * 128 + R[i]) * Kb + C[i] * 2);
    }
    __device__ __forceinline__ void a_ready(const pg8::Unit&) const {}
    __device__ __forceinline__ void done(const pg8::Unit&) const {}
};
template <bool GATHER> __device__ __forceinline__ int moe_tables(Frame& F, gu32* cnt, const v4u* rec, int shift, int skip_tail = 0) {
    LAS int* utab = (LAS int*)(F.lds + UT_OFF); LAS int* toktab = (LAS int*)(F.lds + TOK_OFF); LAS int* bkt = (LAS int*)(F.lds + PFX_OFF + 2064);
    expert_prefix(F, cnt);
    const LAS int* startL = (const LAS int*)(F.lds + PFX_OFF); const LAS int* tsL = startL + 258;
    const int total = (__builtin_amdgcn_readfirstlane(tsL[257]) - skip_tail) << shift;
    int nun = total > F.vcu ? (total - F.vcu + F.G - 1) / F.G : 0;
    const int cap = GATHER ? MAXU_TOK : MAXU_GT; if (nun > cap) nun = cap;
    __syncthreads();
    if (F.tid < nun) { const int Lu = F.tid * F.G + F.vcu, t = Lu >> shift;
        int lo = 0, hi = 257;
        while (lo < hi) { const int mid = (lo + hi + 1) >> 1; if (tsL[mid] <= t) lo = mid; else hi = mid - 1; }
        const int e = lo, j = t - tsL[e], n = startL[e + 1] - startL[e] - 256 * j;
        utab[4 * F.tid] = e; utab[4 * F.tid + 1] = startL[e] + 256 * j; utab[4 * F.tid + 2] = n < 256 ? n : 256; utab[4 * F.tid + 3] = Lu & ((1 << shift) - 1); bkt[F.tid] = e * REC_CAP + 256 * j; }
    __syncthreads();
    if (GATHER) { for (int idx = F.tid; idx < nun * 256; idx += 512) { const int i = idx >> 8, r = idx & 255, nr = utab[4 * i + 2]; toktab[idx] = (int)((const GAS v4u*)rec)[(size_t)bkt[i] + (r < nr ? r : nr - 1)].z; }
        __syncthreads(); }
    else { LAS unsigned short* gtab = (LAS unsigned short*)(F.lds + TOK_OFF);
        for (int idx = F.tid; idx < nun * 256; idx += 512) { const int i = idx >> 8, r = idx & 255, nr = utab[4 * i + 2];
            const unsigned gb = ((const GAS v4u*)rec)[(size_t)bkt[i] + (r < nr ? r : nr - 1)].y; gtab[idx] = __builtin_bit_cast(unsigned short, (_Float16)__uint_as_float(gb)); }
        __syncthreads(); }
    return nun;
}

__device__ __forceinline__ void combine_phase(Frame& F, const unsigned char* ys, const int* posm, gu32* cnt, const float* mod, float* out) {
    expert_prefix(F, cnt); const LAS int* startL = (const LAS int*)(F.lds + PFX_OFF);
    typedef float f32x2c __attribute__((ext_vector_type(2))); typedef unsigned u32x2c __attribute__((ext_vector_type(2)));
    const int gw = F.vcu * NWAVES + F.wave, NGW = F.G * NWAVES, lane = F.lane;
    for (int blk = gw; blk < T / 16; blk += NGW) {
        const int b = (blk * 16) >> 12; const float* gp = mod + (size_t)b * 6144 + 5120;
        const int pv0 = ((const GAS int*)posm)[(size_t)blk * 128 + lane], pv1 = ((const GAS int*)posm)[(size_t)blk * 128 + 64 + lane];
        f32x4 g2[2][2];
#pragma unroll
        for (int j = 0; j < 2; ++j)
#pragma unroll
            for (int q = 0; q < 2; ++q) g2[j][q] = *(const GAS f32x4*)(gp + 512 * j + 8 * lane + 4 * q) * (1.0f / SC_Y);
        for (int r = 0; r < 16; ++r) { const int tok = blk * 16 + r; const int pvr = r < 8 ? pv0 : pv1;
            float acc[2][8];
#pragma unroll
            for (int j = 0; j < 2; ++j)
#pragma unroll
                for (int i = 0; i < 8; ++i) acc[j][i] = 0.f;
#pragma unroll
            for (int s = 0; s < NSLOT; ++s) { int p = T * TOPK + tok; if (s < TOPK) { const int pk = __builtin_amdgcn_readlane(pvr, (r & 7) * 8 + s); p = startL[pk >> 16] + (pk & 0xFFFF); }
#pragma unroll
                for (int j = 0; j < 2; ++j) { const u32x2c v = *(const GAS u32x2c*)(ys + (size_t)p * D + 512 * j + 8 * lane);
#pragma unroll
                    for (int k = 0; k < 2; ++k) { const f32x2c lo = __builtin_amdgcn_cvt_pk_f32_fp8(v[k], false), hi = __builtin_amdgcn_cvt_pk_f32_fp8(v[k], true);
                        acc[j][4 * k] += lo[0]; acc[j][4 * k + 1] += lo[1]; acc[j][4 * k + 2] += hi[0]; acc[j][4 * k + 3] += hi[1]; } } }
            float* orow = out + (size_t)tok * D;
#pragma unroll
            for (int j = 0; j < 2; ++j)
#pragma unroll
                for (int q = 0; q < 2; ++q) { GAS f32x4* p = (GAS f32x4*)(orow + 512 * j + 8 * lane + 4 * q); const f32x4 x1 = *p;
                    const f32x4 av = {acc[j][4 * q], acc[j][4 * q + 1], acc[j][4 * q + 2], acc[j][4 * q + 3]}; *p = x1 + g2[j][q] * av; }
        }
    }
}
#ifndef MK_N_LAUNCHES
#define MK_N_LAUNCHES 1
#endif
constexpr int NPH = 14;
constexpr int N_LAUNCHES = MK_N_LAUNCHES;
struct Args { const void* in[31]; float* out; unsigned char* ws; int ph_lo, ph_hi; };
#ifndef PHMASK
#define PHMASK 0xFFFF
#endif
#ifndef REPMASK
#define REPMASK 0
#endif
#define REPN(k) (1 + ((REPMASK >> (k)) & 1))
constexpr int PTR_OFF = LDSCTL_OFF + 1536;
__device__ __forceinline__ void* ldptr(LAS unsigned char* lds, int i) {
    const volatile LAS unsigned* p = (const volatile LAS unsigned*)(lds + PTR_OFF) + 2 * i;
    const unsigned lo = __builtin_amdgcn_readfirstlane(p[0]), hi = __builtin_amdgcn_readfirstlane(p[1]);
    return (void*)(GAS void*)(((unsigned long long)hi << 32) | lo);
}
__global__ void __launch_bounds__(NWAVES * 64, 2) fwd_kernel(Args args) {
    extern __shared__ __attribute__((aligned(16))) unsigned char lds[];
    Frame F;
    F.lds = (LAS unsigned char*)lds;
    F.MISC = (volatile LAS unsigned*)(F.lds + MISC_OFF);
    F.tid = threadIdx.x; F.lane = F.tid & 63; F.wave = __builtin_amdgcn_readfirstlane(F.tid >> 6);
    F.G = gridDim.x; { const int bx = blockIdx.x; F.vcu = (F.G % 8 == 0) ? (bx % 8) * (F.G / 8) + bx / 8 : bx; }
    F.ctl = (gu32*)(args.ws + WS_CTL);
    for (int u = F.tid; u < (LDS_BYTES - LDSCTL_OFF) / 4; u += NWAVES * 64) ((LAS unsigned*)(F.lds + LDSCTL_OFF))[u] = 0u;
    __syncthreads();
    if (F.tid < 33) { const void* pv = F.tid < 31 ? args.in[F.tid] : (F.tid == 31 ? (const void*)args.out : (const void*)args.ws);
        ((LAS unsigned long long*)(F.lds + PTR_OFF))[F.tid] = (unsigned long long)pv; }
    __syncthreads();
    XcdBarrier bar; bar.bar = (unsigned*)(F.ctl + CW_BAR); bar.x = 0; bar.st = nullptr;
    if (N_LAUNCHES == 1) bar = xcd_barrier_post((unsigned*)(F.ctl + CW_BAR), F.MISC + 8);
#define GRID_BAR() do { if (N_LAUNCHES == 1) { xcd_barrier(bar); } } while (0)
    const int lo = args.ph_lo, hi = args.ph_hi;
#if defined(PROBE_REGION)
    volatile LAS unsigned long long* const prbp = (blockIdx.x == PROBE_BLOCK && F.wave == PROBE_WAVE) ? (volatile LAS unsigned long long*)(F.lds + MISC_OFF + 96) : nullptr;
#define PRBARG(ph) , (PROBE_PHASE == (ph) ? prbp : nullptr)
#else
#define PRBARG(ph)
#endif
#define IN(k) (((PHMASK >> (k)) & 1) && lo <= (k) && (k) < hi)
#if defined(PROBE_CUM)
    const unsigned long long prb_tstart = __builtin_amdgcn_s_memrealtime(); unsigned long long prb_cum = 0;
#define PRB_CUM(k) do { if (PROBE_CUM == (k)) prb_cum = __builtin_amdgcn_s_memrealtime() - prb_tstart; } while (0)
#else
#define PRB_CUM(k) do {} while (0)
#endif
#define BOTH(k) (IN(k) && IN((k) + 1))
#define INP(i) ((const float*)ldptr(F.lds, (i)))
#define OUTP ((float*)ldptr(F.lds, 31))
#define WSP ((unsigned char*)ldptr(F.lds, 32))

    if (IN(0)) { asm volatile("" : "+v"(F.tid), "+v"(F.lane));
        P0Args a{INP(1), INP(3), INP(4), INP(6), INP(21), INP(23), INP(25), INP(26), INP(27), INP(28), INP(29), INP(30), INP(9), INP(11), INP(13), (const int*)INP(2)};
        unsigned char* ws = WSP;
        for (int rep = 0; rep < REPN(0); ++rep) p0_prologue(F, a, ws);
        if (BOTH(0)) GRID_BAR();
    }
    PRB_CUM(1);
    if (IN(1)) { asm volatile("" : "+v"(F.tid), "+v"(F.lane)); unsigned char* ws = WSP; for (int rep = 0; rep < REPN(1); ++rep) norm_mod_phase(F, INP(0), INP(5), (const float*)(ws + WS_MOD), 0, 1024, nullptr, (unsigned char*)OUTP); if (BOTH(1)) GRID_BAR(); }
    PRB_CUM(2);
    if (IN(2)) { asm volatile("" : "+v"(F.tid), "+v"(F.lane));
        unsigned char* ws = WSP;
        pg8::DenseOrder S; S.init(OUTP, ws + WS_WIN, T, INW, D, F.G, (int)blockIdx.x, REPN(2));
        epi::EpiInProj E{(bf16*)(ws + WS_XR), (bf16*)(ws + WS_GAR), (bf16*)(ws + WS_Q), (bf16*)(ws + WS_K), (bf16*)(ws + WS_V), (bf16*)(ws + WS_GB), INP(14), INP(15), (const float*)(ws + WS_CST), 0.125f * 1.4426950408889634f, 1.0f / (SC_H * SC_W)};
        pg8::gemm_phase<epi::EpiInProj, pg8::DenseOrder, true, true>(F.lds + RING_OFF, D, S, E PRBARG(2));
        if (BOTH(2)) GRID_BAR();
    }
    PRB_CUM(3);
    if (IN(4)) { asm volatile("" : "+v"(F.tid), "+v"(F.lane));
        unsigned char* ws = WSP; attn_body::bf16* O0 = (attn_body::bf16*)OUTP;
        const float lam = __expf(wave_sum(INP(16)[F.lane] * INP(17)[F.lane])) - __expf(wave_sum(INP(18)[F.lane] * INP(19)[F.lane])) + 0.2f;
        const attn_body::AttnTensors AT{(const attn_body::bf16*)(ws + WS_Q), (const attn_body::bf16*)(ws + WS_K), (const attn_body::bf16*)(ws + WS_V), O0, O0 + (size_t)T * D, (const attn_body::bf16*)(ws + WS_GB), INP(20), lam};
        const attn_body::PairOrder S((int)F.G, F.vcu);
        const ExpertConvHook H{F.lds}; attn_body::attn_phase<attn_body::PairOrder, ExpertConvHook>((char*)lds + RING_OFF, AT, S, H, REPN(4));
        GRID_BAR();
    }
    PRB_CUM(4);
    if (IN(3)) { asm volatile("" : "+v"(F.tid), "+v"(F.lane));
        unsigned char* ws = WSP;
        LruArgs a{(const bf16*)(ws + WS_XR), (const bf16*)(ws + WS_GAR), (const bf16*)OUTP + (size_t)T * D, (bf16*)(ws + WS_MIX), (const bf16*)(ws + WS_WLRU), INP(7), INP(8), INP(10), INP(12), (const float*)(ws + WS_C8SP)};
        for (int rep = 0; rep < REPN(3); ++rep) lru_phase(F, a);
        GRID_BAR();
    }
    PRB_CUM(5);
    if (IN(6)) { asm volatile("" : "+v"(F.tid), "+v"(F.lane));
        unsigned char* ws = WSP;
        pg8::DenseOrder S; S.init(ws + WS_MIX, ws + WS_WO, T, D, 2 * D, F.G, (int)blockIdx.x, REPN(6));
        epi::EpiWo E{INP(0), OUTP, (const float*)(ws + WS_MOD) + 2048};
        pg8::gemm_phase<epi::EpiWo, pg8::DenseOrder, true>(F.lds + RING_OFF, 2 * D, S, E);
        if (BOTH(6)) GRID_BAR();
    }
    PRB_CUM(6);
    if (IN(7)) { asm volatile("" : "+v"(F.tid), "+v"(F.lane)); unsigned char* ws = WSP; for (int rep = 0; rep < REPN(7); ++rep) norm_mod_phase(F, OUTP, INP(22), (const float*)(ws + WS_MOD), 3072, 4096, (bf16*)(ws + WS_H2), ws + WS_H28); if (BOTH(7)) GRID_BAR(); }
    PRB_CUM(7);
    if (IN(8)) { asm volatile("" : "+v"(F.tid), "+v"(F.lane));
        unsigned char* ws = WSP;
        pg8::DenseOrder S; S.init((const pg8::bf16_t*)(ws + WS_H2), (const pg8::bf16_t*)(ws + WS_WR), T, NEXP, 2 * D, F.G, (int)blockIdx.x, REPN(8));
        epi::EpiF32 E{(float*)(ws + WS_LOGIT)};
        const bool sh_here = (int)F.G > 128;
        if (!sh_here || (int)blockIdx.x < 128) pg8::gemm_phase<epi::EpiF32, pg8::DenseOrder, false>(F.lds + RING_OFF, 2 * D, S, E);
        if (sh_here && (int)blockIdx.x >= 128) { const int nw = (int)F.G - 128, me = (int)blockIdx.x - 128;
            SharedGU S2{ws + WS_H28, ws + WS_WEGU, D, me, nw, (256 - me + nw - 1) / nw};
            epi::EpiGateUp E2{ws + WS_ACT, ws + WS_DUMP, 1.0f / (SC_H * SC_W), SC_A};
            pg8::gemm_phase<epi::EpiGateUp, SharedGU, true, true>(F.lds + RING_OFF, D, S2, E2); }
        if (BOTH(8)) GRID_BAR();
    }
    PRB_CUM(8);
    if (IN(9)) { asm volatile("" : "+v"(F.tid), "+v"(F.lane)); unsigned char* ws = WSP; topk_phase(F, (const float*)(ws + WS_LOGIT), INP(24), (v4u*)(ws + WS_REC), (int*)(ws + WS_POSM), F.ctl + CW_CNT); if (BOTH(9)) GRID_BAR(); }
    PRB_CUM(9);
    PRB_CUM(10);
    if (IN(11)) { asm volatile("" : "+v"(F.tid), "+v"(F.lane));
        unsigned char* ws = WSP;
        const int nun = moe_tables<true>(F, F.ctl + CW_CNT, (const v4u*)(ws + WS_REC), 1, (int)F.G > 128 ? T / 256 : 0);
        MoeOrder<true> S{ws + WS_H28, ws + WS_WEGU, D, 512, (const LAS int*)(F.lds + UT_OFF), (const LAS int*)(F.lds + TOK_OFF), nun, REPN(11)};
        epi::EpiGateUp E{ws + WS_ACT, ws + WS_DUMP, 1.0f / (SC_H * SC_W), SC_A};
        pg8::gemm_phase<epi::EpiGateUp, MoeOrder<true>, true, true>(F.lds + RING_OFF, D, S, E PRBARG(11));
        if (BOTH(11)) GRID_BAR();
    }
    PRB_CUM(11);
    if (IN(12)) { asm volatile("" : "+v"(F.tid), "+v"(F.lane));
        unsigned char* ws = WSP;
        const int nun = moe_tables<false>(F, F.ctl + CW_CNT, (const v4u*)(ws + WS_REC), 2);
        MoeOrder<false> S{ws + WS_ACT, ws + WS_WED, DEXP, 1024, (const LAS int*)(F.lds + UT_OFF), (const LAS int*)(F.lds + TOK_OFF), nun, REPN(12)};
        epi::EpiDown E{ws + WS_YS, (const LAS unsigned short*)(F.lds + TOK_OFF), ws + WS_DUMP, SC_Y / (SC_A * SC_W)};
        pg8::gemm_phase<epi::EpiDown, MoeOrder<false>, true, true>(F.lds + RING_OFF, DEXP, S, E PRBARG(12));
        if (BOTH(12)) GRID_BAR();
    }
    PRB_CUM(12);
    if (IN(13)) { asm volatile("" : "+v"(F.tid), "+v"(F.lane)); unsigned char* ws = WSP; combine_phase(F, ws + WS_YS, (const int*)(ws + WS_POSM), F.ctl + CW_CNT, (const float*)(ws + WS_MOD), OUTP); }
    PRB_CUM(13);
#if defined(PROBE_CUM)
    if (blockIdx.x == 0 && F.tid == 0) { const unsigned long long t0 = __builtin_amdgcn_s_memrealtime(), dl = prb_cum * PROBE_MULT; while (__builtin_amdgcn_s_memrealtime() - t0 < dl) __builtin_amdgcn_s_sleep(32); }
#endif
#if defined(PROBE_REGION)
    if (prbp) { const unsigned long long t0 = __builtin_amdgcn_s_memrealtime(), dl = *prbp * PROBE_MULT; while (__builtin_amdgcn_s_memrealtime() - t0 < dl) __builtin_amdgcn_s_sleep(32); }
#endif
#undef IN
#undef BOTH
}

extern "C" void kernel_launch(void* const* d_in, const int* in_sizes, int n_in, void* d_out, int out_size, void* d_ws, size_t ws_size, hipStream_t stream) {
    static int grid = 0;
    if (grid == 0) {
        if (n_in != 31 || in_sizes[0] != T * D || out_size != T * D || ws_size < WS_END) { fprintf(stderr, "kernel_launch: unexpected shapes: n_in %d in0 %d out %d ws %zu (need %zu); nothing launched\n", n_in, n_in > 0 ? in_sizes[0] : -1, out_size, ws_size, (size_t)WS_END); grid = -1; return; }
        int dev = 0, cus = 0, per_cu = 0;
        if (hipGetDevice(&dev) != hipSuccess || hipDeviceGetAttribute(&cus, hipDeviceAttributeMultiprocessorCount, dev) != hipSuccess) { fprintf(stderr, "kernel_launch: device query failed\n"); grid = -1; return; }
        if (hipFuncSetAttribute((const void*)fwd_kernel, hipFuncAttributeMaxDynamicSharedMemorySize, LDS_BYTES) != hipSuccess) { fprintf(stderr, "kernel_launch: hipFuncSetAttribute failed\n"); grid = -1; return; }
        if (hipOccupancyMaxActiveBlocksPerMultiprocessor(&per_cu, (const void*)fwd_kernel, NWAVES * 64, LDS_BYTES) != hipSuccess || per_cu < 1)
            fprintf(stderr, "kernel_launch: note: occupancy query reports %d workgroups per CU\n", per_cu);
        (void)hipGetLastError();
        grid = cus;
    }
    if (grid < 0) return;
    if (hipMemsetAsync((char*)d_ws + WS_CTL, 0, CTL_ZERO_BYTES, stream) != hipSuccess) { fprintf(stderr, "kernel_launch: hipMemsetAsync failed\n"); return; }
    Args a{};
    for (int i = 0; i < 31; ++i) a.in[i] = d_in[i];
    a.out = (float*)d_out; a.ws = (unsigned char*)d_ws;
    for (int li = 0; li < N_LAUNCHES; ++li) {
        a.ph_lo = (N_LAUNCHES == 1) ? 0 : li; a.ph_hi = (N_LAUNCHES == 1) ? NPH : li + 1;
        hipLaunchKernelGGL(fwd_kernel, dim3(grid), dim3(NWAVES * 64), LDS_BYTES, stream, a);
        const hipError_t le = hipPeekAtLastError();
        if (le != hipSuccess) { fprintf(stderr, "kernel_launch: launch %d failed: %s\n", li, hipGetErrorName(le)); break; }
    }
}
```

```cpp
#define REPMASK 0
#include <hip/hip_runtime.h>
#include <hip/hip_bf16.h>
#include <cstdio>
#include <cstdint>
#include <cmath>
namespace pg8 {
#define PG8_LAS __attribute__((address_space(3)))
typedef unsigned short bf16_t;
typedef short bf16x8 __attribute__((ext_vector_type(8)));
typedef float f32x4 __attribute__((ext_vector_type(4)));
typedef float f32x2 __attribute__((ext_vector_type(2)));
typedef unsigned u32x4 __attribute__((ext_vector_type(4)));
typedef int v4i32_t __attribute__((ext_vector_type(4)));
typedef int v8i32_t __attribute__((ext_vector_type(8)));
constexpr int BM = 256, BK = 64, HALF = 128, HTB = HALF * BK * 2  , STAGE_BYTES = 8 * HTB, NXCD = 8, WGM = 8;

__host__ __device__ __forceinline__ int lds_byte(int r, int c) { const int st = (r >> 4) * 2 + (c >> 5), rr = r & 15, cc = c & 31, ob = rr * 64 + cc * 2; return st * 1024 + (ob ^ (((ob >> 9) & 1) << 5)); }
__host__ __device__ __forceinline__ void stage_rc(int b, int& R, int& C) { const int st = b / 1024, sb = b % 1024, swz = sb ^ (((sb >> 9) & 1) << 5); R = (st >> 1) * 16 + swz / 64; C = (st & 1) * 32 + (swz % 64) / 2; }
__host__ __device__ __forceinline__ int perm32(int rho) { const int n = rho >> 4, i = rho & 15; return 8 * (i >> 2) + 4 * n + (i & 3); }

__host__ __device__ __forceinline__ int perm64(int R) { const int w = R >> 5, n = (R >> 4) & 1, i = R & 15; return 64 * w + 16 * (i >> 2) + 4 * n + (i & 3); }
struct Unit { int pm, pn, row0, nrows, e; };

__device__ __forceinline__ unsigned cvt_pk_bf16(float lo, float hi) { unsigned r; asm volatile("v_cvt_pk_bf16_f32 %0, %1, %2" : "=v"(r) : "v"(lo), "v"(hi)); return r; }
__device__ __forceinline__ float sigmoidf_fast(float v) { return __builtin_amdgcn_rcpf(1.0f + __builtin_amdgcn_exp2f(-1.4426950408889634f * v)); }

struct DenseOrder {
    const void* A; const void* Bt; int Kb;
    int nM, nN, nwg, G, c, nmine, reps;
    __device__ __forceinline__ void init(const void* A_, const void* Bt_, int M, int N, int Kb_, int G_, int c_, int reps_ = 1) { A = A_; Bt = Bt_; Kb = Kb_; nM = M / BM; nN = N / BM; nwg = nM * nN; G = G_; c = c_; nmine = nwg > c ? (nwg - c + G - 1) / G : 0; reps = reps_; }
    __device__ __forceinline__ bool next(int i, Unit& u) const {
        if (i >= nmine * reps) return false; const long L = (long)(i % nmine) * G + c;
        int wgid = (int)L; { const int q = nwg / NXCD, r = nwg % NXCD, xcd = wgid % NXCD, off = wgid / NXCD; wgid = (xcd < r ? xcd * (q + 1) : r * (q + 1) + (xcd - r) * q) + off; }
        const int nig = WGM * nN, gid = wgid / nig, fm = gid * WGM, gsz = (nM - fm) < WGM ? (nM - fm) : WGM;
        u.pm = fm + ((wgid % nig) % gsz); u.pn = (wgid % nig) / gsz; u.row0 = u.pm * BM; u.nrows = BM; u.e = 0; return true;
    }
    __device__ __forceinline__ const char* a_base(const Unit& u) const { return (const char*)A + (size_t)u.pm * BM * Kb; }
    __device__ __forceinline__ const char* b_base(const Unit& u) const { return (const char*)Bt + (size_t)u.pn * BM * Kb; }
    __device__ __forceinline__ void a_voff(const Unit&, int, const int (&R)[2], const int (&C)[2], unsigned (&v)[2][2]) const {
#pragma unroll
        for (int h = 0; h < 2; ++h)
#pragma unroll
            for (int i = 0; i < 2; ++i) v[h][i] = (unsigned)((h * HALF + R[i]) * Kb + C[i] * 2);
    }
    __device__ __forceinline__ void a_ready(const Unit&) const {}
    __device__ __forceinline__ void done(const Unit&) const {}
};

#if defined(PROBE_REGION)
#define PRB_T0(R) unsigned long long prb_t0_##R = 0; if (PROBE_REGION == R && prb) prb_t0_##R = __builtin_amdgcn_s_memrealtime()
#define PRB_T1(R) do { if (PROBE_REGION == R && prb) *prb += __builtin_amdgcn_s_memrealtime() - prb_t0_##R; } while (0)
#else
#define PRB_T0(R) do {} while (0)
#define PRB_T1(R) do {} while (0)
#endif
template <class E, class = void> struct epi_nst { static constexpr int maxv = 0; static __device__ __forceinline__ int get(const E&, const Unit&) { return 0; } };
template <class E> struct epi_nst<E, decltype((void)E::NSTMAX)> { static constexpr int maxv = E::NSTMAX; static __device__ __forceinline__ int get(const E& e, const Unit& u) { return e.nst(u); } };
template <int N> __device__ __forceinline__ void wait_vm() { asm volatile("s_waitcnt vmcnt(%0)" :: "n"(N) : "memory"); }
template <class Epi, class Sched, bool ALIGN_EPI, bool FP8 = false>
__device__ __forceinline__ void gemm_phase(PG8_LAS unsigned char* lds, const int Kb, const Sched& S, const Epi& E, volatile PG8_LAS unsigned long long* prb = nullptr) {
    const int tid = threadIdx.x, wid = __builtin_amdgcn_readfirstlane(tid >> 6), lane = tid & 63, wr = wid >> 2, wc = wid & 3, fr = lane & 15, fq = lane >> 4;
    const int nt = Kb / 128;
    constexpr int NSTMAX = epi_nst<Epi>::maxv; int pnst = 0;
    int Rs[2], Cs[2]; unsigned voffB[2];
#pragma unroll
    for (int i = 0; i < 2; ++i) { stage_rc(tid * 16 + i * 8192, Rs[i], Cs[i]); const int Rb = (int)Epi::PERM == 2 ? perm64(Rs[i]) : Epi::PERM ? ((Rs[i] & ~31) + perm32(Rs[i] & 31)) : Rs[i];
        voffB[i] = (unsigned)(Rb * Kb + Cs[i] * 2); }
    const size_t kstep = (size_t)(BK * 2);
    const size_t hstep = (size_t)((int)Epi::PERM == 2 ? 8 : HALF) * Kb;
    const unsigned ldsw = (unsigned)wid * 1024u;
    const int aoff = FP8 ? lds_byte(wr * 64 + fr, fq * 16) : lds_byte(wr * 64 + fr, fq * 8), boff = FP8 ? lds_byte(wc * 32 + fr, fq * 16) : lds_byte(wc * 32 + fr, fq * 8);
#define PG8_SA(b, h) (((b) * 2 + (h)) * HTB)
#define PG8_SB(b, h) ((4 + (b) * 2 + (h)) * HTB)
#define PG8_STAGE(bufoff, gbase, voff) do { _Pragma("unroll") for (int _i = 0; _i < 2; ++_i) \
        __builtin_amdgcn_global_load_lds((const unsigned*)((const char*)(gbase) + (voff)[_i]), (PG8_LAS unsigned*)(lds + (bufoff) + ldsw + _i * 8192), 16, 0, 0); } while (0)
#define PG8_LDA(dst, b, h) do { _Pragma("unroll") for (int m = 0; m < 4; ++m) _Pragma("unroll") for (int k = 0; k < 2; ++k) dst[m][k] = *(const PG8_LAS bf16x8*)(lds + PG8_SA(b, h) + aoff + m * 2048 + k * (FP8 ? 16 : 1024)); } while (0)
#define PG8_LDB(dst, b, h) do { _Pragma("unroll") for (int n = 0; n < 2; ++n) _Pragma("unroll") for (int k = 0; k < 2; ++k) dst[n][k] = *(const PG8_LAS bf16x8*)(lds + PG8_SB(b, h) + boff + n * 2048 + k * (FP8 ? 16 : 1024)); } while (0)
#define PG8_F8(x) __builtin_shufflevector(__builtin_bit_cast(v4i32_t, x[0]), __builtin_bit_cast(v4i32_t, x[1]), 0, 1, 2, 3, 4, 5, 6, 7)
#define PG8_MFMA8(ACC, A8, B8) asm volatile("v_mfma_f32_16x16x128_f8f6f4 %0, %1, %2, %0" : "+v"(ACC) : "v"(A8), "v"(B8))
#define PG8_MMA(ai, bj, At, Bt) do { __builtin_amdgcn_s_setprio(1); if constexpr (FP8) { _Pragma("unroll") for (int n = 0; n < 2; ++n) { const v8i32_t b8 = PG8_F8(Bt[n]); _Pragma("unroll") for (int m = 0; m < 4; ++m) { const v8i32_t a8 = PG8_F8(At[m]); PG8_MFMA8(acc[ai][bj][m][n], b8, a8); } } } else { \
        _Pragma("unroll") for (int m = 0; m < 4; ++m) _Pragma("unroll") for (int n = 0; n < 2; ++n) _Pragma("unroll") for (int k = 0; k < 2; ++k) \
        acc[ai][bj][m][n] = __builtin_amdgcn_mfma_f32_16x16x32_bf16(Bt[n][k], At[m][k], acc[ai][bj][m][n], 0, 0, 0); } __builtin_amdgcn_s_setprio(0); } while (0)
#define PG8_MFMA8Z(ACC, A8, B8) asm volatile("v_mfma_f32_16x16x128_f8f6f4 %0, %1, %2, 0" : "=&v"(ACC) : "v"(A8), "v"(B8))
#define PG8_MMA0(ai, bj, At, Bt) do { __builtin_amdgcn_s_setprio(1); if constexpr (FP8) { _Pragma("unroll") for (int n = 0; n < 2; ++n) { const v8i32_t b8 = PG8_F8(Bt[n]); _Pragma("unroll") for (int m = 0; m < 4; ++m) { const v8i32_t a8 = PG8_F8(At[m]); PG8_MFMA8Z(acc[ai][bj][m][n], b8, a8); } } } else { \
        _Pragma("unroll") for (int m = 0; m < 4; ++m) _Pragma("unroll") for (int n = 0; n < 2; ++n) { \
        acc[ai][bj][m][n] = __builtin_amdgcn_mfma_f32_16x16x32_bf16(Bt[n][0], At[m][0], (f32x4){0.f, 0.f, 0.f, 0.f}, 0, 0, 0); acc[ai][bj][m][n] = __builtin_amdgcn_mfma_f32_16x16x32_bf16(Bt[n][1], At[m][1], acc[ai][bj][m][n], 0, 0, 0); } } __builtin_amdgcn_s_setprio(0); } while (0)
#define PG8_MFMA_DRAIN do { if constexpr (FP8) { asm volatile("s_nop 15\n\ts_nop 15" ::: "memory"); __builtin_amdgcn_sched_barrier(0); } } while (0)
#define PG8_WAIT_V(n) asm volatile("s_waitcnt vmcnt(" #n ")" ::: "memory")
#define PG8_WAIT_L(n) asm volatile("s_waitcnt lgkmcnt(" #n ")" ::: "memory")
#define PG8_BAR __builtin_amdgcn_s_barrier()
#define PG8_SCHED __builtin_amdgcn_sched_barrier(0)
    Unit cur, nxt; int ui = 0;
    if (!S.next(0, cur)) return;
    f32x4 acc[2][2][4][2];
#pragma unroll
    for (int a = 0; a < 2; ++a)
#pragma unroll
        for (int b = 0; b < 2; ++b)
#pragma unroll
            for (int m = 0; m < 4; ++m)
#pragma unroll
                for (int n = 0; n < 2; ++n) acc[a][b][m][n] = (f32x4){0.f, 0.f, 0.f, 0.f};
    bf16x8 At[4][2], B0[2][2], B1[2][2];
    int sc127 = 0x7F7F7F7F; asm volatile("" : "+v"(sc127));
    unsigned vA[2][2], vN[2][2];
    S.a_voff(cur, 0, Rs, Cs, vA);
    const char* cA = S.a_base(cur); const char* cB = S.b_base(cur);
    typename Epi::Pre pre; E.prefetch(cur, wr, fr, pre);
    S.a_ready(cur);
    PG8_STAGE(PG8_SB(0, 0), cB, voffB); PG8_STAGE(PG8_SB(0, 1), cB + hstep, voffB); PG8_STAGE(PG8_SA(0, 0), cA, vA[0]); PG8_STAGE(PG8_SA(0, 1), cA, vA[1]);
    if (wr == 1) PG8_BAR;
    PG8_WAIT_V(2); PG8_BAR;
    PG8_STAGE(PG8_SB(1, 0), cB + kstep, voffB); PG8_STAGE(PG8_SA(1, 0), cA + kstep, vA[0]); PG8_STAGE(PG8_SB(1, 1), cB + hstep + kstep, voffB); PG8_STAGE(PG8_SA(1, 1), cA + kstep, vA[1]);
    PG8_WAIT_V(8); PG8_BAR;
    for (;;) {
        const bool has_next = S.next(ui + 1, nxt);
        const char* nA = cA; const char* nB = cB;
#pragma unroll
        for (int h = 0; h < 2; ++h)
#pragma unroll
            for (int i = 0; i < 2; ++i) vN[h][i] = vA[h][i];
        if (has_next) { nA = S.a_base(nxt); nB = S.b_base(nxt); S.a_voff(nxt, ui + 1, Rs, Cs, vN); }
        PRB_T0(3);
#pragma unroll 1
        for (int t = 0; t < nt; t += 2) {
            const bool last = (t == nt - 2);
            const int rl = (NSTMAX > 0 && t == 0) ? pnst : 0;
#define PG8_WAIT_R(B) do { if (NSTMAX >= 16 && rl == 16) wait_vm<(B) + 16>(); else if (NSTMAX >= 8 && rl >= 8) wait_vm<(B) + 8>(); else PG8_WAIT_V(8); } while (0)
            const char* a1 = cA + (size_t)(t + 1) * kstep;
            const char* a2 = last ? nA : cA + (size_t)(t + 2) * kstep; const char* b2 = last ? nB : cB + (size_t)(t + 2) * kstep;
            const char* a3 = a2 + kstep; const char* b3 = b2 + kstep;
            unsigned v2[2][2];
#pragma unroll
            for (int h = 0; h < 2; ++h)
#pragma unroll
                for (int i = 0; i < 2; ++i) v2[h][i] = last ? vN[h][i] : vA[h][i];
            if (last && has_next) S.a_ready(nxt);
            PG8_LDB(B0, 0, 0); PG8_LDB(B1, 0, 1); PG8_SCHED; PG8_LDA(At, 0, 0); if (t > 0) { PG8_STAGE(PG8_SA(1, 1), a1, vA[1]); }
            PRB_T0(2); PG8_WAIT_R(10); PG8_WAIT_L(0); PG8_BAR; if (t == 0) PRB_T1(2); if (t == 0) { PG8_MMA0(0, 0, At, B0); PG8_MMA0(0, 1, At, B1); } else { PG8_MMA(0, 0, At, B0); PG8_MMA(0, 1, At, B1); } PG8_BAR; PG8_SCHED;
            PG8_LDA(At, 0, 1); PG8_STAGE(PG8_SB(0, 0), b2, voffB); PG8_STAGE(PG8_SB(0, 1), b2 + hstep, voffB); PG8_STAGE(PG8_SA(0, 0), a2, v2[0]);
            PG8_WAIT_R(14); PG8_WAIT_L(0); PG8_BAR; if (t == 0) { PG8_MMA0(1, 0, At, B0); PG8_MMA0(1, 1, At, B1); } else { PG8_MMA(1, 0, At, B0); PG8_MMA(1, 1, At, B1); } PG8_BAR; PG8_SCHED;
            PG8_LDB(B0, 1, 0); PG8_LDB(B1, 1, 1); PG8_SCHED; PG8_LDA(At, 1, 0); PG8_STAGE(PG8_SA(0, 1), a2, v2[1]);
            PG8_WAIT_R(10); PG8_WAIT_L(0); PG8_BAR; PG8_MMA(0, 0, At, B0); PG8_MMA(0, 1, At, B1); PG8_BAR; PG8_SCHED;
            PG8_LDA(At, 1, 1); PG8_STAGE(PG8_SB(1, 0), b3, voffB); PG8_STAGE(PG8_SB(1, 1), b3 + hstep, voffB); PG8_STAGE(PG8_SA(1, 0), a3, v2[0]);
            PG8_WAIT_R(14); PG8_WAIT_L(0); PG8_BAR; PG8_MMA(1, 0, At, B0); PG8_MMA(1, 1, At, B1); PG8_BAR; PG8_SCHED;
        }
        PG8_STAGE(PG8_SA(1, 1), nA + kstep, vN[1]);
        PRB_T1(3); PRB_T0(1);
        if constexpr (ALIGN_EPI) { if (wr == 0) PG8_BAR; }
        PG8_MFMA_DRAIN; E(acc, cur, wr, wc, fr, fq, pre); S.done(cur); pnst = epi_nst<Epi>::get(E, cur);
        if (!has_next) break;
        cur = nxt; cA = nA; cB = nB; ++ui; E.prefetch(cur, wr, fr, pre);
#pragma unroll
        for (int h = 0; h < 2; ++h)
#pragma unroll
            for (int i = 0; i < 2; ++i) vA[h][i] = vN[h][i];
        if constexpr (ALIGN_EPI) { if (wr == 1) PG8_BAR; }
        PRB_T1(1);
    }
    PG8_WAIT_V(0);
    if constexpr (!ALIGN_EPI) { if (wr == 0) PG8_BAR; }
    PG8_BAR;
#undef PG8_SA
#undef PG8_SB
#undef PG8_STAGE
#undef PG8_LDA
#undef PG8_LDB
#undef PG8_MMA
#undef PG8_F8
#undef PG8_MFMA8
#undef PG8_MFMA8Z
#undef PG8_MMA0
#undef PG8_MFMA_DRAIN
#undef PG8_WAIT_V
#undef PG8_WAIT_R
#undef PG8_WAIT_L
#undef PG8_BAR
#undef PG8_SCHED
}
}
namespace epi {
using pg8::f32x4; using pg8::f32x2; using pg8::u32x4; using pg8::Unit; using pg8::bf16_t; using pg8::cvt_pk_bf16; using pg8::sigmoidf_fast;
constexpr int HALF = 128;
__device__ __forceinline__ float gelu_tanh(float x) { const float z = 1.5957691216057308f * (x + 0.044715f * x * x * x); return x * sigmoidf_fast(z); }
__device__ __forceinline__ float clampf8(float v) { return __builtin_amdgcn_fmed3f(v, -448.0f, 448.0f); }
__device__ __forceinline__ unsigned pk4f8(const f32x4 a) { unsigned w = 0u; w = __builtin_amdgcn_cvt_pk_fp8_f32(clampf8(a[0]), clampf8(a[1]), w, false); w = __builtin_amdgcn_cvt_pk_fp8_f32(clampf8(a[2]), clampf8(a[3]), w, true); return w; }
__device__ __forceinline__ u32x4 pack8(const f32x4 a, const f32x4 b) { u32x4 w; w.x = cvt_pk_bf16(a[0], a[1]); w.y = cvt_pk_bf16(a[2], a[3]); w.z = cvt_pk_bf16(b[0], b[1]); w.w = cvt_pk_bf16(b[2], b[3]); return w; }

struct EpiInProj {
    static constexpr bool PERM = true;
    static constexpr int NSTMAX = 16; __device__ __forceinline__ int nst(const Unit& u) const { return (u.pn >= 4 && u.pn < 12) ? 8 : 16; }
    struct Pre {}; __device__ __forceinline__ void prefetch(const Unit&, int, int, Pre&) const {}
    bf16_t *XR, *GAR, *Q, *Kb, *V, *GB; const float* qg; const float* kg; const float* cstab; float c2; float inv;
    __device__ __forceinline__ void operator()(const f32x4 (&acc)[2][2][4][2], const Unit& u, int wr, int wc, int fr, int fq, const Pre& pre) const {
        const int pn = u.pn; const int rowb = u.pm * 256 + wr * 64 + fr;
        if (pn < 4 || (pn >= 20 && pn < 24) || pn >= 24) {
            bf16_t* base; int colt; const bool sig = false;
            if (pn < 4) { base = XR; colt = pn * 256; } else if (pn < 24) { base = V; colt = (pn - 20) * 256; } else { base = GB; colt = (pn - 24) * 256; }
            const int col0 = colt + wc * 32 + 8 * fq;
#pragma unroll
            for (int ai = 0; ai < 2; ++ai)
#pragma unroll
                for (int m = 0; m < 4; ++m) { bf16_t* rowp = base + (size_t)(rowb + ai * HALF + m * 16) * 1024 + col0;
#pragma unroll
                    for (int bj = 0; bj < 2; ++bj) { f32x4 v0 = acc[ai][bj][m][0] * inv, v1 = acc[ai][bj][m][1] * inv;
                        if (sig) {
#pragma unroll
                            for (int i = 0; i < 4; ++i) { v0[i] = sigmoidf_fast(v0[i]); v1[i] = sigmoidf_fast(v1[i]); } }
                        *(u32x4*)(rowp + bj * HALF) = pack8(v0, v1); } }
        } else if (pn < 12) {
            const int col0 = (pn - 4) * 128 + wc * 32 + 8 * fq;
#pragma unroll
            for (int ai = 0; ai < 2; ++ai)
#pragma unroll
                for (int m = 0; m < 4; ++m) { f32x4 o[2];
#pragma unroll
                    for (int n = 0; n < 2; ++n)
#pragma unroll
                        for (int i = 0; i < 4; ++i) { const float x = acc[ai][0][m][n][i] * inv, y = acc[ai][1][m][n][i] * inv, z = 1.5957691216057308f * (x + 0.044715f * x * x * x);
                            o[n][i] = x * __builtin_amdgcn_rcpf((1.0f + __builtin_amdgcn_exp2f(-1.4426950408889634f * z)) * (1.0f + __builtin_amdgcn_exp2f(-1.4426950408889634f * y))); }
                    *(u32x4*)(GAR + (size_t)(rowb + ai * HALF + m * 16) * 1024 + col0) = pack8(o[0], o[1]); }
        } else {
            const bool isq = pn < 16; const int j = isq ? pn - 12 : pn - 16; bf16_t* base = isq ? Q : Kb; const float* gg = isq ? qg : kg; const float sc = isq ? c2 : 1.0f;
            f32x4 gv[2][2];
#pragma unroll
            for (int bj = 0; bj < 2; ++bj)
#pragma unroll
                for (int n = 0; n < 2; ++n) gv[bj][n] = *(const f32x4*)(gg + 32 * bj + 8 * fq + 4 * n);
#pragma unroll
            for (int ai = 0; ai < 2; ++ai)
#pragma unroll
                for (int m = 0; m < 4; ++m) { const int row = rowb + ai * HALF + m * 16;
                    float ss = 0.f;
#pragma unroll
                    for (int bj = 0; bj < 2; ++bj)
#pragma unroll
                        for (int n = 0; n < 2; ++n) { const f32x4 x = acc[ai][bj][m][n]; ss += (x[0] * x[0] + x[1] * x[1]) + (x[2] * x[2] + x[3] * x[3]); }
                    ss += __shfl_xor(ss, 16); ss += __shfl_xor(ss, 32);
                    const float rstd = inv * __builtin_amdgcn_rsqf(ss * (inv * inv * (1.0f / 64.0f)) + 1e-6f);
                    f32x4 y[2][2];
#pragma unroll
                    for (int bj = 0; bj < 2; ++bj)
#pragma unroll
                        for (int n = 0; n < 2; ++n) y[bj][n] = acc[ai][bj][m][n] * rstd * gv[bj][n];
                    const f32x4 c0 = *(const f32x4*)(cstab + (size_t)row * 16), c1 = *(const f32x4*)(cstab + (size_t)row * 16 + 4);
                    const f32x4 s0 = *(const f32x4*)(cstab + (size_t)row * 16 + 8), s1 = *(const f32x4*)(cstab + (size_t)row * 16 + 12);
                    f32x4 p0, p1;
#pragma unroll
                    for (int i = 0; i < 4; ++i) { p0[i] = __shfl_xor(y[0][0][i], 16); p1[i] = __shfl_xor(y[0][1][i], 16); }
                    { const float sgn = fq == 0 ? -1.0f : 1.0f; const f32x4 r0 = y[0][0] * c0 + (p0 * s0) * sgn, r1 = y[0][1] * c1 + (p1 * s1) * sgn;
#pragma unroll
                      for (int i = 0; i < 4; ++i) { y[0][0][i] = fq < 2 ? r0[i] : y[0][0][i]; y[0][1][i] = fq < 2 ? r1[i] : y[0][1][i]; } }
                    bf16_t* rowp = base + (size_t)row * 1024 + j * 256 + wc * 64 + 8 * fq;
#pragma unroll
                    for (int bj = 0; bj < 2; ++bj) *(u32x4*)(rowp + 32 * bj) = pack8(y[bj][0] * sc, y[bj][1] * sc); }
        }
    }
};

struct EpiWo {
    static constexpr bool PERM = false;
    struct Pre {}; __device__ __forceinline__ void prefetch(const Unit&, int, int, Pre&) const {}
    const float* x; float* out; const float* gate;
    __device__ __forceinline__ void operator()(const f32x4 (&acc)[2][2][4][2], const Unit& u, int wr, int wc, int fr, int fq, const Pre& pre) const {
        const int rowb = u.pm * 256 + wr * 64 + fr; const int col0 = u.pn * 256 + wc * 32 + 4 * fq; const float* gp = gate + (size_t)(u.pm >> 4) * 6144;
        f32x4 gv[2][2];
#pragma unroll
        for (int bj = 0; bj < 2; ++bj)
#pragma unroll
            for (int n = 0; n < 2; ++n) gv[bj][n] = *(const f32x4*)(gp + col0 + bj * HALF + n * 16);
#pragma unroll
        for (int ai = 0; ai < 2; ++ai)
#pragma unroll
            for (int m = 0; m < 4; ++m) { const size_t off = (size_t)(rowb + ai * HALF + m * 16) * 1024 + col0;
#pragma unroll
                for (int bj = 0; bj < 2; ++bj)
#pragma unroll
                    for (int n = 0; n < 2; ++n) { const f32x4 xv = *(const f32x4*)(x + off + bj * HALF + n * 16); *(f32x4*)(out + off + bj * HALF + n * 16) = xv + gv[bj][n] * acc[ai][bj][m][n]; }
                if (m & 1) asm volatile("" ::: "memory"); }
    }
};
struct EpiF32 {
    static constexpr bool PERM = false;
    struct Pre {}; __device__ __forceinline__ void prefetch(const Unit&, int, int, Pre&) const {}
    float* out;
    __device__ __forceinline__ void operator()(const f32x4 (&acc)[2][2][4][2], const Unit& u, int wr, int wc, int fr, int fq, const Pre& pre) const {
        const int rowb = u.pm * 256 + wr * 64 + fr; const int col0 = wc * 32 + 4 * fq;
#pragma unroll
        for (int ai = 0; ai < 2; ++ai)
#pragma unroll
            for (int m = 0; m < 4; ++m) { float* rowp = out + (size_t)(rowb + ai * HALF + m * 16) * 256 + col0;
#pragma unroll
                for (int bj = 0; bj < 2; ++bj)
#pragma unroll
                    for (int n = 0; n < 2; ++n) *(f32x4*)(rowp + bj * HALF + n * 16) = acc[ai][bj][m][n]; }
    }
};
struct EpiGateUp {
    static constexpr bool PERM = true;
    struct Pre {}; __device__ __forceinline__ void prefetch(const Unit&, int, int, Pre&) const {}
    unsigned char* act; unsigned char* dump; float inv; float osc;
    __device__ __forceinline__ void operator()(const f32x4 (&acc)[2][2][4][2], const Unit& u, int wr, int wc, int fr, int fq, const Pre& pre) const {
        const int col0 = u.pn * 128 + wc * 32 + 8 * fq; int tdx = threadIdx.x; asm volatile("" : "+v"(tdx)); unsigned char* dmp = dump + ((size_t)(blockIdx.x * 512 + tdx) << 4);
#pragma unroll
        for (int ai = 0; ai < 2; ++ai)
#pragma unroll
            for (int m = 0; m < 4; ++m) { const int rt = ai * HALF + wr * 64 + m * 16 + fr; f32x4 o[2];
#pragma unroll
                for (int n = 0; n < 2; ++n)
#pragma unroll
                    for (int i = 0; i < 4; ++i) { const float g = acc[ai][0][m][n][i] * inv; o[n][i] = g * sigmoidf_fast(g) * (acc[ai][1][m][n][i] * (inv * osc)); }
                { typedef unsigned u32x2e __attribute__((ext_vector_type(2))); u32x2e w; w.x = pk4f8(o[0]); w.y = pk4f8(o[1]); *(u32x2e*)(rt < u.nrows ? act + (size_t)(u.row0 + rt) * 256 + col0 : dmp) = w; } }
    }
};
struct EpiDown {
    static constexpr int PERM = 2;
    static constexpr int NSTMAX = 8; __device__ __forceinline__ int nst(const Unit&) const { return 8; }
    struct Pre {}; __device__ __forceinline__ void prefetch(const Unit&, int, int, Pre&) const {}
    unsigned char* ys; const PG8_LAS unsigned short* gtab; unsigned char* dump; float sc;
    __device__ __forceinline__ void operator()(const f32x4 (&acc)[2][2][4][2], const Unit& u, int wr, int wc, int fr, int fq, const Pre& pre) const {
        int rt0 = wr * 64 + fr, tdx = threadIdx.x; asm volatile("" : "+v"(rt0), "+v"(tdx));
        unsigned char* base = ys + (size_t)u.row0 * 1024 + u.pn * 256 + wc * 64 + 16 * fq + (size_t)rt0 * 1024;
        unsigned char* dmp = dump + ((size_t)(blockIdx.x * 512 + tdx) << 4);
        const PG8_LAS unsigned short* gp = gtab + u.pm * 256 + rt0;
#pragma unroll
        for (int ai = 0; ai < 2; ++ai) {
#pragma unroll
            for (int m = 0; m < 4; ++m) { const int rt = ai * HALF + m * 16 + rt0; const float gt = (float)__builtin_bit_cast(_Float16, gp[ai * HALF + m * 16]) * sc;
                u32x4 w; w.x = pk4f8(acc[ai][0][m][0] * gt); w.y = pk4f8(acc[ai][0][m][1] * gt); w.z = pk4f8(acc[ai][1][m][0] * gt); w.w = pk4f8(acc[ai][1][m][1] * gt);
                unsigned char* dst = rt < u.nrows ? base + (ai * HALF + m * 16) * 1024 : dmp;
                *(u32x4*)dst = w; }
        }
    }
};
}
namespace attn_body {
using bf16=__hip_bfloat16;
using bf16x8=__attribute__((ext_vector_type(8)))short;
using s16x4=__attribute__((ext_vector_type(4)))short;
using f32x16=__attribute__((ext_vector_type(16)))float;
using u32x4=__attribute__((ext_vector_type(4)))unsigned;
constexpr int BATCH=8,NHEAD=16,SEQ=4096,D=64,DM=NHEAD*D;
constexpr int NW=8,QBLK=32,QB=QBLK*NW,KVBLK=64,NQB=SEQ/QB;
constexpr int ATTN_PITCH=DM, ATTN_UNIT_ROWS=QB;
__device__ __forceinline__ int crow(int r,int hi){return (r&3)+8*(r>>2)+4*hi;}
#define SBAR() __builtin_amdgcn_sched_barrier(0)
__device__ __forceinline__ void cmask(f32x16&p0,f32x16&p1,int jb,int qrel,int hi){
  const float NEG=-INFINITY; int kb=64*jb+4*hi;
  #pragma unroll
  for(int r=0;r<16;++r){int kv=kb+(r&3)+8*(r>>2); if(kv>qrel)p0[r]=NEG; if(kv+32>qrel)p1[r]=NEG;}
}

constexpr int NSLOT=3, SLOTB=8192, VSLOTB=2*SLOTB;
constexpr int LDS_K=0, LDS_V=NSLOT*SLOTB, LDS_WS=LDS_V+NSLOT*VSLOTB, LDS_OST=LDS_WS+NW*64*4, LDS_BYTES=LDS_OST+NW*4096;
constexpr int XARGS_OFF=131072+320+64;
constexpr float C2=0.125f*1.4426950408889634f;
__device__ __forceinline__ void glds16(const void*gsrc,unsigned lds_dst){unsigned keep;
  asm volatile("s_mov_b32 %0, m0\n\ts_mov_b32 m0, %2\n\ts_nop 0\n\tglobal_load_lds_dwordx4 %1, off\n\ts_mov_b32 m0, %0":"=&s"(keep):"v"(gsrc),"s"(lds_dst):"memory");}
__device__ __forceinline__ float max3f(float a,float b,float c){float r;asm("v_max3_f32 %0, %1, %2, %3":"=v"(r):"v"(a),"v"(b),"v"(c));return r;}
__device__ __forceinline__ float max2f(float a,float b){float r;asm("v_max_f32_e32 %0, %1, %2":"=v"(r):"v"(a),"v"(b));return r;}
__device__ __forceinline__ float fadd_s(float a,float b){float r;asm("v_add_f32_e32 %0, %1, %2":"=v"(r):"v"(a),"v"(b));return r;}
__device__ __forceinline__ float fsub_s(float a,float b){float r;asm("v_sub_f32_e32 %0, %1, %2":"=v"(r):"v"(a),"v"(b));return r;}
typedef float f32x2_t __attribute__((ext_vector_type(2))); typedef __bf16 bf16x2_t __attribute__((ext_vector_type(2)));
__device__ __forceinline__ unsigned cvtpk_s(float lo,float hi){f32x2_t v={lo,hi};bf16x2_t b=__builtin_convertvector(v,bf16x2_t);return __builtin_bit_cast(unsigned,b);}
#define WAIT_BAR(N) asm volatile("s_waitcnt vmcnt(" #N ") lgkmcnt(0)\n\ts_barrier":::"memory")

__device__ __forceinline__ void qkt(f32x16&p0,f32x16&p1,const char*Kslot,const bf16x8*qr,int r32,int hi){ const f32x16 negm=f32x16{};
  const char*kb=Kslot+hi*1024+r32*16;
  #pragma unroll
  for(int d0=0;d0<4;++d0){
    const bf16x8 b0=*reinterpret_cast<const bf16x8*>(kb+d0*2048);
    const bf16x8 b1=*reinterpret_cast<const bf16x8*>(kb+d0*2048+512);
    if(d0==0){p0=__builtin_amdgcn_mfma_f32_32x32x16_bf16(b0,qr[0],negm,0,0,0);p1=__builtin_amdgcn_mfma_f32_32x32x16_bf16(b1,qr[0],negm,0,0,0);}
    else{p0=__builtin_amdgcn_mfma_f32_32x32x16_bf16(b0,qr[d0],p0,0,0,0);p1=__builtin_amdgcn_mfma_f32_32x32x16_bf16(b1,qr[d0],p1,0,0,0);}}
}
typedef __attribute__((address_space(3))) const char* lds_cptr;
typedef short v4i16_t __attribute__((ext_vector_type(4)));
__device__ __forceinline__ void kload8(bf16x8*kf,lds_cptr kp){
  kf[0]=*(const __attribute__((address_space(3))) bf16x8*)(kp);      kf[1]=*(const __attribute__((address_space(3))) bf16x8*)(kp+512);
  kf[2]=*(const __attribute__((address_space(3))) bf16x8*)(kp+2048); kf[3]=*(const __attribute__((address_space(3))) bf16x8*)(kp+2560);
  kf[4]=*(const __attribute__((address_space(3))) bf16x8*)(kp+4096); kf[5]=*(const __attribute__((address_space(3))) bf16x8*)(kp+4608);
  kf[6]=*(const __attribute__((address_space(3))) bf16x8*)(kp+6144); kf[7]=*(const __attribute__((address_space(3))) bf16x8*)(kp+6656);
}
__device__ __forceinline__ void kload2(bf16x8*kf,lds_cptr kp,int j){ kf[2*j]=*(const __attribute__((address_space(3))) bf16x8*)(kp+j*2048); kf[2*j+1]=*(const __attribute__((address_space(3))) bf16x8*)(kp+j*2048+512); }
__device__ __forceinline__ s16x4 vtr(lds_cptr p){ return __builtin_bit_cast(s16x4,__builtin_amdgcn_ds_read_tr16_b64_v4i16((__attribute__((address_space(3))) v4i16_t*)p)); }
__device__ __forceinline__ float rowmax(const f32x16&p0,const f32x16&p1){
  float a=max3f(p0[0],p0[1],p1[0]),b=max3f(p0[2],p0[3],p1[1]);a=max3f(a,p1[2],p1[3]);
  #pragma unroll
  for(int r=4;r<16;r+=4){a=max3f(a,p0[r],p0[r+1]);b=max3f(b,p0[r+2],p0[r+3]);a=max3f(a,p1[r],p1[r+1]);b=max3f(b,p1[r+2],p1[r+3]);}
  const float m=max2f(a,b);
  auto rr=__builtin_amdgcn_permlane32_swap(__float_as_uint(m),__float_as_uint(m),false,false);
  return max2f(__uint_as_float(rr[0]),__uint_as_float(rr[1]));
}
__device__ __forceinline__ void pv(f32x16*o,int vb,bf16x8 pa0,bf16x8 pa1,bf16x8 pa2,bf16x8 pa3){
  #pragma unroll
  for(int d0=0;d0<4;++d0){s16x4 lo[4],hi[4];
    #pragma unroll
    for(int ks=0;ks<4;++ks){
      asm volatile("ds_read_b64_tr_b16 %0,%1 offset:%c2":"=&v"(lo[ks]):"v"(vb),"i"(d0*4096+ks*1024):"memory");
      asm volatile("ds_read_b64_tr_b16 %0,%1 offset:%c2":"=&v"(hi[ks]):"v"(vb),"i"(d0*4096+ks*1024+512):"memory");}
    asm volatile("s_waitcnt lgkmcnt(0)":::"memory");SBAR();
    #define PK(k) (bf16x8){lo[k][0],lo[k][1],lo[k][2],lo[k][3],hi[k][0],hi[k][1],hi[k][2],hi[k][3]}
    o[d0]=__builtin_amdgcn_mfma_f32_32x32x16_bf16(pa0,PK(0),o[d0],0,0,0);
    o[d0]=__builtin_amdgcn_mfma_f32_32x32x16_bf16(pa1,PK(1),o[d0],0,0,0);
    o[d0]=__builtin_amdgcn_mfma_f32_32x32x16_bf16(pa2,PK(2),o[d0],0,0,0);
    o[d0]=__builtin_amdgcn_mfma_f32_32x32x16_bf16(pa3,PK(3),o[d0],0,0,0);
    #undef PK
  }
}

#ifndef ATTN_STORE16
#define ATTN_STORE16(p,v) (*(u32x4*)(p)=(v))
#endif
template<int THRL> __device__ __forceinline__ void attn_unit(int b,int hq,int vcol,int qb,const bf16*Q,const bf16*K,const bf16*V,bf16*O,char*shm){
  int tid=threadIdx.x; asm volatile("":"+v"(tid));
  const int lane=tid&63,r32=lane&31,hi=lane>>5; const int wid=__builtin_amdgcn_readfirstlane(tid>>6);
  const long rowbase=(long)b*SEQ; const int q0=qb*QB;
  const bf16*Qw=Q+(rowbase+q0+wid*QBLK)*DM+hq*D;
  const bf16*Kh=K+rowbase*DM+hq*D,*Vh=V+rowbase*DM+vcol;
  const unsigned lds0=(unsigned)(uintptr_t)shm;
  float*wsf=(float*)(shm+LDS_WS)+wid*64;
  const bf16*ksrc=Kh+(long)lane*DM+wid*8;
  const bf16*vsrc=Vh+(long)(16*(wid&3)+(lane>>2))*DM+(wid>>2)*32+(lane&3)*8;
  const unsigned kdst=lds0+LDS_K+wid*1024, vdst=lds0+LDS_V+wid*1024;
  #define DMA_K(t,slot) glds16(ksrc+(long)(t)*KVBLK*DM,(unsigned)__builtin_amdgcn_readfirstlane(kdst+(slot)))
  #define DMA_V(t,slot) do{ glds16(vsrc+(long)(t)*KVBLK*DM,(unsigned)__builtin_amdgcn_readfirstlane(vdst+2*(slot))); glds16(vsrc+64+(long)(t)*KVBLK*DM,(unsigned)__builtin_amdgcn_readfirstlane(vdst+8192+2*(slot))); }while(0)
  const int vb0=(int)(lds0+LDS_V)+((lane>>4)&1)*32+(lane&3)*8+(4*hi+((lane&15)>>2))*64;
  const char*Kbase=shm+LDS_K; bf16x8 kf[8];
  const lds_cptr shm3=(lds_cptr)shm; const lds_cptr kp0=shm3+LDS_K+hi*1024+r32*16; const lds_cptr vp0=shm3+LDS_V+((lane>>4)&1)*32+(lane&3)*8+(4*hi+((lane&15)>>2))*64;
  const int NT=(q0+QB)/KVBLK;
  DMA_K(0,0);DMA_V(0,0);DMA_K(1,SLOTB);
  bf16x8 qr[4];
  #pragma unroll
  for(int d0=0;d0<4;++d0)qr[d0]=*reinterpret_cast<const bf16x8*>(&Qw[(long)r32*DM+d0*16+hi*8]);
  float l_reg=0.f;f32x16 o[4];o[0]=f32x16{};o[1]=f32x16{};o[2]=f32x16{};o[3]=f32x16{};
  const int qrel=wid*QBLK+r32;
  #define CMASK(P0,P1,t) do{int jb_=(t)-(NT-4); if(jb_>=0)cmask(P0,P1,jb_,qrel,hi);}while(0)
  #define START(P0,P1) do{ _Pragma("unroll") for(int r=0;r<16;++r){P0[r]=__builtin_amdgcn_exp2f(P0[r]);P1[r]=__builtin_amdgcn_exp2f(P1[r]);} }while(0)
  #define RESC() do{}while(0)
  f32x16 pA0,pA1,pB0,pB1;
  int sl_prev=0,sl_cur=0,sl_next=SLOTB;
  #define ROT() do{sl_prev=sl_cur;sl_cur=sl_next;sl_next=(sl_next==(NSLOT-1)*SLOTB)?0:sl_next+SLOTB;}while(0)
  DMA_K(2,2*SLOTB);
  WAIT_BAR(4);
  qkt(pA0,pA1,Kbase,qr,r32,hi);asm volatile("s_nop 15\n\ts_nop 7":"+v"(pA0),"+v"(pA1));CMASK(pA0,pA1,0);
  START(pA0,pA1);
  WAIT_BAR(0);
  DMA_K(3,0);DMA_V(1,SLOTB);
  ROT();
  kload8(kf,kp0+sl_cur);
  WAIT_BAR(3);
  s16x4 vlo[4],vhi[4]; u32x4 pw0,pw1,pw2,pw3;
  #define PKW(P,B) cvtpk_s(P[B],P[B+1])
  #define PAF(k) __builtin_bit_cast(bf16x8,pw##k)
  #define VFR(i) (bf16x8){vlo[i][0],vlo[i][1],vlo[i][2],vlo[i][3],vhi[i][0],vhi[i][1],vhi[i][2],vhi[i][3]}
  #define PIN(x) asm volatile("":"+v"(x))
  #define MX3(a,b,c) __builtin_fmaxf(__builtin_fmaxf((a),(b)),(c))
  #define GAPA(MF,A0,A1,A2,A3,W0,W1,PW) do{ MF; sacc+=A0; sacc+=A1; sacc+=A2; sacc+=A3; PIN(sacc); W0; W1; PIN(PW); SBAR(); }while(0)
  #define EXS(v) __builtin_amdgcn_exp2f(v)
  #define VOFF(n) ((2*((n)>>3)+((n)&1))*4096+(((n)&7)>>1)*1024)
  #define VRDN(n) do{ vlo[(n)&3]=vtr(vp_+VOFF(n)); vhi[(n)&3]=vtr(vp_+VOFF(n)+512); }while(0)
  #define GAPB(n,PA,OD,X,B) do{ o[OD]=__builtin_amdgcn_mfma_f32_32x32x16_bf16(PA,VFR((n)&3),o[OD],0,0,0); X[B]=EXS(X[B]); X[(B)+1]=EXS(X[(B)+1]); PIN(X); SBAR(); if((n)+4<16){ VRDN((n)+4); SBAR(); } }while(0)
  #define KRD(G,j) do{ if(G){ kload2(kf,kp0+sl_next,j); SBAR(); } }while(0)
  #define STEP(C0,C1,P0,P1,t,GK,GV,GL) do{ SBAR(); \
    const lds_cptr vp_=vp0+2*sl_prev; const f32x16 zc_=f32x16{}; \
    float sacc=(P0[0]+P0[1]); \
    GAPA(C0=__builtin_amdgcn_mfma_f32_32x32x16_bf16(kf[0],qr[0],zc_,0,0,0), P0[2],P0[3],P0[4],P0[5],     pw0[0]=PKW(P0,0), pw0[1]=PKW(P0,2), pw0); \
    GAPA(C1=__builtin_amdgcn_mfma_f32_32x32x16_bf16(kf[1],qr[0],zc_,0,0,0), P0[6],P0[7],P0[8],P0[9],     pw0[2]=PKW(P0,4), pw0[3]=PKW(P0,6), pw0); \
    GAPA(C0=__builtin_amdgcn_mfma_f32_32x32x16_bf16(kf[2],qr[1],C0,0,0,0),   P0[10],P0[11],P0[12],P0[13], pw1[0]=PKW(P0,8), pw1[1]=PKW(P0,10), pw1); \
    GAPA(C1=__builtin_amdgcn_mfma_f32_32x32x16_bf16(kf[3],qr[1],C1,0,0,0),   P0[14],P0[15],P1[0],P1[1],   pw1[2]=PKW(P0,12),pw1[3]=PKW(P0,14), pw1); \
    VRDN(0); SBAR(); GAPA(C0=__builtin_amdgcn_mfma_f32_32x32x16_bf16(kf[4],qr[2],C0,0,0,0),   P1[2],P1[3],P1[4],P1[5],     pw2[0]=PKW(P1,0), pw2[1]=PKW(P1,2), pw2); \
    VRDN(1); SBAR(); GAPA(C1=__builtin_amdgcn_mfma_f32_32x32x16_bf16(kf[5],qr[2],C1,0,0,0),   P1[6],P1[7],P1[8],P1[9],     pw2[2]=PKW(P1,4), pw2[3]=PKW(P1,6), pw2); \
    VRDN(2); SBAR(); GAPA(C0=__builtin_amdgcn_mfma_f32_32x32x16_bf16(kf[6],qr[3],C0,0,0,0),   P1[10],P1[11],P1[12],P1[13], pw3[0]=PKW(P1,8), pw3[1]=PKW(P1,10), pw3); \
    VRDN(3); SBAR(); GAPA(C1=__builtin_amdgcn_mfma_f32_32x32x16_bf16(kf[7],qr[3],C1,0,0,0),   P1[14],P1[15],0.f,0.f,       pw3[2]=PKW(P1,12),pw3[3]=PKW(P1,14), pw3); \
    l_reg+=sacc; \
    if(GK){DMA_K((t)+3,sl_cur);} if(GV){DMA_V((t)+1,sl_next);} \
    CMASK(C0,C1,t); \
    SBAR(); \
    GAPB(0,PAF(0),0,C0,0);  GAPB(1,PAF(0),1,C0,2);  GAPB(2,PAF(1),0,C0,4);  GAPB(3,PAF(1),1,C0,6); \
    GAPB(4,PAF(2),0,C0,8);  GAPB(5,PAF(2),1,C0,10); GAPB(6,PAF(3),0,C0,12); GAPB(7,PAF(3),1,C0,14); \
    GAPB(8,PAF(0),2,C1,0);  GAPB(9,PAF(0),3,C1,2); \
    KRD(GL,0); GAPB(10,PAF(1),2,C1,4); KRD(GL,1); GAPB(11,PAF(1),3,C1,6); \
    KRD(GL,2); GAPB(12,PAF(2),2,C1,8); KRD(GL,3); GAPB(13,PAF(2),3,C1,10); \
    GAPB(14,PAF(3),2,C1,12); GAPB(15,PAF(3),3,C1,14); \
    }while(0)
  int t=1;
  #undef CMASK
  #define CMASK(P0,P1,t) do{}while(0)
  for(;t+5<NT;t+=2){
    STEP(pB0,pB1,pA0,pA1,t,true,true,true);     WAIT_BAR(3); RESC(); ROT();
    STEP(pA0,pA1,pB0,pB1,t+1,true,true,true);   WAIT_BAR(3); RESC(); ROT();
  }
  #undef CMASK
  #define CMASK(P0,P1,t) do{int jb_=(t)-(NT-4); if(jb_>=0)cmask(P0,P1,jb_,qrel,hi);}while(0)
  #define ENDW(tt) do{ if((tt)+3<NT){WAIT_BAR(3);} else if((tt)+2<NT){WAIT_BAR(2);} else {WAIT_BAR(0);} }while(0)
  for(;t+1<NT;t+=2){
    STEP(pB0,pB1,pA0,pA1,t,(t+3<NT),(t+1<NT),(t+1<NT));       ENDW(t);   RESC(); ROT();
    STEP(pA0,pA1,pB0,pB1,t+1,(t+4<NT),(t+2<NT),(t+2<NT));     ENDW(t+1); RESC(); ROT();
  }
  STEP(pB0,pB1,pA0,pA1,NT-1,false,false,false); RESC();
  { float sacc=pB0[0]+pB0[1]; _Pragma("unroll") for(int r=2;r<16;++r)sacc+=pB0[r]; _Pragma("unroll") for(int r=0;r<16;++r)sacc+=pB1[r]; l_reg+=sacc;
    pw0=(u32x4){PKW(pB0,0),PKW(pB0,2),PKW(pB0,4),PKW(pB0,6)};pw1=(u32x4){PKW(pB0,8),PKW(pB0,10),PKW(pB0,12),PKW(pB0,14)};pw2=(u32x4){PKW(pB1,0),PKW(pB1,2),PKW(pB1,4),PKW(pB1,6)};pw3=(u32x4){PKW(pB1,8),PKW(pB1,10),PKW(pB1,12),PKW(pB1,14)};
    SBAR(); pv(o,vb0+2*sl_cur,PAF(0),PAF(1),PAF(2),PAF(3)); }
  #undef PKW
  #undef PAF
  #undef VFR
  #undef PIN
  #undef MX3
  #undef GAPA
  #undef GAPB
  #undef EXS
  #undef VOFF
  #undef VRDN
  #undef KRD
  #undef STEP
  #undef ENDW
  {auto rr=__builtin_amdgcn_permlane32_swap(__float_as_uint(l_reg),__float_as_uint(l_reg),false,false);l_reg=__uint_as_float(rr[0])+__uint_as_float(rr[1]);}
  if(hi==0)wsf[32+r32]=l_reg;asm volatile("s_waitcnt lgkmcnt(0)":::"memory");
  float rli[16];
  #pragma unroll
  for(int r=0;r<16;++r)rli[r]=__builtin_amdgcn_rcpf(wsf[32+crow(r,hi)]);
  bf16*Ow=O+(rowbase+q0+wid*QBLK)*DM+vcol;
  if((hq&1)==0){ bf16*stg=(bf16*)(shm+LDS_OST)+wid*2048; int lane_f=lane; asm volatile("":"+v"(lane_f));
    #pragma unroll
    for(int hh=0;hh<2;++hh){
      #pragma unroll
      for(int r=0;r<16;++r){const int orow=crow(r,hi);
        #pragma unroll
        for(int d0=0;d0<2;++d0)stg[orow*64+d0*32+r32]=__float2bfloat16(o[2*hh+d0][r]*rli[r]);}
      asm volatile("s_waitcnt lgkmcnt(0)":::"memory");
      #pragma unroll
      for(int i=0;i<4;++i){const int row=i*8+(lane_f>>3),ch=lane_f&7; const u32x4 v=*(const u32x4*)(stg+row*64+ch*8); ATTN_STORE16(Ow+(long)row*DM+hh*64+ch*8,v);}
      asm volatile("s_waitcnt lgkmcnt(0)":::"memory"); } }
  else { bf16*stg=(bf16*)(shm+LDS_OST)+wid*2048;
    const volatile __attribute__((address_space(3))) unsigned* xa=(const volatile __attribute__((address_space(3))) unsigned*)((lds_cptr)shm+XARGS_OFF);
    bf16*YB=(bf16*)(__attribute__((address_space(1))) void*)(((unsigned long long)(unsigned)__builtin_amdgcn_readfirstlane(xa[1])<<32)|(unsigned)__builtin_amdgcn_readfirstlane(xa[0]));
    const bf16*GB=(const bf16*)(__attribute__((address_space(1))) void*)(((unsigned long long)(unsigned)__builtin_amdgcn_readfirstlane(xa[3])<<32)|(unsigned)__builtin_amdgcn_readfirstlane(xa[2]));
    const float*sg=(const float*)(__attribute__((address_space(1))) void*)(((unsigned long long)(unsigned)__builtin_amdgcn_readfirstlane(xa[5])<<32)|(unsigned)__builtin_amdgcn_readfirstlane(xa[4]));
    const float lam=__uint_as_float((unsigned)__builtin_amdgcn_readfirstlane(xa[6]));
    int lane_e=lane; asm volatile("":"+v"(lane_e));
    const int rl=lane_e>>3,ch=lane_e&7; const long goff=(rowbase+q0+wid*QBLK)*DM+vcol;
    float x[2][4][8]; float ss[4]={0.f,0.f,0.f,0.f};
    #define BLO(w) __uint_as_float((w)<<16)
    #define BHI(w) __uint_as_float((w)&0xffff0000u)
    #pragma unroll
    for(int hh=0;hh<2;++hh){
      #pragma unroll
      for(int r=0;r<16;++r){const int orow=crow(r,hi);
        #pragma unroll
        for(int d0=0;d0<2;++d0)stg[orow*64+d0*32+r32]=__float2bfloat16(o[2*hh+d0][r]*rli[r]);}
      asm volatile("s_waitcnt lgkmcnt(0)":::"memory");
      #pragma unroll
      for(int i=0;i<4;++i){const int row=i*8+rl; const u32x4 v1=*(const u32x4*)(stg+row*64+ch*8); const u32x4 v0=*(const u32x4*)(O+goff+(long)row*DM+hh*64+ch*8);
        #pragma unroll
        for(int k=0;k<4;++k){const float lo=BLO(v0[k])-lam*BLO(v1[k]),hv=BHI(v0[k])-lam*BHI(v1[k]); x[hh][i][2*k]=lo; x[hh][i][2*k+1]=hv; ss[i]+=lo*lo+hv*hv;}}
      asm volatile("s_waitcnt lgkmcnt(0)":::"memory"); }
    #pragma unroll
    for(int i=0;i<4;++i){ss[i]+=__shfl_xor(ss[i],1);ss[i]+=__shfl_xor(ss[i],2);ss[i]+=__shfl_xor(ss[i],4);ss[i]=__builtin_amdgcn_rsqf(ss[i]*(1.0f/128.0f)+1e-6f);}
    #pragma unroll
    for(int hh=0;hh<2;++hh){ float sgv[8];
      #pragma unroll
      for(int j=0;j<8;++j)sgv[j]=sg[hh*64+ch*8+j]*0.8f;
      #pragma unroll
      for(int i=0;i<4;++i){const int row=i*8+rl; const u32x4 gb=*(const u32x4*)(GB+goff+(long)row*DM+hh*64+ch*8); u32x4 w;
        #pragma unroll
        for(int k=0;k<4;++k){const float g0=__builtin_amdgcn_rcpf(1.0f+__builtin_amdgcn_exp2f(-1.4426950408889634f*BLO(gb[k]))),g1=__builtin_amdgcn_rcpf(1.0f+__builtin_amdgcn_exp2f(-1.4426950408889634f*BHI(gb[k])));
          w[k]=cvtpk_s(g0*(x[hh][i][2*k]*ss[i]*sgv[2*k]),g1*(x[hh][i][2*k+1]*ss[i]*sgv[2*k+1]));}
        ATTN_STORE16(YB+goff+(long)row*DM+hh*64+ch*8,w);}}
    #undef BLO
    #undef BHI
  }
  asm volatile("s_waitcnt lgkmcnt(0)\n\ts_barrier":::"memory");
  #undef DMA_K
  #undef DMA_V
  #undef CMASK
  #undef START
  #undef RESC
  #undef ROT
}
constexpr int ATTN_LDS_BYTES=LDS_BYTES;
struct AttnTensors { const bf16* Q; const bf16* K; const bf16* V; bf16* O0; bf16* YB; const bf16* GB; const float* sg; float lam; };
struct AttnUnit { int b, h, qb; };
struct PairOrder {
  int vcu, G;
  __device__ __forceinline__ PairOrder(int grid,int vcu_):vcu(vcu_),G(grid){}
  __device__ __forceinline__ bool next(int i,AttnUnit&u)const{ const int ug=i*G+vcu; if(ug>=1024)return false; const int w=ug&31, rnd=ug>>8, bh=((ug&255)>>5)*8+2*rnd+(w>>4);
    u.b=bh>>3; u.h=bh&7; u.qb=(rnd&1)?15-(w&15):(w&15); return true; }
  __device__ __forceinline__ void a_ready(const AttnUnit&)const{}
  __device__ __forceinline__ void done(const AttnUnit&)const{}
};
template<class Sched,class Hook,int THRL=8> __device__ __forceinline__ void attn_phase(char*lds,const AttnTensors&T,const Sched&S,const Hook&H,int reps){
  AttnUnit u;
  if(threadIdx.x==0){ volatile __attribute__((address_space(3))) unsigned* xa=(volatile __attribute__((address_space(3))) unsigned*)((lds_cptr)lds+XARGS_OFF);
    const unsigned long long p0=(unsigned long long)T.YB,p1=(unsigned long long)T.GB,p2=(unsigned long long)T.sg;
    xa[0]=(unsigned)p0;xa[1]=(unsigned)(p0>>32);xa[2]=(unsigned)p1;xa[3]=(unsigned)(p1>>32);xa[4]=(unsigned)p2;xa[5]=(unsigned)(p2>>32);xa[6]=__float_as_uint(T.lam); }
  __syncthreads();
  int hs=0;
  for(int rep=0;rep<reps;++rep)
  for(int i=0;S.next(i>>1,u);++i){ S.a_ready(u);
    attn_unit<THRL>(u.b,2*u.h+(i&1),128*u.h,u.qb,T.Q,T.K,T.V,T.O0,lds);
    S.done(u);
    if(hs<Hook::NSLICE){ H(hs); ++hs; } }
  for(;hs<Hook::NSLICE;++hs)H(hs);
}
#undef SBAR
#undef WAIT_BAR
}
#define GAS __attribute__((address_space(1)))
#define LAS __attribute__((address_space(3)))
typedef unsigned short bf16;
typedef unsigned v4u __attribute__((ext_vector_type(4)));
typedef float f32x4 __attribute__((ext_vector_type(4)));
typedef short bf16x8 __attribute__((ext_vector_type(8)));
typedef GAS unsigned gu32;
typedef GAS unsigned long long gu64;
#define RLX_AGENT __ATOMIC_RELAXED, __HIP_MEMORY_SCOPE_AGENT
#define LDS_WAIT() asm volatile("s_waitcnt lgkmcnt(0)" ::: "memory")
#define VM_WAIT() asm volatile("s_waitcnt vmcnt(0)" ::: "memory")
__device__ __forceinline__ unsigned long long rt() { return __builtin_amdgcn_s_memrealtime(); }
typedef float f32x2_cv __attribute__((ext_vector_type(2))); typedef __bf16 bf16x2_cv __attribute__((ext_vector_type(2)));
__device__ __forceinline__ unsigned pk2(float lo, float hi) { const f32x2_cv v = {lo, hi}; return __builtin_bit_cast(unsigned, __builtin_convertvector(v, bf16x2_cv)); }
__device__ __forceinline__ unsigned f2bf(float f) { return pk2(f, f) & 0xffffu; }

#define XB_TMO      128
#define XB_XCNT(j)  (256  + 64 * (j))
#define XB_XSUB(j)  (1280 + 64 * (j))
#define XB_XGEN(j)  (2304 + 64 * (j))
#define XB_TOP      3328
#define XB_TOPGEN   3392
#define XCD_BAR_WORDS 3456
#define XB_SPIN_CAP (1u << 18)

__device__ __forceinline__ unsigned xb_ld(unsigned* p)              { return __hip_atomic_load(p, __ATOMIC_RELAXED, __HIP_MEMORY_SCOPE_AGENT); }
__device__ __forceinline__ unsigned xb_add(unsigned* p, unsigned v) { return __hip_atomic_fetch_add(p, v, __ATOMIC_RELAXED, __HIP_MEMORY_SCOPE_AGENT); }
__device__ __forceinline__ unsigned xb_xcc_id() { return (unsigned)__builtin_amdgcn_s_getreg((3 << 11) | 20) & 0xFu; }
#define XB_SPIN(cond, bar) do { unsigned _sp = 0; while (cond) { __builtin_amdgcn_s_sleep(1); \
    if ((++_sp & 255u) == 0u) { if (xb_ld(&(bar)[XB_TMO])) break; if (_sp > XB_SPIN_CAP) { atomicAdd(&(bar)[XB_TMO], 1u); break; } } } } while (0)

struct XcdBarrier {
    unsigned* bar; unsigned x;
    volatile LAS unsigned* st;
};

__device__ __forceinline__ XcdBarrier xcd_barrier_post(unsigned* bar, volatile LAS unsigned* st) {
    XcdBarrier b; b.bar = bar; b.x = xb_xcc_id(); b.st = st;
    if (threadIdx.x == 0) (void)xb_add(&bar[XB_XCNT(b.x)], 1u);
    return b;
}
__device__ __forceinline__ void xcd_barrier_complete(unsigned* bar, unsigned x, unsigned& nloc, unsigned& nx) {
    const unsigned G = gridDim.x * gridDim.y * gridDim.z;
    unsigned sum, cnt, mine, sp = 0u;
    for (;;) {
        sum = 0u; cnt = 0u; mine = 0u;
#pragma unroll
        for (unsigned j = 0; j < 16; ++j) { const unsigned c = xb_ld(&bar[XB_XCNT(j)]); sum += c; cnt += (c > 0u) ? 1u : 0u; mine = (j == x) ? c : mine; }
        if (sum == G) break;
        __builtin_amdgcn_s_sleep(1);
        if ((++sp & 255u) == 0u) { if (xb_ld(&bar[XB_TMO])) break; if (sp > XB_SPIN_CAP) { atomicAdd(&bar[XB_TMO], 1u); break; } }
    }
    nloc = mine > 0u ? mine : 1u; nx = cnt > 0u ? cnt : 1u;
}

__device__ __forceinline__ void xcd_barrier(const XcdBarrier& b) {
    asm volatile("s_waitcnt vmcnt(0)" ::: "memory");
    __syncthreads();
    if (threadIdx.x == 0) {
        unsigned* bar = b.bar;
        __builtin_amdgcn_s_waitcnt(0);
        unsigned nloc = b.st[0], nx = b.st[1];
        if (nloc == 0u) { xcd_barrier_complete(bar, b.x, nloc, nx); b.st[0] = nloc; b.st[1] = nx; }
        const unsigned old = xb_add(&bar[XB_XSUB(b.x)], 1u);
        const unsigned gen = old / nloc;
        if (old + 1u == (gen + 1u) * nloc) {
            __builtin_amdgcn_fence(__ATOMIC_RELEASE, "agent");
            asm volatile("s_waitcnt vmcnt(0)" ::: "memory");
            const unsigned og = xb_add(&bar[XB_TOP], 1u);
            const unsigned tg = og / nx;
            if (og + 1u == (tg + 1u) * nx) xb_add(&bar[XB_TOPGEN], 1u);
            else XB_SPIN(xb_ld(&bar[XB_TOPGEN]) == tg, bar);
            __builtin_amdgcn_fence(__ATOMIC_ACQUIRE, "agent");
            xb_add(&bar[XB_XGEN(b.x)], 1u);
            asm volatile("s_waitcnt vmcnt(0)" ::: "memory");
        } else {
            XB_SPIN(xb_ld(&bar[XB_XGEN(b.x)]) == gen, bar);
            __builtin_amdgcn_fence(__ATOMIC_ACQUIRE, "agent");
            asm volatile("s_waitcnt vmcnt(0)" ::: "memory");
        }
    }
    __syncthreads();
}
constexpr int NWAVES = 8;
constexpr int BATCH = 8, SEQ = 4096, T = BATCH * SEQ, D = 1024, NEXP = 256, TOPK = 8, DEXP = 256, NSLOT = TOPK + 1  ;
constexpr int INW = 7168;
constexpr int NPOS = T * NSLOT;
constexpr int MAXTILES = 1408;
constexpr float EPS = 1e-6f;

constexpr size_t MiB = 1u << 20;
constexpr size_t WS_CTL = 0, CTL_ZERO_BYTES = 1 * MiB;
constexpr size_t WS_MOD = 1 * MiB;
constexpr size_t WS_C8SP = 1 * MiB + 256 * 1024;
constexpr size_t WS_CST = 1 * MiB + 512 * 1024;
constexpr size_t WS_WIN = 4 * MiB, WS_WO = 18 * MiB, WS_WR = 20 * MiB, WS_WLRU = 20 * MiB + 512 * 1024;
constexpr size_t WS_TOPE = 21 * MiB, WS_TOPG = 22 * MiB, WS_POSE = 23 * MiB;
constexpr size_t WS_REC = 546 * MiB;
constexpr int REC_CAP = T;
constexpr size_t WS_POSM = 12 * MiB;
constexpr size_t WS_DUMP = 13 * MiB;
constexpr size_t WS_H28 = 482 * MiB;
constexpr float SC_H = 4.0f, SC_W = 64.0f, SC_A = 8.0f, SC_Y = 16.0f;
constexpr size_t WS_WED = 32 * MiB;
constexpr size_t WS_WEGU = 161 * MiB;
constexpr size_t WS_XR = 418 * MiB, WS_GAR = 482 * MiB, WS_Q = 546 * MiB, WS_K = 610 * MiB, WS_V = 674 * MiB, WS_GB = 738 * MiB, WS_MIX = 802 * MiB;
constexpr size_t WS_LOGIT = 738 * MiB;
constexpr size_t WS_H2 = 418 * MiB;
constexpr size_t WS_ACT = 802 * MiB;
constexpr size_t WS_YS = 161 * MiB;
constexpr size_t WS_END = 948 * MiB;
static_assert(WS_YS + (size_t)NPOS * 2048 <= WS_LOGIT && WS_ACT + (size_t)(NPOS + 256) * 512 <= WS_END && WS_WED + (size_t)257 * 1024 * 256 * 2 <= WS_WEGU && WS_WEGU + (size_t)257 * 512 * 1024 * 2 <= WS_XR, "d_ws map");
constexpr int CW_TMO = 0, CW_CODE = 1, CW_NTILES = 64, CW_CONV = 128, CW_CNT = 1024, CW_BAR = 4096;

constexpr int RING_OFF = 0, RING_BYTES = 131072;
constexpr int LDSCTL_OFF = RING_BYTES, MISC_OFF = LDSCTL_OFF + 320;
constexpr int UT_OFF = LDSCTL_OFF + 512;
constexpr int TOK_OFF = LDSCTL_OFF + 2048;
constexpr int PFX_OFF = LDSCTL_OFF + 16384;
constexpr int LDS_BYTES = 147456 + 4096;
constexpr int MAXU_TOK = 14, MAXU = 64, MAXU_GT = 28;
struct Frame {
    LAS unsigned char* lds;
    volatile LAS unsigned* MISC;
    gu32* ctl;
    int tid, lane, wave;
    int vcu, G;
};
#define LBAR() asm volatile("s_waitcnt lgkmcnt(0)\n\ts_barrier" ::: "memory")
__device__ __forceinline__ float wave_sum(float v) {
#pragma unroll
    for (int o = 1; o < 64; o <<= 1) v += __shfl_xor(v, o);
    return v;
}
__device__ __forceinline__ float bf2f(unsigned short h) { return __builtin_bit_cast(float, (unsigned)h << 16); }
__device__ __forceinline__ float bflo(unsigned w) { return __builtin_bit_cast(float, w << 16); }
__device__ __forceinline__ float bfhi(unsigned w) { return __builtin_bit_cast(float, w & 0xffff0000u); }
__device__ __forceinline__ float clamp_f8(float v) { return __builtin_amdgcn_fmed3f(v, -448.0f, 448.0f); }
__device__ __forceinline__ unsigned pk4_fp8(float a, float b, float c, float d) { unsigned w = 0u; a = clamp_f8(a); b = clamp_f8(b); c = clamp_f8(c); d = clamp_f8(d); w = __builtin_amdgcn_cvt_pk_fp8_f32(a, b, w, false); w = __builtin_amdgcn_cvt_pk_fp8_f32(c, d, w, true); return w; }
__device__ __forceinline__ float sigm(float v) { return __builtin_amdgcn_rcpf(1.0f + __builtin_amdgcn_exp2f(-1.4426950408889634f * v)); }

__device__ __forceinline__ void transpose_item(const float* W, int ldn, bf16* WT, int ldk, int k0, int n0, int drow0, LAS float* scr, int lane) {
    float v[32];
#pragma unroll
    for (int i = 0; i < 32; ++i) { const int kk = 2 * i + (lane >> 5); v[i] = __builtin_nontemporal_load(W + (size_t)(k0 + kk) * ldn + n0 + (lane & 31)); }
#pragma unroll
    for (int i = 0; i < 32; ++i) { const int kk = 2 * i + (lane >> 5); scr[kk * 33 + (lane & 31)] = v[i]; }
    LDS_WAIT(); asm volatile("" ::: "memory");
    const int c = lane & 7;
#pragma unroll
    for (int j = 0; j < 4; ++j) { const int n = (lane >> 3) + 8 * j; const LAS float* s = scr + (8 * c) * 33 + n;
        v4u o; o.x = pk2(s[0 * 33], s[1 * 33]); o.y = pk2(s[2 * 33], s[3 * 33]); o.z = pk2(s[4 * 33], s[5 * 33]); o.w = pk2(s[6 * 33], s[7 * 33]);
        *(GAS v4u*)(WT + (size_t)(drow0 + n) * ldk + k0 + 8 * c) = o; }
    LDS_WAIT(); asm volatile("" ::: "memory");
}
__device__ __forceinline__ void transpose_item8(const float* W, int ldn, unsigned char* WT, int ldk, int k0, int n0, int drow0, float scale, LAS float* scr, int lane) {
    float v[32];
#pragma unroll
    for (int i = 0; i < 32; ++i) { const int kk = 2 * i + (lane >> 5); v[i] = __builtin_nontemporal_load(W + (size_t)(k0 + kk) * ldn + n0 + (lane & 31)); }
#pragma unroll
    for (int i = 0; i < 32; ++i) { const int kk = 2 * i + (lane >> 5); scr[kk * 33 + (lane & 31)] = v[i] * scale; }
    LDS_WAIT(); asm volatile("" ::: "memory");
    const int c = lane & 3;
#pragma unroll
    for (int j = 0; j < 2; ++j) { const int n = (lane >> 2) + 16 * j; const LAS float* s = scr + (16 * c) * 33 + n;
        v4u o; o.x = pk4_fp8(s[0 * 33], s[1 * 33], s[2 * 33], s[3 * 33]); o.y = pk4_fp8(s[4 * 33], s[5 * 33], s[6 * 33], s[7 * 33]);
        o.z = pk4_fp8(s[8 * 33], s[9 * 33], s[10 * 33], s[11 * 33]); o.w = pk4_fp8(s[12 * 33], s[13 * 33], s[14 * 33], s[15 * 33]);
        *(GAS v4u*)(WT + (size_t)(drow0 + n) * ldk + k0 + 16 * c) = o; }
    LDS_WAIT(); asm volatile("" ::: "memory");
}
__device__ __forceinline__ int rowmap_in(int n0) {
    const int seg = n0 >> 10, o = n0 & 1023;
    if (seg == 0) return o;
    if (seg == 1) return 1024 + 256 * (o >> 7) + (o & 127);
    if (seg == 2 || seg == 3) { const int j = o >> 8, r = o & 255; return (seg == 2 ? 3072 : 4096) + 256 * j + 128 * ((r >> 5) & 1) + 32 * (r >> 6) + (r & 31); }
    if (seg == 4) return 5120 + o;
    if (seg == 5) return 1024 + 256 * (o >> 7) + 128 + (o & 127);
    return 6144 + o;
}
struct P0Args { const float *c, *w_ada, *b_ada, *w_in, *w_o, *w_router, *we_gate, *we_up, *we_down, *ws_gate, *ws_up, *ws_down, *lru_wa, *lru_wx, *lru_lambda; const int* positions; };
__device__ __forceinline__ void p0_prologue(Frame& F, const P0Args& a, unsigned char* ws) {
    float* mod = (float*)(ws + WS_MOD);
    __syncthreads();
    for (int u = F.vcu; u < 192; u += F.G) {
        LAS float* sc = (LAS float*)F.lds; LAS float* red = (LAS float*)(F.lds + 32768);
        for (int i = F.tid; i < 8192; i += 512) { const float v = a.c[i]; sc[i] = v * sigm(v); }
        __syncthreads();
        const int cl = F.tid & 31, ks = F.tid >> 5, col = u * 32 + cl;
        float acc[8];
#pragma unroll
        for (int b = 0; b < 8; ++b) acc[b] = 0.f;
#pragma unroll 16
        for (int k = ks * 64; k < ks * 64 + 64; ++k) { const float w = a.w_ada[(size_t)k * 6144 + col];
#pragma unroll
            for (int b = 0; b < 8; ++b) acc[b] += sc[b * 1024 + k] * w; }
#pragma unroll
        for (int b = 0; b < 8; ++b) red[(ks * 8 + b) * 32 + cl] = acc[b];
        __syncthreads();
        if (F.tid < 256) { const int b = F.tid >> 5; float s = a.b_ada[col];
#pragma unroll
          for (int k2 = 0; k2 < 16; ++k2) s += red[(k2 * 8 + b) * 32 + cl];
          mod[b * 6144 + col] = s; }
        __syncthreads();
    }
    const int gt = F.vcu * 512 + F.tid, NT_ = F.G * 512;
    if (gt < 1024) { const double z = -(double)a.lru_lambda[gt]; const double sp = (z > 0.0 ? z : 0.0) + log1p(exp(-(z > 0.0 ? z : -z))); ((float*)(ws + WS_C8SP))[gt] = (float)(8.0 * sp); }
    for (int idx = gt; idx < T * 8; idx += NT_) { const int tok = idx >> 3, i = idx & 7;
        const float inv = exp2f(-(float)i * 0.125f * 18.931568569324174f);
        const float ang = (float)a.positions[tok] * inv;
        double rev = (double)ang * 0.15915494309189535; rev -= floor(rev); const float fr = (float)rev;
        float* cs = (float*)(ws + WS_CST) + (size_t)tok * 16;
        cs[i] = __builtin_amdgcn_cosf(fr); cs[8 + i] = __builtin_amdgcn_sinf(fr); }
    LAS float* scr = (LAS float*)(F.lds + RING_OFF + F.wave * 16384);
    const int gw = F.vcu * NWAVES + F.wave, NGW = F.G * NWAVES;
    bf16* Wo_t = (bf16*)(ws + WS_WO); bf16* Wr_t = (bf16*)(ws + WS_WR); bf16* Wlru = (bf16*)(ws + WS_WLRU);
    constexpr int I_IN = 16 * 224, I_O = 16 * 32, I_R = 16 * 8, I_E = 384 * 257, I_L = 64;
    constexpr int NITEMS = I_E + I_IN + I_O + I_R + I_L;
    for (int it = gw + I_E; it < NITEMS; it += NGW) {
        int r = it;
        if (r < I_E) { const int e = r / 384, q = r % 384, which = q >> 7, ii = q & 127;
            if (which < 2) { const float* src = (e < 256) ? ((which ? a.we_up : a.we_gate) + (size_t)e * 262144) : (which ? a.ws_up : a.ws_gate);
                const int kb = ii >> 3, nb = ii & 7, n0 = nb * 32;
                transpose_item8(src, 256, ws + WS_WEGU + (size_t)e * 524288, 1024, kb * 64, n0, 256 * (n0 >> 7) + (which ? 128 : 0) + (n0 & 127), SC_W, scr, F.lane);
            } else { const float* src = (e < 256) ? (a.we_down + (size_t)e * 262144) : a.ws_down;
                const int kb = ii >> 5, nb = ii & 31;
                transpose_item8(src, 1024, ws + WS_WED + (size_t)e * 262144, 256, kb * 64, nb * 32, nb * 32, SC_W, scr, F.lane); }
            continue; }
        r -= I_E;
        if (r < I_IN) { const int kb = r / 224, nb = r % 224; transpose_item8(a.w_in, INW, ws + WS_WIN, 1024, kb * 64, nb * 32, rowmap_in(nb * 32), SC_W, scr, F.lane); continue; }
        r -= I_IN;
        if (r < I_O) { const int kb = r >> 5, nb = r & 31; transpose_item(a.w_o, 1024, Wo_t, 1024, kb * 64, nb * 32, nb * 32, scr, F.lane); continue; }
        r -= I_O;
        if (r < I_R) { const int kb = r >> 3, nb = r & 7; transpose_item(a.w_router, 256, Wr_t, 1024, kb * 64, nb * 32, nb * 32, scr, F.lane); continue; }
        r -= I_R;
        { const int g = r >> 2, wx = (r >> 1) & 1, hf = r & 1;
          transpose_item((wx ? a.lru_wx : a.lru_wa) + (size_t)g * 4096, 64, Wlru, 64, 0, hf * 32, (g * 2 + hf) * 64 + (wx ? 32 : 0), scr, F.lane); }
    }
}

struct ExpertConvHook {
    static constexpr int NSLICE = 8;
    LAS unsigned char* lds;
    __device__ __forceinline__ void operator()(int s) const {
        const int G = (int)gridDim.x, bx = (int)blockIdx.x, vcu = (G % 8 == 0) ? (bx % 8) * (G / 8) + bx / 8 : bx;
        int tdx = (int)threadIdx.x; asm volatile("" : "+v"(tdx));
        const int wave = __builtin_amdgcn_readfirstlane(tdx >> 6), lane = tdx & 63;
        LAS float* scr = (LAS float*)(lds + RING_OFF + wave * 16384);
        const volatile LAS unsigned* pt = (const volatile LAS unsigned*)(lds + LDSCTL_OFF + 1536);
#define ECH_PTR(i) ((GAS unsigned char*)(((unsigned long long)(unsigned)__builtin_amdgcn_readfirstlane(pt[2 * (i) + 1]) << 32) | (unsigned)__builtin_amdgcn_readfirstlane(pt[2 * (i)])))
        unsigned char* ws = (unsigned char*)ECH_PTR(32);
        constexpr int I_E = 384 * 257;
        const int gw = vcu * NWAVES + wave, NGW = G * NWAVES, KIT = (I_E + NGW - 1) / NGW;
#define ECH_DEC(r_, S, LDN, Dp, LDK) do { const int e_ = (r_) / 384, q_ = (r_) % 384, wh_ = q_ >> 7, ii_ = q_ & 127; \
            if (wh_ < 2) { const int kb_ = ii_ >> 3, n0_ = (ii_ & 7) * 32; S = ((e_ < 256) ? ((const float*)ECH_PTR(wh_ ? 26 : 25) + (size_t)e_ * 262144) : (const float*)ECH_PTR(wh_ ? 29 : 28)) + (size_t)(kb_ * 64) * 256 + n0_; LDN = 256; \
                Dp = ws + WS_WEGU + (size_t)e_ * 524288 + (size_t)(256 * (n0_ >> 7) + (wh_ ? 128 : 0) + (n0_ & 127)) * 1024 + kb_ * 64; LDK = 1024; } \
            else { const int kb_ = ii_ >> 5, nb_ = ii_ & 31; S = ((e_ < 256) ? ((const float*)ECH_PTR(27) + (size_t)e_ * 262144) : (const float*)ECH_PTR(30)) + (size_t)(kb_ * 64) * 1024 + nb_ * 32; LDN = 1024; \
                Dp = ws + WS_WED + (size_t)e_ * 262144 + (size_t)(nb_ * 32) * 256 + kb_ * 64; LDK = 256; } } while (0)
#define ECH_LOAD(v, S, LDN) do { const unsigned lo_ = (unsigned)((lane >> 5) * LDN + (lane & 31));        \
            _Pragma("unroll") for (int i = 0; i < 32; ++i) v[i] = __builtin_nontemporal_load((const GAS float*)S + (size_t)(2 * i) * (unsigned)LDN + lo_); } while (0)
#define ECH_STORE(v, Dp, LDK) do { _Pragma("unroll") for (int i = 0; i < 32; ++i) { const int kk = 2 * i + (lane >> 5); scr[kk * 33 + (lane & 31)] = v[i] * SC_W; } \
            LDS_WAIT(); asm volatile("" ::: "memory"); \
            { const int c = lane & 3; _Pragma("unroll") for (int j = 0; j < 2; ++j) { const int n = (lane >> 2) + 16 * j; const LAS float* s_ = scr + (16 * c) * 33 + n; v4u o; \
                o.x = pk4_fp8(s_[0 * 33], s_[1 * 33], s_[2 * 33], s_[3 * 33]); o.y = pk4_fp8(s_[4 * 33], s_[5 * 33], s_[6 * 33], s_[7 * 33]); \
                o.z = pk4_fp8(s_[8 * 33], s_[9 * 33], s_[10 * 33], s_[11 * 33]); o.w = pk4_fp8(s_[12 * 33], s_[13 * 33], s_[14 * 33], s_[15 * 33]); \
                *(GAS v4u*)(Dp + (size_t)n * LDK + 16 * c) = o; } } \
            LDS_WAIT(); asm volatile("" ::: "memory"); } while (0)
        int k = KIT * s / NSLICE; const int k1 = KIT * (s + 1) / NSLICE; int nk = 0; while (k + nk < k1 && gw + (k + nk) * NGW < I_E) ++nk;
        float vA[32], vB[32]; const float *sA = nullptr, *sB = nullptr; unsigned char *dA = nullptr, *dB = nullptr; int lnA = 0, lnB = 0, lkA = 0, lkB = 0;
        if (nk > 0) { ECH_DEC(gw + k * NGW, sA, lnA, dA, lkA); ECH_LOAD(vA, sA, lnA); }
        for (int j = 0; j < nk; j += 2) {
            if (j + 1 < nk) { ECH_DEC(gw + (k + j + 1) * NGW, sB, lnB, dB, lkB); ECH_LOAD(vB, sB, lnB); }
            ECH_STORE(vA, dA, lkA);
            if (j + 2 < nk) { ECH_DEC(gw + (k + j + 2) * NGW, sA, lnA, dA, lkA); ECH_LOAD(vA, sA, lnA); }
            if (j + 1 < nk) { ECH_STORE(vB, dB, lkB); } }
#undef ECH_DEC
#undef ECH_LOAD
#undef ECH_STORE
#undef ECH_PTR
        __syncthreads();
    }
};

__device__ __forceinline__ void norm_mod_phase(Frame& F, const float* src, const float* gvec, const float* mod, int off_shift, int off_scale, bf16* dst, unsigned char* dst8) {
    const int gw = F.vcu * NWAVES + F.wave, NGW = F.G * NWAVES;
    for (int blk = gw; blk < T / 16; blk += NGW) {
        const int row0 = blk * 16, b = row0 >> 12; const float* mp = mod + (size_t)b * 6144;
        f32x4 g[4], sc[4], sh[4];
#pragma unroll
        for (int j = 0; j < 4; ++j) { const int col = 4 * F.lane + 256 * j; g[j] = *(const GAS f32x4*)(gvec + col); sc[j] = *(const GAS f32x4*)(mp + off_scale + col) + 1.0f; sh[j] = *(const GAS f32x4*)(mp + off_shift + col); }
        for (int r = 0; r < 16; ++r) {
            const GAS f32x4* xr = (const GAS f32x4*)(src + (size_t)(row0 + r) * D) + F.lane;
            f32x4 v[4]; float s = 0.f;
#pragma unroll
            for (int j = 0; j < 4; ++j) { v[j] = xr[64 * j]; s += (v[j].x * v[j].x + v[j].y * v[j].y) + (v[j].z * v[j].z + v[j].w * v[j].w); }
            const float rstd = 1.0f / sqrtf(wave_sum(s) * (1.0f / D) + EPS);
            GAS unsigned long long* o8 = (GAS unsigned long long*)(dst + (size_t)(row0 + r) * D) + F.lane;
#pragma unroll
            for (int j = 0; j < 4; ++j) { const f32x4 y = (v[j] * rstd * g[j]) * sc[j] + sh[j];
                if (dst) o8[64 * j] = (unsigned long long)pk2(y.x, y.y) | ((unsigned long long)pk2(y.z, y.w) << 32);
                if (dst8) *((GAS unsigned*)(dst8 + (size_t)(row0 + r) * D) + F.lane + 64 * j) = pk4_fp8(y.x * SC_H, y.y * SC_H, y.z * SC_H, y.w * SC_H); }
        }
    }
}

struct LruArgs { const bf16* XR; const bf16* GAR; const bf16* YB; bf16* MIX; const bf16* Wlru;
    const float *conv_w, *conv_b, *lru_ba, *lru_bx, *c8sp; };
__device__ __forceinline__ void lru_phase(Frame& F, const LruArgs& a) {
    typedef short bf16x8v __attribute__((ext_vector_type(8)));
    LAS unsigned char* L = F.lds;
    LAS unsigned char* At = L;
    LAS float* AGG = (LAS float*)(L + 36864);
    LAS unsigned char* HT = L + 38912;
    const int tid = F.tid, lane = F.lane, w = F.wave, fr = lane & 15, fq = lane >> 4, cp = tid & 31, sub = tid >> 5;
    for (int u = F.vcu; u < 256; u += F.G) {
        const int b = u >> 5, g = (u >> 1) & 15, hf = u & 1;
        bf16x8v bfr[4][2];
        { const bf16* wl = a.Wlru + (size_t)((g * 2 + hf) * 64) * 64;
#pragma unroll
          for (int nb = 0; nb < 4; ++nb)
#pragma unroll
              for (int kk = 0; kk < 2; ++kk) bfr[nb][kk] = *(const GAS bf16x8v*)(wl + (nb * 16 + fr) * 64 + kk * 32 + fq * 8); }
        const int chc = g * 64 + 2 * cp;
        float cw[4][2], cb[2];
#pragma unroll
        for (int tp = 0; tp < 4; ++tp) { cw[tp][0] = a.conv_w[tp * 1024 + chc]; cw[tp][1] = a.conv_w[tp * 1024 + chc + 1]; }
        cb[0] = a.conv_b[chc]; cb[1] = a.conv_b[chc + 1];
        float ba2[2], bx2[2], c8[2];
#pragma unroll
        for (int nbp = 0; nbp < 2; ++nbp) { const int ch = g * 64 + hf * 32 + 16 * nbp + fr; ba2[nbp] = a.lru_ba[ch]; bx2[nbp] = a.lru_bx[ch]; c8[nbp] = a.c8sp[ch] * 1.4426950408889634f; }
        float carry[2] = {0.f, 0.f};
        const bf16* xr = a.XR + (size_t)b * SEQ * D + chc;
        unsigned xraw[19];
#pragma unroll
        for (int j = 0; j < 19; ++j) { const int t = 16 * sub - 3 + j; xraw[j] = (t >= 0) ? *(const GAS unsigned*)(xr + (size_t)t * D) : 0u; }
        const int part = tid & 3;
        for (int it = 0; it < 16; ++it) {
            const int t0 = it * 256;
            { float x0[19], x1[19];
#pragma unroll
              for (int j = 0; j < 19; ++j) { x0[j] = bflo(xraw[j]); x1[j] = bfhi(xraw[j]); }
#pragma unroll
              for (int j = 0; j < 16; ++j) {
                  const float y0 = cb[0] + cw[0][0] * x0[j] + cw[1][0] * x0[j + 1] + cw[2][0] * x0[j + 2] + cw[3][0] * x0[j + 3];
                  const float y1 = cb[1] + cw[0][1] * x1[j] + cw[1][1] * x1[j + 1] + cw[2][1] * x1[j + 2] + cw[3][1] * x1[j + 3];
                  *(LAS unsigned*)(At + (16 * sub + j) * 144 + 4 * cp) = pk2(y0, y1); } }
            if (it + 1 < 16) {
#pragma unroll
                for (int j = 0; j < 19; ++j) { const int t = t0 + 256 + 16 * sub - 3 + j; xraw[j] = *(const GAS unsigned*)(xr + (size_t)t * D); } }
            v4u garv[2], ybv[2];
#pragma unroll
            for (int j = 0; j < 2; ++j) { const size_t go = (size_t)(b * SEQ + t0 + (tid >> 2) + 128 * j) * D + g * 64 + hf * 32 + part * 8; garv[j] = *(const GAS v4u*)(a.GAR + go); ybv[j] = *(const GAS v4u*)(a.YB + go); }
            LBAR();
            float hl[2][2][4], pl[2][2][4], Pw[2][2], Hw[2][2], Pe[2][2], He[2][2];
#pragma unroll
            for (int sb = 0; sb < 2; ++sb) {
                f32x4 acc[4];
                { const int row = 32 * w + 16 * sb + fr;
                  const bf16x8v a0 = *(const LAS bf16x8v*)(At + row * 144 + fq * 16), a1 = *(const LAS bf16x8v*)(At + row * 144 + 64 + fq * 16);
#pragma unroll
                  for (int nb = 0; nb < 4; ++nb) { acc[nb] = __builtin_amdgcn_mfma_f32_16x16x32_bf16(a0, bfr[nb][0], (f32x4){0.f, 0.f, 0.f, 0.f}, 0, 0, 0);
                      acc[nb] = __builtin_amdgcn_mfma_f32_16x16x32_bf16(a1, bfr[nb][1], acc[nb], 0, 0, 0); } }
#pragma unroll
                for (int nbp = 0; nbp < 2; ++nbp) { float h = 0.f, p = 1.f;
#pragma unroll
                    for (int rg = 0; rg < 4; ++rg) { const int tk = 32 * w + 16 * sb + 4 * fq + rg;
                        const float xcv = bf2f(*(const LAS unsigned short*)(At + tk * 144 + (hf * 32 + 16 * nbp + fr) * 2));
                        const float r = sigm(acc[nbp][rg] + ba2[nbp]), ig = sigm(acc[2 + nbp][rg] + bx2[nbp]);
                        const float av = __builtin_amdgcn_exp2f(-r * c8[nbp]), mu = __builtin_amdgcn_sqrtf(__builtin_fmaf(-av, av, 1.0f)), uu = mu * ig * xcv;
                        h = av * h + uu; p = p * av; hl[sb][nbp][rg] = h; pl[sb][nbp][rg] = p; }
                    float Pp = __shfl(p, lane - 16), Hp = __shfl(h, lane - 16);
                    if (fq >= 1) { h = p * Hp + h; p = p * Pp; }
                    Pp = __shfl(p, lane - 32); Hp = __shfl(h, lane - 32);
                    if (fq >= 2) { h = p * Hp + h; p = p * Pp; }
                    Pw[sb][nbp] = __shfl(p, 48 + fr); Hw[sb][nbp] = __shfl(h, 48 + fr);
                    Pp = __shfl(p, lane - 16); Hp = __shfl(h, lane - 16);
                    Pe[sb][nbp] = fq >= 1 ? Pp : 1.f; He[sb][nbp] = fq >= 1 ? Hp : 0.f; } }
            if (fq == 3) {
#pragma unroll
                for (int nbp = 0; nbp < 2; ++nbp) { AGG[(w * 32 + 16 * nbp + fr) * 2] = Pw[0][nbp] * Pw[1][nbp]; AGG[(w * 32 + 16 * nbp + fr) * 2 + 1] = Pw[1][nbp] * Hw[0][nbp] + Hw[1][nbp]; } }
            LBAR();
#pragma unroll
            for (int nbp = 0; nbp < 2; ++nbp) { float c = carry[nbp], cwv = 0.f;
#pragma unroll
                for (int w2 = 0; w2 < 8; ++w2) { const float Pa = AGG[(w2 * 32 + 16 * nbp + fr) * 2], Ha = AGG[(w2 * 32 + 16 * nbp + fr) * 2 + 1]; if (w2 == w) cwv = c; c = Pa * c + Ha; }
                carry[nbp] = c;
#pragma unroll
                for (int sb = 0; sb < 2; ++sb) { const float cin = sb == 0 ? cwv : Pw[0][nbp] * cwv + Hw[0][nbp]; const float hent = He[sb][nbp] + Pe[sb][nbp] * cin;
#pragma unroll
                    for (int rg = 0; rg < 4; ++rg) { const float hf_ = hl[sb][nbp][rg] + pl[sb][nbp][rg] * hent;
                        *(LAS unsigned short*)(HT + (32 * w + 16 * sb + 4 * fq + rg) * 80 + (16 * nbp + fr) * 2) = (unsigned short)f2bf(hf_); } } }
            LBAR();
#pragma unroll
            for (int j = 0; j < 2; ++j) { const int tk = (tid >> 2) + 128 * j; const v4u hv = *(const LAS v4u*)(HT + tk * 80 + part * 16); const v4u gv = garv[j], yv = ybv[j]; v4u o;
#pragma unroll
              for (int k = 0; k < 4; ++k) o[k] = pk2(bflo(hv[k]) * bflo(gv[k]) + bflo(yv[k]), bfhi(hv[k]) * bfhi(gv[k]) + bfhi(yv[k]));
              *(GAS v4u*)(a.MIX + (size_t)(b * SEQ + t0 + tk) * D + g * 64 + hf * 32 + part * 8) = o; }
        }
        LBAR();
    }
}

struct MixArgs { const bf16 *O0, *O1, *GB; bf16* MIX; const float *lq1, *lk1, *lq2, *lk2, *subln_g; };
__device__ __forceinline__ void mix_phase(Frame& F, const MixArgs& a) {
    const int gw = F.vcu * NWAVES + F.wave, NGW = F.G * NWAVES, lane = F.lane;
    const float lam = __expf(wave_sum(a.lq1[lane] * a.lk1[lane])) - __expf(wave_sum(a.lq2[lane] * a.lk2[lane])) + 0.2f;
    float sg[16];
#pragma unroll
    for (int i = 0; i < 16; ++i) sg[i] = a.subln_g[16 * (lane & 7) + i] * 0.8f;
    for (int blk = gw; blk < T / 16; blk += NGW) {
        for (int r = 0; r < 16; ++r) {
            const size_t off = (size_t)(blk * 16 + r) * D + 16 * lane;
            v4u o0[2], o1[2], gb[2], mx[2];
#pragma unroll
            for (int q = 0; q < 2; ++q) { o0[q] = *(const GAS v4u*)(a.O0 + off + 8 * q); o1[q] = *(const GAS v4u*)(a.O1 + off + 8 * q); gb[q] = *(const GAS v4u*)(a.GB + off + 8 * q); mx[q] = *(const GAS v4u*)(a.MIX + off + 8 * q); }
            float o[16]; float ss = 0.f;
#pragma unroll
            for (int q = 0; q < 2; ++q)
#pragma unroll
                for (int k = 0; k < 4; ++k) { const float lo = bflo(o0[q][k]) - lam * bflo(o1[q][k]), hi = bfhi(o0[q][k]) - lam * bfhi(o1[q][k]); o[8 * q + 2 * k] = lo; o[8 * q + 2 * k + 1] = hi; ss += lo * lo + hi * hi; }
            ss += __shfl_xor(ss, 1); ss += __shfl_xor(ss, 2); ss += __shfl_xor(ss, 4);
            const float rstd = 1.0f / sqrtf(ss * (1.0f / 128.0f) + EPS);
            v4u out[2];
#pragma unroll
            for (int q = 0; q < 2; ++q)
#pragma unroll
                for (int k = 0; k < 4; ++k) { const int i0 = 8 * q + 2 * k;
                    const float lo = bflo(mx[q][k]) + sigm(bflo(gb[q][k])) * (o[i0] * rstd * sg[i0]), hi = bfhi(mx[q][k]) + sigm(bfhi(gb[q][k])) * (o[i0 + 1] * rstd * sg[i0 + 1]);
                    out[q][k] = pk2(lo, hi); }
#pragma unroll
            for (int q = 0; q < 2; ++q) *(GAS v4u*)(a.MIX + off + 8 * q) = out[q];
        }
    }
}

__device__ __forceinline__ unsigned wave_max_u32(unsigned v) {
    unsigned t;
    t = (unsigned)__builtin_amdgcn_update_dpp(0, (int)v, 0xB1, 0xF, 0xF, false); v = v > t ? v : t;
    t = (unsigned)__builtin_amdgcn_update_dpp(0, (int)v, 0x4E, 0xF, 0xF, false); v = v > t ? v : t;
    t = (unsigned)__builtin_amdgcn_update_dpp(0, (int)v, 0x141, 0xF, 0xF, false); v = v > t ? v : t;
    t = (unsigned)__builtin_amdgcn_update_dpp(0, (int)v, 0x140, 0xF, 0xF, false); v = v > t ? v : t;
    t = (unsigned)__builtin_amdgcn_update_dpp(0, (int)v, 0x142, 0xA, 0xF, false); v = v > t ? v : t;
    t = (unsigned)__builtin_amdgcn_update_dpp(0, (int)v, 0x143, 0xC, 0xF, false); v = v > t ? v : t;
    return (unsigned)__builtin_amdgcn_readlane((int)v, 63);
}
__device__ __forceinline__ void topk_phase(Frame& F, const float* logits, const float* rbias, v4u* rec, int* posm, gu32* cnt) {
    LAS unsigned* hist = (LAS unsigned*)F.lds;
    LAS unsigned* baseL = hist + 256;
    LAS int* ek = (LAS int*)(hist + 512);
    LAS int* rk = ek + 1024;
    LAS float* gk = (LAS float*)(rk + 1024);
    const int lane = F.lane;
    const f32x4 bias = *(const GAS f32x4*)(rbias + 4 * lane);
    for (int tb = F.vcu; tb < T / 128; tb += F.G) {
        for (int i = F.tid; i < 256; i += 512) hist[i] = 0u;
        __syncthreads();
        f32x4 lgn = *(const GAS f32x4*)(logits + (size_t)(tb * 128 + F.wave * 16) * 256 + 4 * lane);
        for (int tl = F.wave * 16; tl < F.wave * 16 + 16; ++tl) {
            const int tok = tb * 128 + tl;
            const f32x4 lg = lgn;
            if (tl + 1 < F.wave * 16 + 16) lgn = *(const GAS f32x4*)(logits + (size_t)(tok + 1) * 256 + 4 * lane);
            const float s0 = sigm(lg.x), s1 = sigm(lg.y), s2 = sigm(lg.z), s3 = sigm(lg.w);
            unsigned k0, k1, k2, k3;
            { const unsigned e0 = 255u - 4u * (unsigned)lane;
#define TK_KEY(S, B, E) ({ const unsigned u_ = __float_as_uint((S) + (B)); (((u_ & 0x80000000u) ? ~u_ : (u_ | 0x80000000u)) & 0xFFFFFF00u) | (E); })
              k0 = TK_KEY(s0, bias.x, e0); k1 = TK_KEY(s1, bias.y, e0 - 1u); k2 = TK_KEY(s2, bias.z, e0 - 2u); k3 = TK_KEY(s3, bias.w, e0 - 3u);
#undef TK_KEY
            }
            int my_e = 0; float my_s = 0.f, ssum = 0.f;
#pragma unroll
            for (int k = 0; k < 8; ++k) {
                const unsigned m01 = k0 > k1 ? k0 : k1, m23 = k2 > k3 ? k2 : k3, ml = m01 > m23 ? m01 : m23;
                const unsigned win = wave_max_u32(ml);
                const int e = 255 - (int)(win & 255u), own = e >> 2, j = e & 3;
                const float sj = j == 0 ? s0 : j == 1 ? s1 : j == 2 ? s2 : s3;
                const float sv = __builtin_bit_cast(float, __builtin_amdgcn_readlane(__builtin_bit_cast(int, sj), own));
                k0 = k0 == win ? 0u : k0; k1 = k1 == win ? 0u : k1; k2 = k2 == win ? 0u : k2; k3 = k3 == win ? 0u : k3;
                ssum += sv;
                if (lane == k) { my_e = e; my_s = sv; }
            }
            if (lane < 8) { const float gte = my_s / ssum * 2.5f; gk[tl * 8 + lane] = gte;
                const unsigned rank = __hip_atomic_fetch_add(&hist[my_e], 1u, __ATOMIC_RELAXED, __HIP_MEMORY_SCOPE_WORKGROUP); ek[tl * 8 + lane] = my_e; rk[tl * 8 + lane] = (int)rank; }
        }
        __syncthreads();
        if (F.tid < 256) { const unsigned h = hist[F.tid]; baseL[F.tid] = h ? __hip_atomic_fetch_add(cnt + F.tid, h, RLX_AGENT) : 0u; }
        __syncthreads();
        for (int i = F.tid; i < 1024; i += 512) { const int e = ek[i], ps = (int)baseL[e] + rk[i], tok = tb * 128 + (i >> 3);
            ((GAS v4u*)rec)[(size_t)e * REC_CAP + ps] = (v4u){0u, __float_as_uint(gk[i]), (unsigned)tok, 0u}; ((GAS int*)posm)[(size_t)tb * 1024 + i] = (e << 16) | ps; }
        if (F.tid < 128) { const int tok = tb * 128 + F.tid; ((GAS v4u*)rec)[(size_t)NEXP * REC_CAP + tok] = (v4u){0u, __float_as_uint(1.0f), (unsigned)tok, 0u}; }
        __syncthreads();
    }
}
__device__ __forceinline__ void expert_prefix(Frame& F, gu32* cnt) {
    LAS int* startL = (LAS int*)(F.lds + PFX_OFF); LAS int* tsL = startL + 258;
    if (__builtin_amdgcn_readfirstlane((int)F.MISC[12]) != 0) return;
    int tid = (int)threadIdx.x; asm volatile("" : "+v"(tid));
    LAS int* cntL = (LAS int*)F.lds; LAS int* segC = cntL + 320; LAS int* segT = segC + 16;
    __syncthreads();
    if (tid < 256) cntL[tid] = (int)__hip_atomic_load(cnt + tid, RLX_AGENT); else if (tid == 256) cntL[256] = T;
    __syncthreads();
    if (tid < 8) { int sc = 0, st = 0; for (int e = 32 * tid; e < 32 * tid + 32; ++e) { sc += cntL[e]; st += (cntL[e] + 255) >> 8; } segC[tid] = sc; segT[tid] = st; }
    __syncthreads();
    if (tid < 258) { const int e = tid, sg = e >> 5; int s = 0, ts = 0;
        for (int w = 0; w < sg && w < 8; ++w) { s += segC[w]; ts += segT[w]; }
        for (int q = (sg < 8 ? sg : 8) * 32; q < e; ++q) { s += cntL[q]; ts += (cntL[q] + 255) >> 8; }
        startL[e] = s; tsL[e] = ts; }
    __syncthreads();
    if (tid == 0) F.MISC[12] = 1u;
    __syncthreads();
}

template <bool GATHER> struct MoeOrder {
    const void* A; const void* Bt; int Kb; int rowsB;
    const LAS int* utab; const LAS int* toktab; int nun, reps;
    __device__ __forceinline__ bool next(int i, pg8::Unit& u) const {
        if (i >= nun * reps) return false; i %= nun;
        u.e = __builtin_amdgcn_readfirstlane(utab[4 * i]); u.row0 = __builtin_amdgcn_readfirstlane(utab[4 * i + 1]); u.nrows = __builtin_amdgcn_readfirstlane(utab[4 * i + 2]); u.pn = __builtin_amdgcn_readfirstlane(utab[4 * i + 3]); u.pm = i; return true; }
    __device__ __forceinline__ const char* a_base(const pg8::Unit& u) const { return GATHER ? (const char*)A : (const char*)A + (size_t)u.row0 * Kb; }
    __device__ __forceinline__ const char* b_base(const pg8::Unit& u) const { return (const char*)Bt + ((size_t)u.e * rowsB + (size_t)u.pn * 256) * Kb; }
    __device__ __forceinline__ void a_voff(const pg8::Unit&, int ui, const int (&R)[2], const int (&C)[2], unsigned (&v)[2][2]) const {
#pragma unroll
        for (int h = 0; h < 2; ++h)
#pragma unroll
            for (int i = 0; i < 2; ++i) v[h][i] = GATHER ? (unsigned)toktab[(ui % nun) * 256 + h * 128 + R[i]] * (unsigned)Kb + (unsigned)(C[i] * 2) : (unsigned)((h * 128 + R[i]) * Kb + C[i] * 2);
    }
    __device__ __forceinline__ void a_ready(const pg8::Unit&) const {}
    __device__ __forceinline__ void done(const pg8::Unit&) const {}
};
struct SharedGU {
    const void* A; const void* Bt; int Kb; int first, stride, n;
    __device__ __forceinline__ bool next(int i, pg8::Unit& u) const { if (i >= n) return false; const int idx = first + i * stride; u.e = NEXP; u.row0 = T * TOPK + 256 * (idx >> 1); u.nrows = 256; u.pn = idx & 1; u.pm = 0; return true; }
    __device__ __forceinline__ const char* a_base(const pg8::Unit& u) const { return (const char*)A + (size_t)(u.row0 - T * TOPK) * Kb; }
    __device__ __forceinline__ const char* b_base(const pg8::Unit& u) const { return (const char*)Bt + ((size_t)NEXP * 512 + (size_t)u.pn * 256) * Kb; }
    __device__ __forceinline__ void a_voff(const pg8::Unit&, int, const int (&R)[2], const int (&C)[2], unsigned (&v)[2][2]) const {
#pragma unroll
        for (int h = 0; h < 2; ++h)
#pragma unroll
            for (int i = 0; i < 2; ++i) v[h][i] = (unsigned)((h * 128 + R[i]) * Kb + C[i] * 2);
    }
    __device__ __forceinline__ void a_ready(const pg8::Unit&) const {}
    __device__ __forceinline__ void done(const pg8::Unit&) const {}
};
template <bool GATHER> __device__ __forceinline__ int moe_tables(Frame& F, gu32* cnt, const v4u* rec, int shift, int skip_tail = 0) {
    LAS int* utab = (LAS int*)(F.lds + UT_OFF); LAS int* toktab = (LAS int*)(F.lds + TOK_OFF); LAS int* bkt = (LAS int*)(F.lds + PFX_OFF + 2064);
    expert_prefix(F, cnt);
    const LAS int* startL = (const LAS int*)(F.lds + PFX_OFF); const LAS int* tsL = startL + 258;
    const int total = (__builtin_amdgcn_readfirstlane(tsL[257]) - skip_tail) << shift;
    int nun = total > F.vcu ? (total - F.vcu + F.G - 1) / F.G : 0;
    const int cap = GATHER ? MAXU_TOK : MAXU_GT; if (nun > cap) nun = cap;
    __syncthreads();
    if (F.tid < nun) { const int Lu = F.tid * F.G + F.vcu, t = Lu >> shift;
        int lo = 0, hi = 257;
        while (lo < hi) { const int mid = (lo + hi + 1) >> 1; if (tsL[mid] <= t) lo = mid; else hi = mid - 1; }
        const int e = lo, j = t - tsL[e], n = startL[e + 1] - startL[e] - 256 * j;
        utab[4 * F.tid] = e; utab[4 * F.tid + 1] = startL[e] + 256 * j; utab[4 * F.tid + 2] = n < 256 ? n : 256; utab[4 * F.tid + 3] = Lu & ((1 << shift) - 1); bkt[F.tid] = e * REC_CAP + 256 * j; }
    __syncthreads();
    if (GATHER) { for (int idx = F.tid; idx < nun * 256; idx += 512) { const int i = idx >> 8, r = idx & 255, nr = utab[4 * i + 2]; toktab[idx] = (int)((const GAS v4u*)rec)[(size_t)bkt[i] + (r < nr ? r : nr - 1)].z; }
        __syncthreads(); }
    else { LAS unsigned short* gtab = (LAS unsigned short*)(F.lds + TOK_OFF);
        for (int idx = F.tid; idx < nun * 256; idx += 512) { const int i = idx >> 8, r = idx & 255, nr = utab[4 * i + 2];
            const unsigned gb = ((const GAS v4u*)rec)[(size_t)bkt[i] + (r < nr ? r : nr - 1)].y; gtab[idx] = __builtin_bit_cast(unsigned short, (_Float16)__uint_as_float(gb)); }
        __syncthreads(); }
    return nun;
}

__device__ __forceinline__ void combine_phase(Frame& F, const unsigned char* ys, const int* posm, gu32* cnt, const float* mod, float* out) {
    expert_prefix(F, cnt); const LAS int* startL = (const LAS int*)(F.lds + PFX_OFF);
    typedef float f32x2c __attribute__((ext_vector_type(2))); typedef unsigned u32x2c __attribute__((ext_vector_type(2)));
    const int gw = F.vcu * NWAVES + F.wave, NGW = F.G * NWAVES, lane = F.lane;
    for (int blk = gw; blk < T / 16; blk += NGW) {
        const int b = (blk * 16) >> 12; const float* gp = mod + (size_t)b * 6144 + 5120;
        const int pv0 = ((const GAS int*)posm)[(size_t)blk * 128 + lane], pv1 = ((const GAS int*)posm)[(size_t)blk * 128 + 64 + lane];
        f32x4 g2[2][2];
#pragma unroll
        for (int j = 0; j < 2; ++j)
#pragma unroll
            for (int q = 0; q < 2; ++q) g2[j][q] = *(const GAS f32x4*)(gp + 512 * j + 8 * lane + 4 * q) * (1.0f / SC_Y);
        for (int r = 0; r < 16; ++r) { const int tok = blk * 16 + r; const int pvr = r < 8 ? pv0 : pv1;
            float acc[2][8];
#pragma unroll
            for (int j = 0; j < 2; ++j)
#pragma unroll
                for (int i = 0; i < 8; ++i) acc[j][i] = 0.f;
#pragma unroll
            for (int s = 0; s < NSLOT; ++s) { int p = T * TOPK + tok; if (s < TOPK) { const int pk = __builtin_amdgcn_readlane(pvr, (r & 7) * 8 + s); p = startL[pk >> 16] + (pk & 0xFFFF); }
#pragma unroll
                for (int j = 0; j < 2; ++j) { const u32x2c v = *(const GAS u32x2c*)(ys + (size_t)p * D + 512 * j + 8 * lane);
#pragma unroll
                    for (int k = 0; k < 2; ++k) { const f32x2c lo = __builtin_amdgcn_cvt_pk_f32_fp8(v[k], false), hi = __builtin_amdgcn_cvt_pk_f32_fp8(v[k], true);
                        acc[j][4 * k] += lo[0]; acc[j][4 * k + 1] += lo[1]; acc[j][4 * k + 2] += hi[0]; acc[j][4 * k + 3] += hi[1]; } } }
            float* orow = out + (size_t)tok * D;
#pragma unroll
            for (int j = 0; j < 2; ++j)
#pragma unroll
                for (int q = 0; q < 2; ++q) { GAS f32x4* p = (GAS f32x4*)(orow + 512 * j + 8 * lane + 4 * q); const f32x4 x1 = *p;
                    const f32x4 av = {acc[j][4 * q], acc[j][4 * q + 1], acc[j][4 * q + 2], acc[j][4 * q + 3]}; *p = x1 + g2[j][q] * av; }
        }
    }
}
#ifndef MK_N_LAUNCHES
#define MK_N_LAUNCHES 1
#endif
constexpr int NPH = 14;
constexpr int N_LAUNCHES = MK_N_LAUNCHES;
struct Args { const void* in[31]; float* out; unsigned char* ws; int ph_lo, ph_hi; };
#ifndef PHMASK
#define PHMASK 0xFFFF
#endif
#ifndef REPMASK
#define REPMASK 0
#endif
#define REPN(k) (1 + ((REPMASK >> (k)) & 1))
constexpr int PTR_OFF = LDSCTL_OFF + 1536;
__device__ __forceinline__ void* ldptr(LAS unsigned char* lds, int i) {
    const volatile LAS unsigned* p = (const volatile LAS unsigned*)(lds + PTR_OFF) + 2 * i;
    const unsigned lo = __builtin_amdgcn_readfirstlane(p[0]), hi = __builtin_amdgcn_readfirstlane(p[1]);
    return (void*)(GAS void*)(((unsigned long long)hi << 32) | lo);
}
__global__ void __launch_bounds__(NWAVES * 64, 2) fwd_kernel(Args args) {
    extern __shared__ __attribute__((aligned(16))) unsigned char lds[];
    Frame F;
    F.lds = (LAS unsigned char*)lds;
    F.MISC = (volatile LAS unsigned*)(F.lds + MISC_OFF);
    F.tid = threadIdx.x; F.lane = F.tid & 63; F.wave = __builtin_amdgcn_readfirstlane(F.tid >> 6);
    F.G = gridDim.x; { const int bx = blockIdx.x; F.vcu = (F.G % 8 == 0) ? (bx % 8) * (F.G / 8) + bx / 8 : bx; }
    F.ctl = (gu32*)(args.ws + WS_CTL);
    for (int u = F.tid; u < (LDS_BYTES - LDSCTL_OFF) / 4; u += NWAVES * 64) ((LAS unsigned*)(F.lds + LDSCTL_OFF))[u] = 0u;
    __syncthreads();
    if (F.tid < 33) { const void* pv = F.tid < 31 ? args.in[F.tid] : (F.tid == 31 ? (const void*)args.out : (const void*)args.ws);
        ((LAS unsigned long long*)(F.lds + PTR_OFF))[F.tid] = (unsigned long long)pv; }
    __syncthreads();
    XcdBarrier bar; bar.bar = (unsigned*)(F.ctl + CW_BAR); bar.x = 0; bar.st = nullptr;
    if (N_LAUNCHES == 1) bar = xcd_barrier_post((unsigned*)(F.ctl + CW_BAR), F.MISC + 8);
#define GRID_BAR() do { if (N_LAUNCHES == 1) { xcd_barrier(bar); } } while (0)
    const int lo = args.ph_lo, hi = args.ph_hi;
#if defined(PROBE_REGION)
    volatile LAS unsigned long long* const prbp = (blockIdx.x == PROBE_BLOCK && F.wave == PROBE_WAVE) ? (volatile LAS unsigned long long*)(F.lds + MISC_OFF + 96) : nullptr;
#define PRBARG(ph) , (PROBE_PHASE == (ph) ? prbp : nullptr)
#else
#define PRBARG(ph)
#endif
#define IN(k) (((PHMASK >> (k)) & 1) && lo <= (k) && (k) < hi)
#if defined(PROBE_CUM)
    const unsigned long long prb_tstart = __builtin_amdgcn_s_memrealtime(); unsigned long long prb_cum = 0;
#define PRB_CUM(k) do { if (PROBE_CUM == (k)) prb_cum = __builtin_amdgcn_s_memrealtime() - prb_tstart; } while (0)
#else
#define PRB_CUM(k) do {} while (0)
#endif
#define BOTH(k) (IN(k) && IN((k) + 1))
#define INP(i) ((const float*)ldptr(F.lds, (i)))
#define OUTP ((float*)ldptr(F.lds, 31))
#define WSP ((unsigned char*)ldptr(F.lds, 32))

    if (IN(0)) { asm volatile("" : "+v"(F.tid), "+v"(F.lane));
        P0Args a{INP(1), INP(3), INP(4), INP(6), INP(21), INP(23), INP(25), INP(26), INP(27), INP(28), INP(29), INP(30), INP(9), INP(11), INP(13), (const int*)INP(2)};
        unsigned char* ws = WSP;
        for (int rep = 0; rep < REPN(0); ++rep) p0_prologue(F, a, ws);
        if (BOTH(0)) GRID_BAR();
    }
    PRB_CUM(1);
    if (IN(1)) { asm volatile("" : "+v"(F.tid), "+v"(F.lane)); unsigned char* ws = WSP; for (int rep = 0; rep < REPN(1); ++rep) norm_mod_phase(F, INP(0), INP(5), (const float*)(ws + WS_MOD), 0, 1024, nullptr, (unsigned char*)OUTP); if (BOTH(1)) GRID_BAR(); }
    PRB_CUM(2);
    if (IN(2)) { asm volatile("" : "+v"(F.tid), "+v"(F.lane));
        unsigned char* ws = WSP;
        pg8::DenseOrder S; S.init(OUTP, ws + WS_WIN, T, INW, D, F.G, (int)blockIdx.x, REPN(2));
        epi::EpiInProj E{(bf16*)(ws + WS_XR), (bf16*)(ws + WS_GAR), (bf16*)(ws + WS_Q), (bf16*)(ws + WS_K), (bf16*)(ws + WS_V), (bf16*)(ws + WS_GB), INP(14), INP(15), (const float*)(ws + WS_CST), 0.125f * 1.4426950408889634f, 1.0f / (SC_H * SC_W)};
        pg8::gemm_phase<epi::EpiInProj, pg8::DenseOrder, true, true>(F.lds + RING_OFF, D, S, E PRBARG(2));
        if (BOTH(2)) GRID_BAR();
    }
    PRB_CUM(3);
    if (IN(4)) { asm volatile("" : "+v"(F.tid), "+v"(F.lane));
        unsigned char* ws = WSP; attn_body::bf16* O0 = (attn_body::bf16*)OUTP;
        const float lam = __expf(wave_sum(INP(16)[F.lane] * INP(17)[F.lane])) - __expf(wave_sum(INP(18)[F.lane] * INP(19)[F.lane])) + 0.2f;
        const attn_body::AttnTensors AT{(const attn_body::bf16*)(ws + WS_Q), (const attn_body::bf16*)(ws + WS_K), (const attn_body::bf16*)(ws + WS_V), O0, O0 + (size_t)T * D, (const attn_body::bf16*)(ws + WS_GB), INP(20), lam};
        const attn_body::PairOrder S((int)F.G, F.vcu);
        const ExpertConvHook H{F.lds}; attn_body::attn_phase<attn_body::PairOrder, ExpertConvHook>((char*)lds + RING_OFF, AT, S, H, REPN(4));
        GRID_BAR();
    }
    PRB_CUM(4);
    if (IN(3)) { asm volatile("" : "+v"(F.tid), "+v"(F.lane));
        unsigned char* ws = WSP;
        LruArgs a{(const bf16*)(ws + WS_XR), (const bf16*)(ws + WS_GAR), (const bf16*)OUTP + (size_t)T * D, (bf16*)(ws + WS_MIX), (const bf16*)(ws + WS_WLRU), INP(7), INP(8), INP(10), INP(12), (const float*)(ws + WS_C8SP)};
        for (int rep = 0; rep < REPN(3); ++rep) lru_phase(F, a);
        GRID_BAR();
    }
    PRB_CUM(5);
    if (IN(6)) { asm volatile("" : "+v"(F.tid), "+v"(F.lane));
        unsigned char* ws = WSP;
        pg8::DenseOrder S; S.init(ws + WS_MIX, ws + WS_WO, T, D, 2 * D, F.G, (int)blockIdx.x, REPN(6));
        epi::EpiWo E{INP(0), OUTP, (const float*)(ws + WS_MOD) + 2048};
        pg8::gemm_phase<epi::EpiWo, pg8::DenseOrder, true>(F.lds + RING_OFF, 2 * D, S, E);
        if (BOTH(6)) GRID_BAR();
    }
    PRB_CUM(6);
    if (IN(7)) { asm volatile("" : "+v"(F.tid), "+v"(F.lane)); unsigned char* ws = WSP; for (int rep = 0; rep < REPN(7); ++rep) norm_mod_phase(F, OUTP, INP(22), (const float*)(ws + WS_MOD), 3072, 4096, (bf16*)(ws + WS_H2), ws + WS_H28); if (BOTH(7)) GRID_BAR(); }
    PRB_CUM(7);
    if (IN(8)) { asm volatile("" : "+v"(F.tid), "+v"(F.lane));
        unsigned char* ws = WSP;
        pg8::DenseOrder S; S.init((const pg8::bf16_t*)(ws + WS_H2), (const pg8::bf16_t*)(ws + WS_WR), T, NEXP, 2 * D, F.G, (int)blockIdx.x, REPN(8));
        epi::EpiF32 E{(float*)(ws + WS_LOGIT)};
        const bool sh_here = (int)F.G > 128;
        if (!sh_here || (int)blockIdx.x < 128) pg8::gemm_phase<epi::EpiF32, pg8::DenseOrder, false>(F.lds + RING_OFF, 2 * D, S, E);
        if (sh_here && (int)blockIdx.x >= 128) { const int nw = (int)F.G - 128, me = (int)blockIdx.x - 128;
            SharedGU S2{ws + WS_H28, ws + WS_WEGU, D, me, nw, (256 - me + nw - 1) / nw};
            epi::EpiGateUp E2{ws + WS_ACT, ws + WS_DUMP, 1.0f / (SC_H * SC_W), SC_A};
            pg8::gemm_phase<epi::EpiGateUp, SharedGU, true, true>(F.lds + RING_OFF, D, S2, E2); }
        if (BOTH(8)) GRID_BAR();
    }
    PRB_CUM(8);
    if (IN(9)) { asm volatile("" : "+v"(F.tid), "+v"(F.lane)); unsigned char* ws = WSP; topk_phase(F, (const float*)(ws + WS_LOGIT), INP(24), (v4u*)(ws + WS_REC), (int*)(ws + WS_POSM), F.ctl + CW_CNT); if (BOTH(9)) GRID_BAR(); }
    PRB_CUM(9);
    PRB_CUM(10);
    if (IN(11)) { asm volatile("" : "+v"(F.tid), "+v"(F.lane));
        unsigned char* ws = WSP;
        const int nun = moe_tables<true>(F, F.ctl + CW_CNT, (const v4u*)(ws + WS_REC), 1, (int)F.G > 128 ? T / 256 : 0);
        MoeOrder<true> S{ws + WS_H28, ws + WS_WEGU, D, 512, (const LAS int*)(F.lds + UT_OFF), (const LAS int*)(F.lds + TOK_OFF), nun, REPN(11)};
        epi::EpiGateUp E{ws + WS_ACT, ws + WS_DUMP, 1.0f / (SC_H * SC_W), SC_A};
        pg8::gemm_phase<epi::EpiGateUp, MoeOrder<true>, true, true>(F.lds + RING_OFF, D, S, E PRBARG(11));
        if (BOTH(11)) GRID_BAR();
    }
    PRB_CUM(11);
    if (IN(12)) { asm volatile("" : "+v"(F.tid), "+v"(F.lane));
        unsigned char* ws = WSP;
        const int nun = moe_tables<false>(F, F.ctl + CW_CNT, (const v4u*)(ws + WS_REC), 2);
        MoeOrder<false> S{ws + WS_ACT, ws + WS_WED, DEXP, 1024, (const LAS int*)(F.lds + UT_OFF), (const LAS int*)(F.lds + TOK_OFF), nun, REPN(12)};
        epi::EpiDown E{ws + WS_YS, (const LAS unsigned short*)(F.lds + TOK_OFF), ws + WS_DUMP, SC_Y / (SC_A * SC_W)};
        if (F.vcu & 1) __builtin_amdgcn_s_sleep(127);
        pg8::gemm_phase<epi::EpiDown, MoeOrder<false>, true, true>(F.lds + RING_OFF, DEXP, S, E PRBARG(12));
        if (BOTH(12)) GRID_BAR();
    }
    PRB_CUM(12);
    if (IN(13)) { asm volatile("" : "+v"(F.tid), "+v"(F.lane)); unsigned char* ws = WSP; combine_phase(F, ws + WS_YS, (const int*)(ws + WS_POSM), F.ctl + CW_CNT, (const float*)(ws + WS_MOD), OUTP); }
    PRB_CUM(13);
#if defined(PROBE_CUM)
    if (blockIdx.x == 0 && F.tid == 0) { const unsigned long long t0 = __builtin_amdgcn_s_memrealtime(), dl = prb_cum * PROBE_MULT; while (__builtin_amdgcn_s_memrealtime() - t0 < dl) __builtin_amdgcn_s_sleep(32); }
#endif
#if defined(PROBE_REGION)
    if (prbp) { const unsigned long long t0 = __builtin_amdgcn_s_memrealtime(), dl = *prbp * PROBE_MULT; while (__builtin_amdgcn_s_memrealtime() - t0 < dl) __builtin_amdgcn_s_sleep(32); }
#endif
#undef IN
#undef BOTH
}

extern "C" void kernel_launch(void* const* d_in, const int* in_sizes, int n_in, void* d_out, int out_size, void* d_ws, size_t ws_size, hipStream_t stream) {
    static int grid = 0;
    if (grid == 0) {
        if (n_in != 31 || in_sizes[0] != T * D || out_size != T * D || ws_size < WS_END) { fprintf(stderr, "kernel_launch: unexpected shapes: n_in %d in0 %d out %d ws %zu (need %zu); nothing launched\n", n_in, n_in > 0 ? in_sizes[0] : -1, out_size, ws_size, (size_t)WS_END); grid = -1; return; }
        int dev = 0, cus = 0, per_cu = 0;
        if (hipGetDevice(&dev) != hipSuccess || hipDeviceGetAttribute(&cus, hipDeviceAttributeMultiprocessorCount, dev) != hipSuccess) { fprintf(stderr, "kernel_launch: device query failed\n"); grid = -1; return; }
        if (hipFuncSetAttribute((const void*)fwd_kernel, hipFuncAttributeMaxDynamicSharedMemorySize, LDS_BYTES) != hipSuccess) { fprintf(stderr, "kernel_launch: hipFuncSetAttribute failed\n"); grid = -1; return; }
        if (hipOccupancyMaxActiveBlocksPerMultiprocessor(&per_cu, (const void*)fwd_kernel, NWAVES * 64, LDS_BYTES) != hipSuccess || per_cu < 1)
            fprintf(stderr, "kernel_launch: note: occupancy query reports %d workgroups per CU\n", per_cu);
        (void)hipGetLastError();
        grid = cus;
    }
    if (grid < 0) return;
    if (hipMemsetAsync((char*)d_ws + WS_CTL, 0, CTL_ZERO_BYTES, stream) != hipSuccess) { fprintf(stderr, "kernel_launch: hipMemsetAsync failed\n"); return; }
    Args a{};
    for (int i = 0; i < 31; ++i) a.in[i] = d_in[i];
    a.out = (float*)d_out; a.ws = (unsigned char*)d_ws;
    for (int li = 0; li < N_LAUNCHES; ++li) {
        a.ph_lo = (N_LAUNCHES == 1) ? 0 : li; a.ph_hi = (N_LAUNCHES == 1) ? NPH : li + 1;
        hipLaunchKernelGGL(fwd_kernel, dim3(grid), dim3(NWAVES * 64), LDS_BYTES, stream, a);
        const hipError_t le = hipPeekAtLastError();
        if (le != hipSuccess) { fprintf(stderr, "kernel_launch: launch %d failed: %s\n", li, hipGetErrorName(le)); break; }
    }
}
```

```cpp
#define REPMASK 0
#include <hip/hip_runtime.h>
#include <hip/hip_bf16.h>
#include <cstdio>
#include <cstdint>
#include <cmath>
namespace pg8 {
#define PG8_LAS __attribute__((address_space(3)))
typedef unsigned short bf16_t;
typedef short bf16x8 __attribute__((ext_vector_type(8)));
typedef float f32x4 __attribute__((ext_vector_type(4)));
typedef float f32x2 __attribute__((ext_vector_type(2)));
typedef unsigned u32x4 __attribute__((ext_vector_type(4)));
typedef int v4i32_t __attribute__((ext_vector_type(4)));
typedef int v8i32_t __attribute__((ext_vector_type(8)));
constexpr int BM = 256, BK = 64, HALF = 128, HTB = HALF * BK * 2  , STAGE_BYTES = 8 * HTB, NXCD = 8, WGM = 8;

__host__ __device__ __forceinline__ int lds_byte(int r, int c) { const int st = (r >> 4) * 2 + (c >> 5), rr = r & 15, cc = c & 31, ob = rr * 64 + cc * 2; return st * 1024 + (ob ^ (((ob >> 9) & 1) << 5)); }
__host__ __device__ __forceinline__ void stage_rc(int b, int& R, int& C) { const int st = b / 1024, sb = b % 1024, swz = sb ^ (((sb >> 9) & 1) << 5); R = (st >> 1) * 16 + swz / 64; C = (st & 1) * 32 + (swz % 64) / 2; }
__host__ __device__ __forceinline__ int perm32(int rho) { const int n = rho >> 4, i = rho & 15; return 8 * (i >> 2) + 4 * n + (i & 3); }

__host__ __device__ __forceinline__ int perm64(int R) { const int w = R >> 5, n = (R >> 4) & 1, i = R & 15; return 64 * w + 16 * (i >> 2) + 4 * n + (i & 3); }
struct Unit { int pm, pn, row0, nrows, e; };

__device__ __forceinline__ unsigned cvt_pk_bf16(float lo, float hi) { unsigned r; asm volatile("v_cvt_pk_bf16_f32 %0, %1, %2" : "=v"(r) : "v"(lo), "v"(hi)); return r; }
__device__ __forceinline__ float sigmoidf_fast(float v) { return __builtin_amdgcn_rcpf(1.0f + __builtin_amdgcn_exp2f(-1.4426950408889634f * v)); }

struct DenseOrder {
    const void* A; const void* Bt; int Kb;
    int nM, nN, nwg, G, c, nmine, reps;
    __device__ __forceinline__ void init(const void* A_, const void* Bt_, int M, int N, int Kb_, int G_, int c_, int reps_ = 1) { A = A_; Bt = Bt_; Kb = Kb_; nM = M / BM; nN = N / BM; nwg = nM * nN; G = G_; c = c_; nmine = nwg > c ? (nwg - c + G - 1) / G : 0; reps = reps_; }
    __device__ __forceinline__ bool next(int i, Unit& u) const {
        if (i >= nmine * reps) return false; const long L = (long)(i % nmine) * G + c;
        int wgid = (int)L; { const int q = nwg / NXCD, r = nwg % NXCD, xcd = wgid % NXCD, off = wgid / NXCD; wgid = (xcd < r ? xcd * (q + 1) : r * (q + 1) + (xcd - r) * q) + off; }
        const int nig = WGM * nN, gid = wgid / nig, fm = gid * WGM, gsz = (nM - fm) < WGM ? (nM - fm) : WGM;
        u.pm = fm + ((wgid % nig) % gsz); u.pn = (wgid % nig) / gsz; u.row0 = u.pm * BM; u.nrows = BM; u.e = 0; return true;
    }
    __device__ __forceinline__ const char* a_base(const Unit& u) const { return (const char*)A + (size_t)u.pm * BM * Kb; }
    __device__ __forceinline__ const char* b_base(const Unit& u) const { return (const char*)Bt + (size_t)u.pn * BM * Kb; }
    __device__ __forceinline__ void a_voff(const Unit&, int, const int (&R)[2], const int (&C)[2], unsigned (&v)[2][2]) const {
#pragma unroll
        for (int h = 0; h < 2; ++h)
#pragma unroll
            for (int i = 0; i < 2; ++i) v[h][i] = (unsigned)((h * HALF + R[i]) * Kb + C[i] * 2);
    }
    __device__ __forceinline__ void a_ready(const Unit&) const {}
    __device__ __forceinline__ void done(const Unit&) const {}
};

#if defined(PROBE_REGION)
#define PRB_T0(R) unsigned long long prb_t0_##R = 0; if (PROBE_REGION == R && prb) prb_t0_##R = __builtin_amdgcn_s_memrealtime()
#define PRB_T1(R) do { if (PROBE_REGION == R && prb) *prb += __builtin_amdgcn_s_memrealtime() - prb_t0_##R; } while (0)
#else
#define PRB_T0(R) do {} while (0)
#define PRB_T1(R) do {} while (0)
#endif
template <class E, class = void> struct epi_nst { static constexpr int maxv = 0; static __device__ __forceinline__ int get(const E&, const Unit&) { return 0; } };
template <class E> struct epi_nst<E, decltype((void)E::NSTMAX)> { static constexpr int maxv = E::NSTMAX; static __device__ __forceinline__ int get(const E& e, const Unit& u) { return e.nst(u); } };
template <int N> __device__ __forceinline__ void wait_vm() { asm volatile("s_waitcnt vmcnt(%0)" :: "n"(N) : "memory"); }
template <class Epi, class Sched, bool ALIGN_EPI, bool FP8 = false>
__device__ __forceinline__ void gemm_phase(PG8_LAS unsigned char* lds, const int Kb, const Sched& S, const Epi& E, volatile PG8_LAS unsigned long long* prb = nullptr) {
    const int tid = threadIdx.x, wid = __builtin_amdgcn_readfirstlane(tid >> 6), lane = tid & 63, wr = wid >> 2, wc = wid & 3, fr = lane & 15, fq = lane >> 4;
    const int nt = Kb / 128;
    constexpr int NSTMAX = epi_nst<Epi>::maxv; int pnst = 0;
    int Rs[2], Cs[2]; unsigned voffB[2];
#pragma unroll
    for (int i = 0; i < 2; ++i) { stage_rc(tid * 16 + i * 8192, Rs[i], Cs[i]); const int Rb = (int)Epi::PERM == 2 ? perm64(Rs[i]) : Epi::PERM ? ((Rs[i] & ~31) + perm32(Rs[i] & 31)) : Rs[i];
        voffB[i] = (unsigned)(Rb * Kb + Cs[i] * 2); }
    const size_t kstep = (size_t)(BK * 2);
    const size_t hstep = (size_t)((int)Epi::PERM == 2 ? 8 : HALF) * Kb;
    const unsigned ldsw = (unsigned)wid * 1024u;
    const int aoff = FP8 ? lds_byte(wr * 64 + fr, fq * 16) : lds_byte(wr * 64 + fr, fq * 8), boff = FP8 ? lds_byte(wc * 32 + fr, fq * 16) : lds_byte(wc * 32 + fr, fq * 8);
#define PG8_SA(b, h) (((b) * 2 + (h)) * HTB)
#define PG8_SB(b, h) ((4 + (b) * 2 + (h)) * HTB)
#define PG8_STAGE(bufoff, gbase, voff) do { _Pragma("unroll") for (int _i = 0; _i < 2; ++_i) \
        __builtin_amdgcn_global_load_lds((const unsigned*)((const char*)(gbase) + (voff)[_i]), (PG8_LAS unsigned*)(lds + (bufoff) + ldsw + _i * 8192), 16, 0, 0); } while (0)
#define PG8_LDA(dst, b, h) do { _Pragma("unroll") for (int m = 0; m < 4; ++m) _Pragma("unroll") for (int k = 0; k < 2; ++k) dst[m][k] = *(const PG8_LAS bf16x8*)(lds + PG8_SA(b, h) + aoff + m * 2048 + k * (FP8 ? 16 : 1024)); } while (0)
#define PG8_LDB(dst, b, h) do { _Pragma("unroll") for (int n = 0; n < 2; ++n) _Pragma("unroll") for (int k = 0; k < 2; ++k) dst[n][k] = *(const PG8_LAS bf16x8*)(lds + PG8_SB(b, h) + boff + n * 2048 + k * (FP8 ? 16 : 1024)); } while (0)
#define PG8_F8(x) __builtin_shufflevector(__builtin_bit_cast(v4i32_t, x[0]), __builtin_bit_cast(v4i32_t, x[1]), 0, 1, 2, 3, 4, 5, 6, 7)
#define PG8_MFMA8(ACC, A8, B8) asm volatile("v_mfma_f32_16x16x128_f8f6f4 %0, %1, %2, %0" : "+v"(ACC) : "v"(A8), "v"(B8))
#define PG8_MMA(ai, bj, At, Bt) do { __builtin_amdgcn_s_setprio(1); if constexpr (FP8) { _Pragma("unroll") for (int n = 0; n < 2; ++n) { const v8i32_t b8 = PG8_F8(Bt[n]); _Pragma("unroll") for (int m = 0; m < 4; ++m) { const v8i32_t a8 = PG8_F8(At[m]); PG8_MFMA8(acc[ai][bj][m][n], b8, a8); } } } else { \
        _Pragma("unroll") for (int m = 0; m < 4; ++m) _Pragma("unroll") for (int n = 0; n < 2; ++n) _Pragma("unroll") for (int k = 0; k < 2; ++k) \
        acc[ai][bj][m][n] = __builtin_amdgcn_mfma_f32_16x16x32_bf16(Bt[n][k], At[m][k], acc[ai][bj][m][n], 0, 0, 0); } __builtin_amdgcn_s_setprio(0); } while (0)
#define PG8_MFMA8Z(ACC, A8, B8) asm volatile("v_mfma_f32_16x16x128_f8f6f4 %0, %1, %2, 0" : "=&v"(ACC) : "v"(A8), "v"(B8))
#define PG8_MMA0(ai, bj, At, Bt) do { __builtin_amdgcn_s_setprio(1); if constexpr (FP8) { _Pragma("unroll") for (int n = 0; n < 2; ++n) { const v8i32_t b8 = PG8_F8(Bt[n]); _Pragma("unroll") for (int m = 0; m < 4; ++m) { const v8i32_t a8 = PG8_F8(At[m]); PG8_MFMA8Z(acc[ai][bj][m][n], b8, a8); } } } else { \
        _Pragma("unroll") for (int m = 0; m < 4; ++m) _Pragma("unroll") for (int n = 0; n < 2; ++n) { \
        acc[ai][bj][m][n] = __builtin_amdgcn_mfma_f32_16x16x32_bf16(Bt[n][0], At[m][0], (f32x4){0.f, 0.f, 0.f, 0.f}, 0, 0, 0); acc[ai][bj][m][n] = __builtin_amdgcn_mfma_f32_16x16x32_bf16(Bt[n][1], At[m][1], acc[ai][bj][m][n], 0, 0, 0); } } __builtin_amdgcn_s_setprio(0); } while (0)
#define PG8_MFMA_DRAIN do { if constexpr (FP8) { asm volatile("s_nop 15\n\ts_nop 15" ::: "memory"); __builtin_amdgcn_sched_barrier(0); } } while (0)
#define PG8_WAIT_V(n) asm volatile("s_waitcnt vmcnt(" #n ")" ::: "memory")
#define PG8_WAIT_L(n) asm volatile("s_waitcnt lgkmcnt(" #n ")" ::: "memory")
#define PG8_BAR __builtin_amdgcn_s_barrier()
#define PG8_SCHED __builtin_amdgcn_sched_barrier(0)
    Unit cur, nxt; int ui = 0;
    if (!S.next(0, cur)) return;
    f32x4 acc[2][2][4][2];
#pragma unroll
    for (int a = 0; a < 2; ++a)
#pragma unroll
        for (int b = 0; b < 2; ++b)
#pragma unroll
            for (int m = 0; m < 4; ++m)
#pragma unroll
                for (int n = 0; n < 2; ++n) acc[a][b][m][n] = (f32x4){0.f, 0.f, 0.f, 0.f};
    bf16x8 At[4][2], B0[2][2], B1[2][2];
    int sc127 = 0x7F7F7F7F; asm volatile("" : "+v"(sc127));
    unsigned vA[2][2], vN[2][2];
    S.a_voff(cur, 0, Rs, Cs, vA);
    const char* cA = S.a_base(cur); const char* cB = S.b_base(cur);
    typename Epi::Pre pre; E.prefetch(cur, wr, fr, pre);
    S.a_ready(cur);
    PG8_STAGE(PG8_SB(0, 0), cB, voffB); PG8_STAGE(PG8_SB(0, 1), cB + hstep, voffB); PG8_STAGE(PG8_SA(0, 0), cA, vA[0]); PG8_STAGE(PG8_SA(0, 1), cA, vA[1]);
    if (wr == 1) PG8_BAR;
    PG8_WAIT_V(2); PG8_BAR;
    PG8_STAGE(PG8_SB(1, 0), cB + kstep, voffB); PG8_STAGE(PG8_SA(1, 0), cA + kstep, vA[0]); PG8_STAGE(PG8_SB(1, 1), cB + hstep + kstep, voffB); PG8_STAGE(PG8_SA(1, 1), cA + kstep, vA[1]);
    PG8_WAIT_V(8); PG8_BAR;
    for (;;) {
        const bool has_next = S.next(ui + 1, nxt);
        const char* nA = cA; const char* nB = cB;
#pragma unroll
        for (int h = 0; h < 2; ++h)
#pragma unroll
            for (int i = 0; i < 2; ++i) vN[h][i] = vA[h][i];
        if (has_next) { nA = S.a_base(nxt); nB = S.b_base(nxt); S.a_voff(nxt, ui + 1, Rs, Cs, vN); }
        PRB_T0(3);
#pragma unroll 1
        for (int t = 0; t < nt; t += 2) {
            const bool last = (t == nt - 2);
            const int rl = (NSTMAX > 0 && t == 0) ? pnst : 0;
#define PG8_WAIT_R(B) do { if (NSTMAX >= 16 && rl == 16) wait_vm<(B) + 16>(); else if (NSTMAX >= 8 && rl >= 8) wait_vm<(B) + 8>(); else PG8_WAIT_V(8); } while (0)
            const char* a1 = cA + (size_t)(t + 1) * kstep;
            const char* a2 = last ? nA : cA + (size_t)(t + 2) * kstep; const char* b2 = last ? nB : cB + (size_t)(t + 2) * kstep;
            const char* a3 = a2 + kstep; const char* b3 = b2 + kstep;
            unsigned v2[2][2];
#pragma unroll
            for (int h = 0; h < 2; ++h)
#pragma unroll
                for (int i = 0; i < 2; ++i) v2[h][i] = last ? vN[h][i] : vA[h][i];
            if (last && has_next) S.a_ready(nxt);
            PG8_LDB(B0, 0, 0); PG8_LDB(B1, 0, 1); PG8_SCHED; PG8_LDA(At, 0, 0); if (t > 0) { PG8_STAGE(PG8_SA(1, 1), a1, vA[1]); }
            PRB_T0(2); PG8_WAIT_R(10); PG8_WAIT_L(0); PG8_BAR; if (t == 0) PRB_T1(2); if (t == 0) { PG8_MMA0(0, 0, At, B0); PG8_MMA0(0, 1, At, B1); } else { PG8_MMA(0, 0, At, B0); PG8_MMA(0, 1, At, B1); } PG8_BAR; PG8_SCHED;
            PG8_LDA(At, 0, 1); PG8_STAGE(PG8_SB(0, 0), b2, voffB); PG8_STAGE(PG8_SB(0, 1), b2 + hstep, voffB); PG8_STAGE(PG8_SA(0, 0), a2, v2[0]);
            PG8_WAIT_R(14); PG8_WAIT_L(0); PG8_BAR; if (t == 0) { PG8_MMA0(1, 0, At, B0); PG8_MMA0(1, 1, At, B1); } else { PG8_MMA(1, 0, At, B0); PG8_MMA(1, 1, At, B1); } PG8_BAR; PG8_SCHED;
            PG8_LDB(B0, 1, 0); PG8_LDB(B1, 1, 1); PG8_SCHED; PG8_LDA(At, 1, 0); PG8_STAGE(PG8_SA(0, 1), a2, v2[1]);
            PG8_WAIT_R(10); PG8_WAIT_L(0); PG8_BAR; PG8_MMA(0, 0, At, B0); PG8_MMA(0, 1, At, B1); PG8_BAR; PG8_SCHED;
            PG8_LDA(At, 1, 1); PG8_STAGE(PG8_SB(1, 0), b3, voffB); PG8_STAGE(PG8_SB(1, 1), b3 + hstep, voffB); PG8_STAGE(PG8_SA(1, 0), a3, v2[0]);
            PG8_WAIT_R(14); PG8_WAIT_L(0); PG8_BAR; PG8_MMA(1, 0, At, B0); PG8_MMA(1, 1, At, B1); PG8_BAR; PG8_SCHED;
        }
        PG8_STAGE(PG8_SA(1, 1), nA + kstep, vN[1]);
        PRB_T1(3); PRB_T0(1);
        if constexpr (ALIGN_EPI) { if (wr == 0) PG8_BAR; }
        PG8_MFMA_DRAIN; E(acc, cur, wr, wc, fr, fq, pre); S.done(cur); pnst = epi_nst<Epi>::get(E, cur);
        if (!has_next) break;
        cur = nxt; cA = nA; cB = nB; ++ui; E.prefetch(cur, wr, fr, pre);
#pragma unroll
        for (int h = 0; h < 2; ++h)
#pragma unroll
            for (int i = 0; i < 2; ++i) vA[h][i] = vN[h][i];
        if constexpr (ALIGN_EPI) { if (wr == 1) PG8_BAR; }
        PRB_T1(1);
    }
    PG8_WAIT_V(0);
    if constexpr (!ALIGN_EPI) { if (wr == 0) PG8_BAR; }
    PG8_BAR;
#undef PG8_SA
#undef PG8_SB
#undef PG8_STAGE
#undef PG8_LDA
#undef PG8_LDB
#undef PG8_MMA
#undef PG8_F8
#undef PG8_MFMA8
#undef PG8_MFMA8Z
#undef PG8_MMA0
#undef PG8_MFMA_DRAIN
#undef PG8_WAIT_V
#undef PG8_WAIT_R
#undef PG8_WAIT_L
#undef PG8_BAR
#undef PG8_SCHED
}
}
namespace epi {
using pg8::f32x4; using pg8::f32x2; using pg8::u32x4; using pg8::Unit; using pg8::bf16_t; using pg8::cvt_pk_bf16; using pg8::sigmoidf_fast;
constexpr int HALF = 128;
__device__ __forceinline__ float gelu_tanh(float x) { const float z = 1.5957691216057308f * (x + 0.044715f * x * x * x); return x * sigmoidf_fast(z); }
__device__ __forceinline__ float clampf8(float v) { return __builtin_amdgcn_fmed3f(v, -448.0f, 448.0f); }
__device__ __forceinline__ unsigned pk4f8(const f32x4 a) { unsigned w = 0u; w = __builtin_amdgcn_cvt_pk_fp8_f32(clampf8(a[0]), clampf8(a[1]), w, false); w = __builtin_amdgcn_cvt_pk_fp8_f32(clampf8(a[2]), clampf8(a[3]), w, true); return w; }
__device__ __forceinline__ u32x4 pack8(const f32x4 a, const f32x4 b) { u32x4 w; w.x = cvt_pk_bf16(a[0], a[1]); w.y = cvt_pk_bf16(a[2], a[3]); w.z = cvt_pk_bf16(b[0], b[1]); w.w = cvt_pk_bf16(b[2], b[3]); return w; }

struct EpiInProj {
    static constexpr bool PERM = true;
    static constexpr int NSTMAX = 16; __device__ __forceinline__ int nst(const Unit& u) const { return (u.pn >= 4 && u.pn < 12) ? 8 : 16; }
    struct Pre {}; __device__ __forceinline__ void prefetch(const Unit&, int, int, Pre&) const {}
    bf16_t *XR, *GAR, *Q, *Kb, *V, *GB; const float* qg; const float* kg; const float* cstab; float c2; float inv;
    __device__ __forceinline__ void operator()(const f32x4 (&acc)[2][2][4][2], const Unit& u, int wr, int wc, int fr, int fq, const Pre& pre) const {
        const int pn = u.pn; const int rowb = u.pm * 256 + wr * 64 + fr;
        if (pn < 4 || (pn >= 20 && pn < 24) || pn >= 24) {
            bf16_t* base; int colt; const bool sig = false;
            if (pn < 4) { base = XR; colt = pn * 256; } else if (pn < 24) { base = V; colt = (pn - 20) * 256; } else { base = GB; colt = (pn - 24) * 256; }
            const int col0 = colt + wc * 32 + 8 * fq;
#pragma unroll
            for (int ai = 0; ai < 2; ++ai)
#pragma unroll
                for (int m = 0; m < 4; ++m) { bf16_t* rowp = base + (size_t)(rowb + ai * HALF + m * 16) * 1024 + col0;
#pragma unroll
                    for (int bj = 0; bj < 2; ++bj) { f32x4 v0 = acc[ai][bj][m][0] * inv, v1 = acc[ai][bj][m][1] * inv;
                        if (sig) {
#pragma unroll
                            for (int i = 0; i < 4; ++i) { v0[i] = sigmoidf_fast(v0[i]); v1[i] = sigmoidf_fast(v1[i]); } }
                        *(u32x4*)(rowp + bj * HALF) = pack8(v0, v1); } }
        } else if (pn < 12) {
            const int col0 = (pn - 4) * 128 + wc * 32 + 8 * fq;
#pragma unroll
            for (int ai = 0; ai < 2; ++ai)
#pragma unroll
                for (int m = 0; m < 4; ++m) { f32x4 o[2];
#pragma unroll
                    for (int n = 0; n < 2; ++n)
#pragma unroll
                        for (int i = 0; i < 4; ++i) { const float x = acc[ai][0][m][n][i] * inv, y = acc[ai][1][m][n][i] * inv, z = 1.5957691216057308f * (x + 0.044715f * x * x * x);
                            o[n][i] = x * __builtin_amdgcn_rcpf((1.0f + __builtin_amdgcn_exp2f(-1.4426950408889634f * z)) * (1.0f + __builtin_amdgcn_exp2f(-1.4426950408889634f * y))); }
                    *(u32x4*)(GAR + (size_t)(rowb + ai * HALF + m * 16) * 1024 + col0) = pack8(o[0], o[1]); }
        } else {
            const bool isq = pn < 16; const int j = isq ? pn - 12 : pn - 16; bf16_t* base = isq ? Q : Kb; const float* gg = isq ? qg : kg; const float sc = isq ? c2 : 1.0f;
            f32x4 gv[2][2];
#pragma unroll
            for (int bj = 0; bj < 2; ++bj)
#pragma unroll
                for (int n = 0; n < 2; ++n) gv[bj][n] = *(const f32x4*)(gg + 32 * bj + 8 * fq + 4 * n);
#pragma unroll
            for (int ai = 0; ai < 2; ++ai)
#pragma unroll
                for (int m = 0; m < 4; ++m) { const int row = rowb + ai * HALF + m * 16;
                    float ss = 0.f;
#pragma unroll
                    for (int bj = 0; bj < 2; ++bj)
#pragma unroll
                        for (int n = 0; n < 2; ++n) { const f32x4 x = acc[ai][bj][m][n]; ss += (x[0] * x[0] + x[1] * x[1]) + (x[2] * x[2] + x[3] * x[3]); }
                    ss += __shfl_xor(ss, 16); ss += __shfl_xor(ss, 32);
                    const float rstd = inv * __builtin_amdgcn_rsqf(ss * (inv * inv * (1.0f / 64.0f)) + 1e-6f);
                    f32x4 y[2][2];
#pragma unroll
                    for (int bj = 0; bj < 2; ++bj)
#pragma unroll
                        for (int n = 0; n < 2; ++n) y[bj][n] = acc[ai][bj][m][n] * rstd * gv[bj][n];
                    const f32x4 c0 = *(const f32x4*)(cstab + (size_t)row * 16), c1 = *(const f32x4*)(cstab + (size_t)row * 16 + 4);
                    const f32x4 s0 = *(const f32x4*)(cstab + (size_t)row * 16 + 8), s1 = *(const f32x4*)(cstab + (size_t)row * 16 + 12);
                    f32x4 p0, p1;
#pragma unroll
                    for (int i = 0; i < 4; ++i) { p0[i] = __shfl_xor(y[0][0][i], 16); p1[i] = __shfl_xor(y[0][1][i], 16); }
                    { const float sgn = fq == 0 ? -1.0f : 1.0f; const f32x4 r0 = y[0][0] * c0 + (p0 * s0) * sgn, r1 = y[0][1] * c1 + (p1 * s1) * sgn;
#pragma unroll
                      for (int i = 0; i < 4; ++i) { y[0][0][i] = fq < 2 ? r0[i] : y[0][0][i]; y[0][1][i] = fq < 2 ? r1[i] : y[0][1][i]; } }
                    bf16_t* rowp = base + (size_t)row * 1024 + j * 256 + wc * 64 + 8 * fq;
#pragma unroll
                    for (int bj = 0; bj < 2; ++bj) *(u32x4*)(rowp + 32 * bj) = pack8(y[bj][0] * sc, y[bj][1] * sc); }
        }
    }
};

struct EpiWo {
    static constexpr bool PERM = false;
    struct Pre {}; __device__ __forceinline__ void prefetch(const Unit&, int, int, Pre&) const {}
    const float* x; float* out; const float* gate;
    __device__ __forceinline__ void operator()(const f32x4 (&acc)[2][2][4][2], const Unit& u, int wr, int wc, int fr, int fq, const Pre& pre) const {
        const int rowb = u.pm * 256 + wr * 64 + fr; const int col0 = u.pn * 256 + wc * 32 + 4 * fq; const float* gp = gate + (size_t)(u.pm >> 4) * 6144;
        f32x4 gv[2][2];
#pragma unroll
        for (int bj = 0; bj < 2; ++bj)
#pragma unroll
            for (int n = 0; n < 2; ++n) gv[bj][n] = *(const f32x4*)(gp + col0 + bj * HALF + n * 16);
#pragma unroll
        for (int ai = 0; ai < 2; ++ai)
#pragma unroll
            for (int m = 0; m < 4; ++m) { const size_t off = (size_t)(rowb + ai * HALF + m * 16) * 1024 + col0;
#pragma unroll
                for (int bj = 0; bj < 2; ++bj)
#pragma unroll
                    for (int n = 0; n < 2; ++n) { const f32x4 xv = *(const f32x4*)(x + off + bj * HALF + n * 16); *(f32x4*)(out + off + bj * HALF + n * 16) = xv + gv[bj][n] * acc[ai][bj][m][n]; }
                if (m & 1) asm volatile("" ::: "memory"); }
    }
};
struct EpiF32 {
    static constexpr bool PERM = false;
    struct Pre {}; __device__ __forceinline__ void prefetch(const Unit&, int, int, Pre&) const {}
    float* out;
    __device__ __forceinline__ void operator()(const f32x4 (&acc)[2][2][4][2], const Unit& u, int wr, int wc, int fr, int fq, const Pre& pre) const {
        const int rowb = u.pm * 256 + wr * 64 + fr; const int col0 = wc * 32 + 4 * fq;
#pragma unroll
        for (int ai = 0; ai < 2; ++ai)
#pragma unroll
            for (int m = 0; m < 4; ++m) { float* rowp = out + (size_t)(rowb + ai * HALF + m * 16) * 256 + col0;
#pragma unroll
                for (int bj = 0; bj < 2; ++bj)
#pragma unroll
                    for (int n = 0; n < 2; ++n) *(f32x4*)(rowp + bj * HALF + n * 16) = acc[ai][bj][m][n]; }
    }
};
struct EpiGateUp {
    static constexpr bool PERM = true;
    struct Pre {}; __device__ __forceinline__ void prefetch(const Unit&, int, int, Pre&) const {}
    unsigned char* act; unsigned char* dump; float inv; float osc;
    __device__ __forceinline__ void operator()(const f32x4 (&acc)[2][2][4][2], const Unit& u, int wr, int wc, int fr, int fq, const Pre& pre) const {
        const int col0 = u.pn * 128 + wc * 32 + 8 * fq; int tdx = threadIdx.x; asm volatile("" : "+v"(tdx)); unsigned char* dmp = dump + ((size_t)(blockIdx.x * 512 + tdx) << 4);
#pragma unroll
        for (int ai = 0; ai < 2; ++ai)
#pragma unroll
            for (int m = 0; m < 4; ++m) { const int rt = ai * HALF + wr * 64 + m * 16 + fr; f32x4 o[2];
#pragma unroll
                for (int n = 0; n < 2; ++n)
#pragma unroll
                    for (int i = 0; i < 4; ++i) { const float g = acc[ai][0][m][n][i] * inv; o[n][i] = g * sigmoidf_fast(g) * (acc[ai][1][m][n][i] * (inv * osc)); }
                { typedef unsigned u32x2e __attribute__((ext_vector_type(2))); u32x2e w; w.x = pk4f8(o[0]); w.y = pk4f8(o[1]); *(u32x2e*)(rt < u.nrows ? act + (size_t)(u.row0 + rt) * 256 + col0 : dmp) = w; } }
    }
};
struct EpiDown {
    static constexpr int PERM = 2;
    static constexpr int NSTMAX = 8; __device__ __forceinline__ int nst(const Unit&) const { return 8; }
    struct Pre {}; __device__ __forceinline__ void prefetch(const Unit&, int, int, Pre&) const {}
    unsigned char* ys; const PG8_LAS unsigned short* gtab; unsigned char* dump; float sc;
    __device__ __forceinline__ void operator()(const f32x4 (&acc)[2][2][4][2], const Unit& u, int wr, int wc, int fr, int fq, const Pre& pre) const {
        int rt0 = wr * 64 + fr, tdx = threadIdx.x; asm volatile("" : "+v"(rt0), "+v"(tdx));
        unsigned char* base = ys + (size_t)u.row0 * 1024 + u.pn * 256 + wc * 64 + 16 * fq + (size_t)rt0 * 1024;
        unsigned char* dmp = dump + ((size_t)(blockIdx.x * 512 + tdx) << 4);
        const PG8_LAS unsigned short* gp = gtab + u.pm * 256 + rt0;
#pragma unroll
        for (int ai = 0; ai < 2; ++ai) {
#pragma unroll
            for (int m = 0; m < 4; ++m) { const int rt = ai * HALF + m * 16 + rt0; const float gt = (float)__builtin_bit_cast(_Float16, gp[ai * HALF + m * 16]) * sc;
                u32x4 w; w.x = pk4f8(acc[ai][0][m][0] * gt); w.y = pk4f8(acc[ai][0][m][1] * gt); w.z = pk4f8(acc[ai][1][m][0] * gt); w.w = pk4f8(acc[ai][1][m][1] * gt);
                unsigned char* dst = rt < u.nrows ? base + (ai * HALF + m * 16) * 1024 : dmp;
                *(u32x4*)dst = w; }
        }
    }
};
}
namespace attn_body {
using bf16=__hip_bfloat16;
using bf16x8=__attribute__((ext_vector_type(8)))short;
using s16x4=__attribute__((ext_vector_type(4)))short;
using f32x16=__attribute__((ext_vector_type(16)))float;
using u32x4=__attribute__((ext_vector_type(4)))unsigned;
constexpr int BATCH=8,NHEAD=16,SEQ=4096,D=64,DM=NHEAD*D;
constexpr int NW=8,QBLK=32,QB=QBLK*NW,KVBLK=64,NQB=SEQ/QB;
constexpr int ATTN_PITCH=DM, ATTN_UNIT_ROWS=QB;
__device__ __forceinline__ int crow(int r,int hi){return (r&3)+8*(r>>2)+4*hi;}
#define SBAR() __builtin_amdgcn_sched_barrier(0)
__device__ __forceinline__ void cmask(f32x16&p0,f32x16&p1,int jb,int qrel,int hi){
  const float NEG=-INFINITY; int kb=64*jb+4*hi;
  #pragma unroll
  for(int r=0;r<16;++r){int kv=kb+(r&3)+8*(r>>2); if(kv>qrel)p0[r]=NEG; if(kv+32>qrel)p1[r]=NEG;}
}

constexpr int NSLOT=3, SLOTB=8192, VSLOTB=2*SLOTB;
constexpr int LDS_K=0, LDS_V=NSLOT*SLOTB, LDS_WS=LDS_V+NSLOT*VSLOTB, LDS_OST=LDS_WS+NW*64*4, LDS_BYTES=LDS_OST+NW*4096;
constexpr int XARGS_OFF=131072+320+64;
constexpr float C2=0.125f*1.4426950408889634f;
__device__ __forceinline__ void glds16(const void*gsrc,unsigned lds_dst){unsigned keep;
  asm volatile("s_mov_b32 %0, m0\n\ts_mov_b32 m0, %2\n\ts_nop 0\n\tglobal_load_lds_dwordx4 %1, off\n\ts_mov_b32 m0, %0":"=&s"(keep):"v"(gsrc),"s"(lds_dst):"memory");}
__device__ __forceinline__ float max3f(float a,float b,float c){float r;asm("v_max3_f32 %0, %1, %2, %3":"=v"(r):"v"(a),"v"(b),"v"(c));return r;}
__device__ __forceinline__ float max2f(float a,float b){float r;asm("v_max_f32_e32 %0, %1, %2":"=v"(r):"v"(a),"v"(b));return r;}
__device__ __forceinline__ float fadd_s(float a,float b){float r;asm("v_add_f32_e32 %0, %1, %2":"=v"(r):"v"(a),"v"(b));return r;}
__device__ __forceinline__ float fsub_s(float a,float b){float r;asm("v_sub_f32_e32 %0, %1, %2":"=v"(r):"v"(a),"v"(b));return r;}
typedef float f32x2_t __attribute__((ext_vector_type(2))); typedef __bf16 bf16x2_t __attribute__((ext_vector_type(2)));
__device__ __forceinline__ unsigned cvtpk_s(float lo,float hi){f32x2_t v={lo,hi};bf16x2_t b=__builtin_convertvector(v,bf16x2_t);return __builtin_bit_cast(unsigned,b);}
#define WAIT_BAR(N) asm volatile("s_waitcnt vmcnt(" #N ") lgkmcnt(0)\n\ts_barrier":::"memory")

__device__ __forceinline__ void qkt(f32x16&p0,f32x16&p1,const char*Kslot,const bf16x8*qr,int r32,int hi){ const f32x16 negm=f32x16{};
  const char*kb=Kslot+hi*1024+r32*16;
  #pragma unroll
  for(int d0=0;d0<4;++d0){
    const bf16x8 b0=*reinterpret_cast<const bf16x8*>(kb+d0*2048);
    const bf16x8 b1=*reinterpret_cast<const bf16x8*>(kb+d0*2048+512);
    if(d0==0){p0=__builtin_amdgcn_mfma_f32_32x32x16_bf16(b0,qr[0],negm,0,0,0);p1=__builtin_amdgcn_mfma_f32_32x32x16_bf16(b1,qr[0],negm,0,0,0);}
    else{p0=__builtin_amdgcn_mfma_f32_32x32x16_bf16(b0,qr[d0],p0,0,0,0);p1=__builtin_amdgcn_mfma_f32_32x32x16_bf16(b1,qr[d0],p1,0,0,0);}}
}
typedef __attribute__((address_space(3))) const char* lds_cptr;
typedef short v4i16_t __attribute__((ext_vector_type(4)));
__device__ __forceinline__ void kload8(bf16x8*kf,lds_cptr kp){
  kf[0]=*(const __attribute__((address_space(3))) bf16x8*)(kp);      kf[1]=*(const __attribute__((address_space(3))) bf16x8*)(kp+512);
  kf[2]=*(const __attribute__((address_space(3))) bf16x8*)(kp+2048); kf[3]=*(const __attribute__((address_space(3))) bf16x8*)(kp+2560);
  kf[4]=*(const __attribute__((address_space(3))) bf16x8*)(kp+4096); kf[5]=*(const __attribute__((address_space(3))) bf16x8*)(kp+4608);
  kf[6]=*(const __attribute__((address_space(3))) bf16x8*)(kp+6144); kf[7]=*(const __attribute__((address_space(3))) bf16x8*)(kp+6656);
}
__device__ __forceinline__ void kload2(bf16x8*kf,lds_cptr kp,int j){ kf[2*j]=*(const __attribute__((address_space(3))) bf16x8*)(kp+j*2048); kf[2*j+1]=*(const __attribute__((address_space(3))) bf16x8*)(kp+j*2048+512); }
__device__ __forceinline__ s16x4 vtr(lds_cptr p){ return __builtin_bit_cast(s16x4,__builtin_amdgcn_ds_read_tr16_b64_v4i16((__attribute__((address_space(3))) v4i16_t*)p)); }
__device__ __forceinline__ float rowmax(const f32x16&p0,const f32x16&p1){
  float a=max3f(p0[0],p0[1],p1[0]),b=max3f(p0[2],p0[3],p1[1]);a=max3f(a,p1[2],p1[3]);
  #pragma unroll
  for(int r=4;r<16;r+=4){a=max3f(a,p0[r],p0[r+1]);b=max3f(b,p0[r+2],p0[r+3]);a=max3f(a,p1[r],p1[r+1]);b=max3f(b,p1[r+2],p1[r+3]);}
  const float m=max2f(a,b);
  auto rr=__builtin_amdgcn_permlane32_swap(__float_as_uint(m),__float_as_uint(m),false,false);
  return max2f(__uint_as_float(rr[0]),__uint_as_float(rr[1]));
}
__device__ __forceinline__ void pv(f32x16*o,int vb,bf16x8 pa0,bf16x8 pa1,bf16x8 pa2,bf16x8 pa3){
  #pragma unroll
  for(int d0=0;d0<4;++d0){s16x4 lo[4],hi[4];
    #pragma unroll
    for(int ks=0;ks<4;++ks){
      asm volatile("ds_read_b64_tr_b16 %0,%1 offset:%c2":"=&v"(lo[ks]):"v"(vb),"i"(d0*4096+ks*1024):"memory");
      asm volatile("ds_read_b64_tr_b16 %0,%1 offset:%c2":"=&v"(hi[ks]):"v"(vb),"i"(d0*4096+ks*1024+512):"memory");}
    asm volatile("s_waitcnt lgkmcnt(0)":::"memory");SBAR();
    #define PK(k) (bf16x8){lo[k][0],lo[k][1],lo[k][2],lo[k][3],hi[k][0],hi[k][1],hi[k][2],hi[k][3]}
    o[d0]=__builtin_amdgcn_mfma_f32_32x32x16_bf16(pa0,PK(0),o[d0],0,0,0);
    o[d0]=__builtin_amdgcn_mfma_f32_32x32x16_bf16(pa1,PK(1),o[d0],0,0,0);
    o[d0]=__builtin_amdgcn_mfma_f32_32x32x16_bf16(pa2,PK(2),o[d0],0,0,0);
    o[d0]=__builtin_amdgcn_mfma_f32_32x32x16_bf16(pa3,PK(3),o[d0],0,0,0);
    #undef PK
  }
}

#ifndef ATTN_STORE16
#define ATTN_STORE16(p,v) (*(u32x4*)(p)=(v))
#endif
template<int THRL> __device__ __forceinline__ void attn_unit(int b,int hq,int vcol,int qb,const bf16*Q,const bf16*K,const bf16*V,bf16*O,char*shm){
  int tid=threadIdx.x; asm volatile("":"+v"(tid));
  const int lane=tid&63,r32=lane&31,hi=lane>>5; const int wid=__builtin_amdgcn_readfirstlane(tid>>6);
  const long rowbase=(long)b*SEQ; const int q0=qb*QB;
  const bf16*Qw=Q+(rowbase+q0+wid*QBLK)*DM+hq*D;
  const bf16*Kh=K+rowbase*DM+hq*D,*Vh=V+rowbase*DM+vcol;
  const unsigned lds0=(unsigned)(uintptr_t)shm;
  float*wsf=(float*)(shm+LDS_WS)+wid*64;
  const bf16*ksrc=Kh+(long)lane*DM+wid*8;
  const bf16*vsrc=Vh+(long)(16*(wid&3)+(lane>>2))*DM+(wid>>2)*32+(lane&3)*8;
  const unsigned kdst=lds0+LDS_K+wid*1024, vdst=lds0+LDS_V+wid*1024;
  #define DMA_K(t,slot) glds16(ksrc+(long)(t)*KVBLK*DM,(unsigned)__builtin_amdgcn_readfirstlane(kdst+(slot)))
  #define DMA_V(t,slot) do{ glds16(vsrc+(long)(t)*KVBLK*DM,(unsigned)__builtin_amdgcn_readfirstlane(vdst+2*(slot))); glds16(vsrc+64+(long)(t)*KVBLK*DM,(unsigned)__builtin_amdgcn_readfirstlane(vdst+8192+2*(slot))); }while(0)
  const int vb0=(int)(lds0+LDS_V)+((lane>>4)&1)*32+(lane&3)*8+(4*hi+((lane&15)>>2))*64;
  const char*Kbase=shm+LDS_K; bf16x8 kf[8];
  const lds_cptr shm3=(lds_cptr)shm; const lds_cptr kp0=shm3+LDS_K+hi*1024+r32*16; const lds_cptr vp0=shm3+LDS_V+((lane>>4)&1)*32+(lane&3)*8+(4*hi+((lane&15)>>2))*64;
  const int NT=(q0+QB)/KVBLK;
  DMA_K(0,0);DMA_V(0,0);DMA_K(1,SLOTB);
  bf16x8 qr[4];
  #pragma unroll
  for(int d0=0;d0<4;++d0)qr[d0]=*reinterpret_cast<const bf16x8*>(&Qw[(long)r32*DM+d0*16+hi*8]);
  float l_reg=0.f;f32x16 o[4];o[0]=f32x16{};o[1]=f32x16{};o[2]=f32x16{};o[3]=f32x16{};
  const int qrel=wid*QBLK+r32;
  #define CMASK(P0,P1,t) do{int jb_=(t)-(NT-4); if(jb_>=0)cmask(P0,P1,jb_,qrel,hi);}while(0)
  #define START(P0,P1) do{ _Pragma("unroll") for(int r=0;r<16;++r){P0[r]=__builtin_amdgcn_exp2f(P0[r]);P1[r]=__builtin_amdgcn_exp2f(P1[r]);} }while(0)
  #define RESC() do{}while(0)
  f32x16 pA0,pA1,pB0,pB1;
  int sl_prev=0,sl_cur=0,sl_next=SLOTB;
  #define ROT() do{sl_prev=sl_cur;sl_cur=sl_next;sl_next=(sl_next==(NSLOT-1)*SLOTB)?0:sl_next+SLOTB;}while(0)
  DMA_K(2,2*SLOTB);
  WAIT_BAR(4);
  qkt(pA0,pA1,Kbase,qr,r32,hi);asm volatile("s_nop 15\n\ts_nop 7":"+v"(pA0),"+v"(pA1));CMASK(pA0,pA1,0);
  START(pA0,pA1);
  WAIT_BAR(0);
  DMA_K(3,0);DMA_V(1,SLOTB);
  ROT();
  kload8(kf,kp0+sl_cur);
  WAIT_BAR(3);
  s16x4 vlo[4],vhi[4]; u32x4 pw0,pw1,pw2,pw3;
  #define PKW(P,B) cvtpk_s(P[B],P[B+1])
  #define PAF(k) __builtin_bit_cast(bf16x8,pw##k)
  #define VFR(i) (bf16x8){vlo[i][0],vlo[i][1],vlo[i][2],vlo[i][3],vhi[i][0],vhi[i][1],vhi[i][2],vhi[i][3]}
  #define PIN(x) asm volatile("":"+v"(x))
  #define MX3(a,b,c) __builtin_fmaxf(__builtin_fmaxf((a),(b)),(c))
  #define GAPA(MF,A0,A1,A2,A3,W0,W1,PW) do{ MF; sacc+=A0; sacc+=A1; sacc+=A2; sacc+=A3; PIN(sacc); W0; W1; PIN(PW); SBAR(); }while(0)
  #define EXS(v) __builtin_amdgcn_exp2f(v)
  #define VOFF(n) ((2*((n)>>3)+((n)&1))*4096+(((n)&7)>>1)*1024)
  #define VRDN(n) do{ vlo[(n)&3]=vtr(vp_+VOFF(n)); vhi[(n)&3]=vtr(vp_+VOFF(n)+512); }while(0)
  #define GAPB(n,PA,OD,X,B) do{ o[OD]=__builtin_amdgcn_mfma_f32_32x32x16_bf16(PA,VFR((n)&3),o[OD],0,0,0); X[B]=EXS(X[B]); X[(B)+1]=EXS(X[(B)+1]); PIN(X); SBAR(); if((n)+4<16){ VRDN((n)+4); SBAR(); } }while(0)
  #define KRD(G,j) do{ if(G){ kload2(kf,kp0+sl_next,j); SBAR(); } }while(0)
  #define STEP(C0,C1,P0,P1,t,GK,GV,GL) do{ SBAR(); \
    const lds_cptr vp_=vp0+2*sl_prev; const f32x16 zc_=f32x16{}; \
    float sacc=(P0[0]+P0[1]); \
    GAPA(C0=__builtin_amdgcn_mfma_f32_32x32x16_bf16(kf[0],qr[0],zc_,0,0,0), P0[2],P0[3],P0[4],P0[5],     pw0[0]=PKW(P0,0), pw0[1]=PKW(P0,2), pw0); \
    GAPA(C1=__builtin_amdgcn_mfma_f32_32x32x16_bf16(kf[1],qr[0],zc_,0,0,0), P0[6],P0[7],P0[8],P0[9],     pw0[2]=PKW(P0,4), pw0[3]=PKW(P0,6), pw0); \
    GAPA(C0=__builtin_amdgcn_mfma_f32_32x32x16_bf16(kf[2],qr[1],C0,0,0,0),   P0[10],P0[11],P0[12],P0[13], pw1[0]=PKW(P0,8), pw1[1]=PKW(P0,10), pw1); \
    GAPA(C1=__builtin_amdgcn_mfma_f32_32x32x16_bf16(kf[3],qr[1],C1,0,0,0),   P0[14],P0[15],P1[0],P1[1],   pw1[2]=PKW(P0,12),pw1[3]=PKW(P0,14), pw1); \
    VRDN(0); SBAR(); GAPA(C0=__builtin_amdgcn_mfma_f32_32x32x16_bf16(kf[4],qr[2],C0,0,0,0),   P1[2],P1[3],P1[4],P1[5],     pw2[0]=PKW(P1,0), pw2[1]=PKW(P1,2), pw2); \
    VRDN(1); SBAR(); GAPA(C1=__builtin_amdgcn_mfma_f32_32x32x16_bf16(kf[5],qr[2],C1,0,0,0),   P1[6],P1[7],P1[8],P1[9],     pw2[2]=PKW(P1,4), pw2[3]=PKW(P1,6), pw2); \
    VRDN(2); SBAR(); GAPA(C0=__builtin_amdgcn_mfma_f32_32x32x16_bf16(kf[6],qr[3],C0,0,0,0),   P1[10],P1[11],P1[12],P1[13], pw3[0]=PKW(P1,8), pw3[1]=PKW(P1,10), pw3); \
    VRDN(3); SBAR(); GAPA(C1=__builtin_amdgcn_mfma_f32_32x32x16_bf16(kf[7],qr[3],C1,0,0,0),   P1[14],P1[15],0.f,0.f,       pw3[2]=PKW(P1,12),pw3[3]=PKW(P1,14), pw3); \
    l_reg+=sacc; \
    if(GK){DMA_K((t)+3,sl_cur);} if(GV){DMA_V((t)+1,sl_next);} \
    CMASK(C0,C1,t); \
    SBAR(); \
    GAPB(0,PAF(0),0,C0,0);  GAPB(1,PAF(0),1,C0,2);  GAPB(2,PAF(1),0,C0,4);  GAPB(3,PAF(1),1,C0,6); \
    GAPB(4,PAF(2),0,C0,8);  GAPB(5,PAF(2),1,C0,10); GAPB(6,PAF(3),0,C0,12); GAPB(7,PAF(3),1,C0,14); \
    GAPB(8,PAF(0),2,C1,0);  GAPB(9,PAF(0),3,C1,2); \
    KRD(GL,0); GAPB(10,PAF(1),2,C1,4); KRD(GL,1); GAPB(11,PAF(1),3,C1,6); \
    KRD(GL,2); GAPB(12,PAF(2),2,C1,8); KRD(GL,3); GAPB(13,PAF(2),3,C1,10); \
    GAPB(14,PAF(3),2,C1,12); GAPB(15,PAF(3),3,C1,14); \
    }while(0)
  int t=1;
  #undef CMASK
  #define CMASK(P0,P1,t) do{}while(0)
  for(;t+5<NT;t+=2){
    STEP(pB0,pB1,pA0,pA1,t,true,true,true);     WAIT_BAR(3); RESC(); ROT();
    STEP(pA0,pA1,pB0,pB1,t+1,true,true,true);   WAIT_BAR(3); RESC(); ROT();
  }
  #undef CMASK
  #define CMASK(P0,P1,t) do{int jb_=(t)-(NT-4); if(jb_>=0)cmask(P0,P1,jb_,qrel,hi);}while(0)
  #define ENDW(tt) do{ if((tt)+3<NT){WAIT_BAR(3);} else if((tt)+2<NT){WAIT_BAR(2);} else {WAIT_BAR(0);} }while(0)
  for(;t+1<NT;t+=2){
    STEP(pB0,pB1,pA0,pA1,t,(t+3<NT),(t+1<NT),(t+1<NT));       ENDW(t);   RESC(); ROT();
    STEP(pA0,pA1,pB0,pB1,t+1,(t+4<NT),(t+2<NT),(t+2<NT));     ENDW(t+1); RESC(); ROT();
  }
  STEP(pB0,pB1,pA0,pA1,NT-1,false,false,false); RESC();
  { float sacc=pB0[0]+pB0[1]; _Pragma("unroll") for(int r=2;r<16;++r)sacc+=pB0[r]; _Pragma("unroll") for(int r=0;r<16;++r)sacc+=pB1[r]; l_reg+=sacc;
    pw0=(u32x4){PKW(pB0,0),PKW(pB0,2),PKW(pB0,4),PKW(pB0,6)};pw1=(u32x4){PKW(pB0,8),PKW(pB0,10),PKW(pB0,12),PKW(pB0,14)};pw2=(u32x4){PKW(pB1,0),PKW(pB1,2),PKW(pB1,4),PKW(pB1,6)};pw3=(u32x4){PKW(pB1,8),PKW(pB1,10),PKW(pB1,12),PKW(pB1,14)};
    SBAR(); pv(o,vb0+2*sl_cur,PAF(0),PAF(1),PAF(2),PAF(3)); }
  #undef PKW
  #undef PAF
  #undef VFR
  #undef PIN
  #undef MX3
  #undef GAPA
  #undef GAPB
  #undef EXS
  #undef VOFF
  #undef VRDN
  #undef KRD
  #undef STEP
  #undef ENDW
  {auto rr=__builtin_amdgcn_permlane32_swap(__float_as_uint(l_reg),__float_as_uint(l_reg),false,false);l_reg=__uint_as_float(rr[0])+__uint_as_float(rr[1]);}
  if(hi==0)wsf[32+r32]=l_reg;asm volatile("s_waitcnt lgkmcnt(0)":::"memory");
  float rli[16];
  #pragma unroll
  for(int r=0;r<16;++r)rli[r]=__builtin_amdgcn_rcpf(wsf[32+crow(r,hi)]);
  bf16*Ow=O+(rowbase+q0+wid*QBLK)*DM+vcol;
  if((hq&1)==0){ bf16*stg=(bf16*)(shm+LDS_OST)+wid*2048; int lane_f=lane; asm volatile("":"+v"(lane_f));
    #pragma unroll
    for(int hh=0;hh<2;++hh){
      #pragma unroll
      for(int r=0;r<16;++r){const int orow=crow(r,hi);
        #pragma unroll
        for(int d0=0;d0<2;++d0)stg[orow*64+d0*32+r32]=__float2bfloat16(o[2*hh+d0][r]*rli[r]);}
      asm volatile("s_waitcnt lgkmcnt(0)":::"memory");
      #pragma unroll
      for(int i=0;i<4;++i){const int row=i*8+(lane_f>>3),ch=lane_f&7; const u32x4 v=*(const u32x4*)(stg+row*64+ch*8); ATTN_STORE16(Ow+(long)row*DM+hh*64+ch*8,v);}
      asm volatile("s_waitcnt lgkmcnt(0)":::"memory"); } }
  else { bf16*stg=(bf16*)(shm+LDS_OST)+wid*2048;
    const volatile __attribute__((address_space(3))) unsigned* xa=(const volatile __attribute__((address_space(3))) unsigned*)((lds_cptr)shm+XARGS_OFF);
    bf16*YB=(bf16*)(__attribute__((address_space(1))) void*)(((unsigned long long)(unsigned)__builtin_amdgcn_readfirstlane(xa[1])<<32)|(unsigned)__builtin_amdgcn_readfirstlane(xa[0]));
    const bf16*GB=(const bf16*)(__attribute__((address_space(1))) void*)(((unsigned long long)(unsigned)__builtin_amdgcn_readfirstlane(xa[3])<<32)|(unsigned)__builtin_amdgcn_readfirstlane(xa[2]));
    const float*sg=(const float*)(__attribute__((address_space(1))) void*)(((unsigned long long)(unsigned)__builtin_amdgcn_readfirstlane(xa[5])<<32)|(unsigned)__builtin_amdgcn_readfirstlane(xa[4]));
    const float lam=__uint_as_float((unsigned)__builtin_amdgcn_readfirstlane(xa[6]));
    int lane_e=lane; asm volatile("":"+v"(lane_e));
    const int rl=lane_e>>3,ch=lane_e&7; const long goff=(rowbase+q0+wid*QBLK)*DM+vcol;
    float x[2][4][8]; float ss[4]={0.f,0.f,0.f,0.f};
    #define BLO(w) __uint_as_float((w)<<16)
    #define BHI(w) __uint_as_float((w)&0xffff0000u)
    #pragma unroll
    for(int hh=0;hh<2;++hh){
      #pragma unroll
      for(int r=0;r<16;++r){const int orow=crow(r,hi);
        #pragma unroll
        for(int d0=0;d0<2;++d0)stg[orow*64+d0*32+r32]=__float2bfloat16(o[2*hh+d0][r]*rli[r]);}
      asm volatile("s_waitcnt lgkmcnt(0)":::"memory");
      #pragma unroll
      for(int i=0;i<4;++i){const int row=i*8+rl; const u32x4 v1=*(const u32x4*)(stg+row*64+ch*8); const u32x4 v0=*(const u32x4*)(O+goff+(long)row*DM+hh*64+ch*8);
        #pragma unroll
        for(int k=0;k<4;++k){const float lo=BLO(v0[k])-lam*BLO(v1[k]),hv=BHI(v0[k])-lam*BHI(v1[k]); x[hh][i][2*k]=lo; x[hh][i][2*k+1]=hv; ss[i]+=lo*lo+hv*hv;}}
      asm volatile("s_waitcnt lgkmcnt(0)":::"memory"); }
    #pragma unroll
    for(int i=0;i<4;++i){ss[i]+=__shfl_xor(ss[i],1);ss[i]+=__shfl_xor(ss[i],2);ss[i]+=__shfl_xor(ss[i],4);ss[i]=__builtin_amdgcn_rsqf(ss[i]*(1.0f/128.0f)+1e-6f);}
    #pragma unroll
    for(int hh=0;hh<2;++hh){ float sgv[8];
      #pragma unroll
      for(int j=0;j<8;++j)sgv[j]=sg[hh*64+ch*8+j]*0.8f;
      #pragma unroll
      for(int i=0;i<4;++i){const int row=i*8+rl; const u32x4 gb=*(const u32x4*)(GB+goff+(long)row*DM+hh*64+ch*8); u32x4 w;
        #pragma unroll
        for(int k=0;k<4;++k){const float g0=__builtin_amdgcn_rcpf(1.0f+__builtin_amdgcn_exp2f(-1.4426950408889634f*BLO(gb[k]))),g1=__builtin_amdgcn_rcpf(1.0f+__builtin_amdgcn_exp2f(-1.4426950408889634f*BHI(gb[k])));
          w[k]=cvtpk_s(g0*(x[hh][i][2*k]*ss[i]*sgv[2*k]),g1*(x[hh][i][2*k+1]*ss[i]*sgv[2*k+1]));}
        ATTN_STORE16(YB+goff+(long)row*DM+hh*64+ch*8,w);}}
    #undef BLO
    #undef BHI
  }
  asm volatile("s_waitcnt lgkmcnt(0)\n\ts_barrier":::"memory");
  #undef DMA_K
  #undef DMA_V
  #undef CMASK
  #undef START
  #undef RESC
  #undef ROT
}
constexpr int ATTN_LDS_BYTES=LDS_BYTES;
struct AttnTensors { const bf16* Q; const bf16* K; const bf16* V; bf16* O0; bf16* YB; const bf16* GB; const float* sg; float lam; };
struct AttnUnit { int b, h, qb; };
struct PairOrder {
  int vcu, G;
  __device__ __forceinline__ PairOrder(int grid,int vcu_):vcu(vcu_),G(grid){}
  __device__ __forceinline__ bool next(int i,AttnUnit&u)const{ const int ug=i*G+vcu; if(ug>=1024)return false; const int w=ug&31, rnd=ug>>8, bh=((ug&255)>>5)*8+2*rnd+(w>>4);
    u.b=bh>>3; u.h=bh&7; u.qb=(rnd&1)?15-(w&15):(w&15); return true; }
  __device__ __forceinline__ void a_ready(const AttnUnit&)const{}
  __device__ __forceinline__ void done(const AttnUnit&)const{}
};
template<class Sched,class Hook,int THRL=8> __device__ __forceinline__ void attn_phase(char*lds,const AttnTensors&T,const Sched&S,const Hook&H,int reps){
  AttnUnit u;
  if(threadIdx.x==0){ volatile __attribute__((address_space(3))) unsigned* xa=(volatile __attribute__((address_space(3))) unsigned*)((lds_cptr)lds+XARGS_OFF);
    const unsigned long long p0=(unsigned long long)T.YB,p1=(unsigned long long)T.GB,p2=(unsigned long long)T.sg;
    xa[0]=(unsigned)p0;xa[1]=(unsigned)(p0>>32);xa[2]=(unsigned)p1;xa[3]=(unsigned)(p1>>32);xa[4]=(unsigned)p2;xa[5]=(unsigned)(p2>>32);xa[6]=__float_as_uint(T.lam); }
  __syncthreads();
  int hs=0;
  for(int rep=0;rep<reps;++rep)
  for(int i=0;S.next(i>>1,u);++i){ S.a_ready(u);
    attn_unit<THRL>(u.b,2*u.h+(i&1),128*u.h,u.qb,T.Q,T.K,T.V,T.O0,lds);
    S.done(u);
    if(hs<Hook::NSLICE){ H(hs); ++hs; } }
  for(;hs<Hook::NSLICE;++hs)H(hs);
}
#undef SBAR
#undef WAIT_BAR
}
#define GAS __attribute__((address_space(1)))
#define LAS __attribute__((address_space(3)))
typedef unsigned short bf16;
typedef unsigned v4u __attribute__((ext_vector_type(4)));
typedef float f32x4 __attribute__((ext_vector_type(4)));
typedef short bf16x8 __attribute__((ext_vector_type(8)));
typedef GAS unsigned gu32;
typedef GAS unsigned long long gu64;
#define RLX_AGENT __ATOMIC_RELAXED, __HIP_MEMORY_SCOPE_AGENT
#define LDS_WAIT() asm volatile("s_waitcnt lgkmcnt(0)" ::: "memory")
#define VM_WAIT() asm volatile("s_waitcnt vmcnt(0)" ::: "memory")
__device__ __forceinline__ unsigned long long rt() { return __builtin_amdgcn_s_memrealtime(); }
typedef float f32x2_cv __attribute__((ext_vector_type(2))); typedef __bf16 bf16x2_cv __attribute__((ext_vector_type(2)));
__device__ __forceinline__ unsigned pk2(float lo, float hi) { const f32x2_cv v = {lo, hi}; return __builtin_bit_cast(unsigned, __builtin_convertvector(v, bf16x2_cv)); }
__device__ __forceinline__ unsigned f2bf(float f) { return pk2(f, f) & 0xffffu; }

#define XB_TMO      128
#define XB_XCNT(j)  (256  + 64 * (j))
#define XB_XSUB(j)  (1280 + 64 * (j))
#define XB_XGEN(j)  (2304 + 64 * (j))
#define XB_TOP      3328
#define XB_TOPGEN   3392
#define XCD_BAR_WORDS 3456
#define XB_SPIN_CAP (1u << 18)

__device__ __forceinline__ unsigned xb_ld(unsigned* p)              { return __hip_atomic_load(p, __ATOMIC_RELAXED, __HIP_MEMORY_SCOPE_AGENT); }
__device__ __forceinline__ unsigned xb_add(unsigned* p, unsigned v) { return __hip_atomic_fetch_add(p, v, __ATOMIC_RELAXED, __HIP_MEMORY_SCOPE_AGENT); }
__device__ __forceinline__ unsigned xb_xcc_id() { return (unsigned)__builtin_amdgcn_s_getreg((3 << 11) | 20) & 0xFu; }
#define XB_SPIN(cond, bar) do { unsigned _sp = 0; while (cond) { __builtin_amdgcn_s_sleep(1); \
    if ((++_sp & 255u) == 0u) { if (xb_ld(&(bar)[XB_TMO])) break; if (_sp > XB_SPIN_CAP) { atomicAdd(&(bar)[XB_TMO], 1u); break; } } } } while (0)

struct XcdBarrier {
    unsigned* bar; unsigned x;
    volatile LAS unsigned* st;
};

__device__ __forceinline__ XcdBarrier xcd_barrier_post(unsigned* bar, volatile LAS unsigned* st) {
    XcdBarrier b; b.bar = bar; b.x = xb_xcc_id(); b.st = st;
    if (threadIdx.x == 0) (void)xb_add(&bar[XB_XCNT(b.x)], 1u);
    return b;
}
__device__ __forceinline__ void xcd_barrier_complete(unsigned* bar, unsigned x, unsigned& nloc, unsigned& nx) {
    const unsigned G = gridDim.x * gridDim.y * gridDim.z;
    unsigned sum, cnt, mine, sp = 0u;
    for (;;) {
        sum = 0u; cnt = 0u; mine = 0u;
#pragma unroll
        for (unsigned j = 0; j < 16; ++j) { const unsigned c = xb_ld(&bar[XB_XCNT(j)]); sum += c; cnt += (c > 0u) ? 1u : 0u; mine = (j == x) ? c : mine; }
        if (sum == G) break;
        __builtin_amdgcn_s_sleep(1);
        if ((++sp & 255u) == 0u) { if (xb_ld(&bar[XB_TMO])) break; if (sp > XB_SPIN_CAP) { atomicAdd(&bar[XB_TMO], 1u); break; } }
    }
    nloc = mine > 0u ? mine : 1u; nx = cnt > 0u ? cnt : 1u;
}

__device__ __forceinline__ void xcd_barrier(const XcdBarrier& b) {
    asm volatile("s_waitcnt vmcnt(0)" ::: "memory");
    __syncthreads();
    if (threadIdx.x == 0) {
        unsigned* bar = b.bar;
        __builtin_amdgcn_s_waitcnt(0);
        unsigned nloc = b.st[0], nx = b.st[1];
        if (nloc == 0u) { xcd_barrier_complete(bar, b.x, nloc, nx); b.st[0] = nloc; b.st[1] = nx; }
        const unsigned old = xb_add(&bar[XB_XSUB(b.x)], 1u);
        const unsigned gen = old / nloc;
        if (old + 1u == (gen + 1u) * nloc) {
            __builtin_amdgcn_fence(__ATOMIC_RELEASE, "agent");
            asm volatile("s_waitcnt vmcnt(0)" ::: "memory");
            const unsigned og = xb_add(&bar[XB_TOP], 1u);
            const unsigned tg = og / nx;
            if (og + 1u == (tg + 1u) * nx) xb_add(&bar[XB_TOPGEN], 1u);
            else XB_SPIN(xb_ld(&bar[XB_TOPGEN]) == tg, bar);
            __builtin_amdgcn_fence(__ATOMIC_ACQUIRE, "agent");
            xb_add(&bar[XB_XGEN(b.x)], 1u);
            asm volatile("s_waitcnt vmcnt(0)" ::: "memory");
        } else {
            XB_SPIN(xb_ld(&bar[XB_XGEN(b.x)]) == gen, bar);
            __builtin_amdgcn_fence(__ATOMIC_ACQUIRE, "agent");
            asm volatile("s_waitcnt vmcnt(0)" ::: "memory");
        }
    }
    __syncthreads();
}
constexpr int NWAVES = 8;
constexpr int BATCH = 8, SEQ = 4096, T = BATCH * SEQ, D = 1024, NEXP = 256, TOPK = 8, DEXP = 256, NSLOT = TOPK + 1  ;
constexpr int INW = 7168;
constexpr int NPOS = T * NSLOT;
constexpr int MAXTILES = 1408;
constexpr float EPS = 1e-6f;

constexpr size_t MiB = 1u << 20;
constexpr size_t WS_CTL = 0, CTL_ZERO_BYTES = 1 * MiB;
constexpr size_t WS_MOD = 1 * MiB;
constexpr size_t WS_C8SP = 1 * MiB + 256 * 1024;
constexpr size_t WS_CST = 1 * MiB + 512 * 1024;
constexpr size_t WS_WIN = 4 * MiB, WS_WO = 18 * MiB, WS_WR = 20 * MiB, WS_WLRU = 20 * MiB + 512 * 1024;
constexpr size_t WS_TOPE = 21 * MiB, WS_TOPG = 22 * MiB, WS_POSE = 23 * MiB;
constexpr size_t WS_REC = 546 * MiB;
constexpr int REC_CAP = T;
constexpr size_t WS_POSM = 12 * MiB;
constexpr size_t WS_DUMP = 13 * MiB;
constexpr size_t WS_H28 = 482 * MiB;
constexpr float SC_H = 4.0f, SC_W = 64.0f, SC_A = 8.0f, SC_Y = 16.0f;
constexpr size_t WS_WED = 32 * MiB;
constexpr size_t WS_WEGU = 161 * MiB;
constexpr size_t WS_XR = 418 * MiB, WS_GAR = 482 * MiB, WS_Q = 546 * MiB, WS_K = 610 * MiB, WS_V = 674 * MiB, WS_GB = 738 * MiB, WS_MIX = 802 * MiB;
constexpr size_t WS_LOGIT = 738 * MiB;
constexpr size_t WS_H2 = 418 * MiB;
constexpr size_t WS_ACT = 802 * MiB;
constexpr size_t WS_YS = 161 * MiB;
constexpr size_t WS_END = 948 * MiB;
static_assert(WS_YS + (size_t)NPOS * 2048 <= WS_LOGIT && WS_ACT + (size_t)(NPOS + 256) * 512 <= WS_END && WS_WED + (size_t)257 * 1024 * 256 * 2 <= WS_WEGU && WS_WEGU + (size_t)257 * 512 * 1024 * 2 <= WS_XR, "d_ws map");
constexpr int CW_TMO = 0, CW_CODE = 1, CW_NTILES = 64, CW_CONV = 128, CW_CNT = 1024, CW_BAR = 4096;

constexpr int RING_OFF = 0, RING_BYTES = 131072;
constexpr int LDSCTL_OFF = RING_BYTES, MISC_OFF = LDSCTL_OFF + 320;
constexpr int UT_OFF = LDSCTL_OFF + 512;
constexpr int TOK_OFF = LDSCTL_OFF + 2048;
constexpr int PFX_OFF = LDSCTL_OFF + 16384;
constexpr int LDS_BYTES = 147456 + 4096;
constexpr int MAXU_TOK = 14, MAXU = 64, MAXU_GT = 28;
struct Frame {
    LAS unsigned char* lds;
    volatile LAS unsigned* MISC;
    gu32* ctl;
    int tid, lane, wave;
    int vcu, G;
};
#define LBAR() asm volatile("s_waitcnt lgkmcnt(0)\n\ts_barrier" ::: "memory")
__device__ __forceinline__ float wave_sum(float v) {
#pragma unroll
    for (int o = 1; o < 64; o <<= 1) v += __shfl_xor(v, o);
    return v;
}
__device__ __forceinline__ float bf2f(unsigned short h) { return __builtin_bit_cast(float, (unsigned)h << 16); }
__device__ __forceinline__ float bflo(unsigned w) { return __builtin_bit_cast(float, w << 16); }
__device__ __forceinline__ float bfhi(unsigned w) { return __builtin_bit_cast(float, w & 0xffff0000u); }
__device__ __forceinline__ float clamp_f8(float v) { return __builtin_amdgcn_fmed3f(v, -448.0f, 448.0f); }
__device__ __forceinline__ unsigned pk4_fp8(float a, float b, float c, float d) { unsigned w = 0u; a = clamp_f8(a); b = clamp_f8(b); c = clamp_f8(c); d = clamp_f8(d); w = __builtin_amdgcn_cvt_pk_fp8_f32(a, b, w, false); w = __builtin_amdgcn_cvt_pk_fp8_f32(c, d, w, true); return w; }
__device__ __forceinline__ float sigm(float v) { return __builtin_amdgcn_rcpf(1.0f + __builtin_amdgcn_exp2f(-1.4426950408889634f * v)); }

__device__ __forceinline__ void transpose_item(const float* W, int ldn, bf16* WT, int ldk, int k0, int n0, int drow0, LAS float* scr, int lane) {
    float v[32];
#pragma unroll
    for (int i = 0; i < 32; ++i) { const int kk = 2 * i + (lane >> 5); v[i] = __builtin_nontemporal_load(W + (size_t)(k0 + kk) * ldn + n0 + (lane & 31)); }
#pragma unroll
    for (int i = 0; i < 32; ++i) { const int kk = 2 * i + (lane >> 5); scr[kk * 33 + (lane & 31)] = v[i]; }
    LDS_WAIT(); asm volatile("" ::: "memory");
    const int c = lane & 7;
#pragma unroll
    for (int j = 0; j < 4; ++j) { const int n = (lane >> 3) + 8 * j; const LAS float* s = scr + (8 * c) * 33 + n;
        v4u o; o.x = pk2(s[0 * 33], s[1 * 33]); o.y = pk2(s[2 * 33], s[3 * 33]); o.z = pk2(s[4 * 33], s[5 * 33]); o.w = pk2(s[6 * 33], s[7 * 33]);
        *(GAS v4u*)(WT + (size_t)(drow0 + n) * ldk + k0 + 8 * c) = o; }
    LDS_WAIT(); asm volatile("" ::: "memory");
}
__device__ __forceinline__ void transpose_item8(const float* W, int ldn, unsigned char* WT, int ldk, int k0, int n0, int drow0, float scale, LAS float* scr, int lane) {
    float v[32];
#pragma unroll
    for (int i = 0; i < 32; ++i) { const int kk = 2 * i + (lane >> 5); v[i] = __builtin_nontemporal_load(W + (size_t)(k0 + kk) * ldn + n0 + (lane & 31)); }
#pragma unroll
    for (int i = 0; i < 32; ++i) { const int kk = 2 * i + (lane >> 5); scr[kk * 33 + (lane & 31)] = v[i] * scale; }
    LDS_WAIT(); asm volatile("" ::: "memory");
    const int c = lane & 3;
#pragma unroll
    for (int j = 0; j < 2; ++j) { const int n = (lane >> 2) + 16 * j; const LAS float* s = scr + (16 * c) * 33 + n;
        v4u o; o.x = pk4_fp8(s[0 * 33], s[1 * 33], s[2 * 33], s[3 * 33]); o.y = pk4_fp8(s[4 * 33], s[5 * 33], s[6 * 33], s[7 * 33]);
        o.z = pk4_fp8(s[8 * 33], s[9 * 33], s[10 * 33], s[11 * 33]); o.w = pk4_fp8(s[12 * 33], s[13 * 33], s[14 * 33], s[15 * 33]);
        *(GAS v4u*)(WT + (size_t)(drow0 + n) * ldk + k0 + 16 * c) = o; }
    LDS_WAIT(); asm volatile("" ::: "memory");
}
__device__ __forceinline__ int rowmap_in(int n0) {
    const int seg = n0 >> 10, o = n0 & 1023;
    if (seg == 0) return o;
    if (seg == 1) return 1024 + 256 * (o >> 7) + (o & 127);
    if (seg == 2 || seg == 3) { const int j = o >> 8, r = o & 255; return (seg == 2 ? 3072 : 4096) + 256 * j + 128 * ((r >> 5) & 1) + 32 * (r >> 6) + (r & 31); }
    if (seg == 4) return 5120 + o;
    if (seg == 5) return 1024 + 256 * (o >> 7) + 128 + (o & 127);
    return 6144 + o;
}
struct P0Args { const float *c, *w_ada, *b_ada, *w_in, *w_o, *w_router, *we_gate, *we_up, *we_down, *ws_gate, *ws_up, *ws_down, *lru_wa, *lru_wx, *lru_lambda; const int* positions; };
__device__ __forceinline__ void p0_prologue(Frame& F, const P0Args& a, unsigned char* ws, int part) {
    float* mod = (float*)(ws + WS_MOD);
    __syncthreads();
    if (part == 0)
    for (int u = F.vcu; u < 192; u += F.G) {
        LAS float* sc = (LAS float*)F.lds; LAS float* red = (LAS float*)(F.lds + 32768);
        for (int i = F.tid; i < 8192; i += 512) { const float v = a.c[i]; sc[i] = v * sigm(v); }
        __syncthreads();
        const int cl = F.tid & 31, ks = F.tid >> 5, col = u * 32 + cl;
        float acc[8];
#pragma unroll
        for (int b = 0; b < 8; ++b) acc[b] = 0.f;
#pragma unroll 16
        for (int k = ks * 64; k < ks * 64 + 64; ++k) { const float w = a.w_ada[(size_t)k * 6144 + col];
#pragma unroll
            for (int b = 0; b < 8; ++b) acc[b] += sc[b * 1024 + k] * w; }
#pragma unroll
        for (int b = 0; b < 8; ++b) red[(ks * 8 + b) * 32 + cl] = acc[b];
        __syncthreads();
        if (F.tid < 256) { const int b = F.tid >> 5; float s = a.b_ada[col];
#pragma unroll
          for (int k2 = 0; k2 < 16; ++k2) s += red[(k2 * 8 + b) * 32 + cl];
          mod[b * 6144 + col] = s; }
        __syncthreads();
    }
    if (part == 0) return;
    const int gt = F.vcu * 512 + F.tid, NT_ = F.G * 512;
    if (gt < 1024) { const double z = -(double)a.lru_lambda[gt]; const double sp = (z > 0.0 ? z : 0.0) + log1p(exp(-(z > 0.0 ? z : -z))); ((float*)(ws + WS_C8SP))[gt] = (float)(8.0 * sp); }
    for (int idx = gt; idx < T * 8; idx += NT_) { const int tok = idx >> 3, i = idx & 7;
        const float inv = exp2f(-(float)i * 0.125f * 18.931568569324174f);
        const float ang = (float)a.positions[tok] * inv;
        double rev = (double)ang * 0.15915494309189535; rev -= floor(rev); const float fr = (float)rev;
        float* cs = (float*)(ws + WS_CST) + (size_t)tok * 16;
        cs[i] = __builtin_amdgcn_cosf(fr); cs[8 + i] = __builtin_amdgcn_sinf(fr); }
    LAS float* scr = (LAS float*)(F.lds + RING_OFF + F.wave * 16384);
    const int gw = F.vcu * NWAVES + F.wave, NGW = F.G * NWAVES;
    bf16* Wo_t = (bf16*)(ws + WS_WO); bf16* Wr_t = (bf16*)(ws + WS_WR); bf16* Wlru = (bf16*)(ws + WS_WLRU);
    constexpr int I_IN = 16 * 224, I_O = 16 * 32, I_R = 16 * 8, I_E = 384 * 257, I_L = 64;
    constexpr int NITEMS = I_E + I_IN + I_O + I_R + I_L;
    for (int it = gw + I_E; it < NITEMS; it += NGW) {
        int r = it;
        if (r < I_E) { const int e = r / 384, q = r % 384, which = q >> 7, ii = q & 127;
            if (which < 2) { const float* src = (e < 256) ? ((which ? a.we_up : a.we_gate) + (size_t)e * 262144) : (which ? a.ws_up : a.ws_gate);
                const int kb = ii >> 3, nb = ii & 7, n0 = nb * 32;
                transpose_item8(src, 256, ws + WS_WEGU + (size_t)e * 524288, 1024, kb * 64, n0, 256 * (n0 >> 7) + (which ? 128 : 0) + (n0 & 127), SC_W, scr, F.lane);
            } else { const float* src = (e < 256) ? (a.we_down + (size_t)e * 262144) : a.ws_down;
                const int kb = ii >> 5, nb = ii & 31;
                transpose_item8(src, 1024, ws + WS_WED + (size_t)e * 262144, 256, kb * 64, nb * 32, nb * 32, SC_W, scr, F.lane); }
            continue; }
        r -= I_E;
        if (r < I_IN) { const int kb = r / 224, nb = r % 224; transpose_item8(a.w_in, INW, ws + WS_WIN, 1024, kb * 64, nb * 32, rowmap_in(nb * 32), SC_W, scr, F.lane); continue; }
        r -= I_IN;
        if (r < I_O) { const int kb = r >> 5, nb = r & 31; transpose_item(a.w_o, 1024, Wo_t, 1024, kb * 64, nb * 32, nb * 32, scr, F.lane); continue; }
        r -= I_O;
        if (r < I_R) { const int kb = r >> 3, nb = r & 7; transpose_item(a.w_router, 256, Wr_t, 1024, kb * 64, nb * 32, nb * 32, scr, F.lane); continue; }
        r -= I_R;
        { const int g = r >> 2, wx = (r >> 1) & 1, hf = r & 1;
          transpose_item((wx ? a.lru_wx : a.lru_wa) + (size_t)g * 4096, 64, Wlru, 64, 0, hf * 32, (g * 2 + hf) * 64 + (wx ? 32 : 0), scr, F.lane); }
    }
}

struct ExpertConvHook {
    static constexpr int NSLICE = 8;
    LAS unsigned char* lds;
    __device__ __forceinline__ void operator()(int s) const {
        const int G = (int)gridDim.x, bx = (int)blockIdx.x, vcu = (G % 8 == 0) ? (bx % 8) * (G / 8) + bx / 8 : bx;
        int tdx = (int)threadIdx.x; asm volatile("" : "+v"(tdx));
        const int wave = __builtin_amdgcn_readfirstlane(tdx >> 6), lane = tdx & 63;
        LAS float* scr = (LAS float*)(lds + RING_OFF + wave * 16384);
        const volatile LAS unsigned* pt = (const volatile LAS unsigned*)(lds + LDSCTL_OFF + 1536);
#define ECH_PTR(i) ((GAS unsigned char*)(((unsigned long long)(unsigned)__builtin_amdgcn_readfirstlane(pt[2 * (i) + 1]) << 32) | (unsigned)__builtin_amdgcn_readfirstlane(pt[2 * (i)])))
        unsigned char* ws = (unsigned char*)ECH_PTR(32);
        constexpr int I_E = 384 * 257;
        const int gw = vcu * NWAVES + wave, NGW = G * NWAVES, KIT = (I_E + NGW - 1) / NGW;
#define ECH_DEC(r_, S, LDN, Dp, LDK) do { const int e_ = (r_) / 384, q_ = (r_) % 384, wh_ = q_ >> 7, ii_ = q_ & 127; \
            if (wh_ < 2) { const int kb_ = ii_ >> 3, n0_ = (ii_ & 7) * 32; S = ((e_ < 256) ? ((const float*)ECH_PTR(wh_ ? 26 : 25) + (size_t)e_ * 262144) : (const float*)ECH_PTR(wh_ ? 29 : 28)) + (size_t)(kb_ * 64) * 256 + n0_; LDN = 256; \
                Dp = ws + WS_WEGU + (size_t)e_ * 524288 + (size_t)(256 * (n0_ >> 7) + (wh_ ? 128 : 0) + (n0_ & 127)) * 1024 + kb_ * 64; LDK = 1024; } \
            else { const int kb_ = ii_ >> 5, nb_ = ii_ & 31; S = ((e_ < 256) ? ((const float*)ECH_PTR(27) + (size_t)e_ * 262144) : (const float*)ECH_PTR(30)) + (size_t)(kb_ * 64) * 1024 + nb_ * 32; LDN = 1024; \
                Dp = ws + WS_WED + (size_t)e_ * 262144 + (size_t)(nb_ * 32) * 256 + kb_ * 64; LDK = 256; } } while (0)
#define ECH_LOAD(v, S, LDN) do { const unsigned lo_ = (unsigned)((lane >> 5) * LDN + (lane & 31));        \
            _Pragma("unroll") for (int i = 0; i < 32; ++i) v[i] = __builtin_nontemporal_load((const GAS float*)S + (size_t)(2 * i) * (unsigned)LDN + lo_); } while (0)
#define ECH_STORE(v, Dp, LDK) do { _Pragma("unroll") for (int i = 0; i < 32; ++i) { const int kk = 2 * i + (lane >> 5); scr[kk * 33 + (lane & 31)] = v[i] * SC_W; } \
            LDS_WAIT(); asm volatile("" ::: "memory"); \
            { const int c = lane & 3; _Pragma("unroll") for (int j = 0; j < 2; ++j) { const int n = (lane >> 2) + 16 * j; const LAS float* s_ = scr + (16 * c) * 33 + n; v4u o; \
                o.x = pk4_fp8(s_[0 * 33], s_[1 * 33], s_[2 * 33], s_[3 * 33]); o.y = pk4_fp8(s_[4 * 33], s_[5 * 33], s_[6 * 33], s_[7 * 33]); \
                o.z = pk4_fp8(s_[8 * 33], s_[9 * 33], s_[10 * 33], s_[11 * 33]); o.w = pk4_fp8(s_[12 * 33], s_[13 * 33], s_[14 * 33], s_[15 * 33]); \
                *(GAS v4u*)(Dp + (size_t)n * LDK + 16 * c) = o; } } \
            LDS_WAIT(); asm volatile("" ::: "memory"); } while (0)
        int k = KIT * s / NSLICE; const int k1 = KIT * (s + 1) / NSLICE; int nk = 0; while (k + nk < k1 && gw + (k + nk) * NGW < I_E) ++nk;
        float vA[32], vB[32]; const float *sA = nullptr, *sB = nullptr; unsigned char *dA = nullptr, *dB = nullptr; int lnA = 0, lnB = 0, lkA = 0, lkB = 0;
        if (nk > 0) { ECH_DEC(gw + k * NGW, sA, lnA, dA, lkA); ECH_LOAD(vA, sA, lnA); }
        for (int j = 0; j < nk; j += 2) {
            if (j + 1 < nk) { ECH_DEC(gw + (k + j + 1) * NGW, sB, lnB, dB, lkB); ECH_LOAD(vB, sB, lnB); }
            ECH_STORE(vA, dA, lkA);
            if (j + 2 < nk) { ECH_DEC(gw + (k + j + 2) * NGW, sA, lnA, dA, lkA); ECH_LOAD(vA, sA, lnA); }
            if (j + 1 < nk) { ECH_STORE(vB, dB, lkB); } }
#undef ECH_DEC
#undef ECH_LOAD
#undef ECH_STORE
#undef ECH_PTR
        __syncthreads();
    }
};

__device__ __forceinline__ void norm_mod_phase(Frame& F, const float* src, const float* gvec, const float* mod, int off_shift, int off_scale, bf16* dst, unsigned char* dst8) {
    const int gw = F.vcu * NWAVES + F.wave, NGW = F.G * NWAVES;
    for (int blk = gw; blk < T / 16; blk += NGW) {
        const int row0 = blk * 16, b = row0 >> 12; const float* mp = mod + (size_t)b * 6144;
        f32x4 g[4], sc[4], sh[4];
#pragma unroll
        for (int j = 0; j < 4; ++j) { const int col = 4 * F.lane + 256 * j; g[j] = *(const GAS f32x4*)(gvec + col); sc[j] = *(const GAS f32x4*)(mp + off_scale + col) + 1.0f; sh[j] = *(const GAS f32x4*)(mp + off_shift + col); }
        for (int r = 0; r < 16; ++r) {
            const GAS f32x4* xr = (const GAS f32x4*)(src + (size_t)(row0 + r) * D) + F.lane;
            f32x4 v[4]; float s = 0.f;
#pragma unroll
            for (int j = 0; j < 4; ++j) { v[j] = xr[64 * j]; s += (v[j].x * v[j].x + v[j].y * v[j].y) + (v[j].z * v[j].z + v[j].w * v[j].w); }
            const float rstd = 1.0f / sqrtf(wave_sum(s) * (1.0f / D) + EPS);
            GAS unsigned long long* o8 = (GAS unsigned long long*)(dst + (size_t)(row0 + r) * D) + F.lane;
#pragma unroll
            for (int j = 0; j < 4; ++j) { const f32x4 y = (v[j] * rstd * g[j]) * sc[j] + sh[j];
                if (dst) o8[64 * j] = (unsigned long long)pk2(y.x, y.y) | ((unsigned long long)pk2(y.z, y.w) << 32);
                if (dst8) *((GAS unsigned*)(dst8 + (size_t)(row0 + r) * D) + F.lane + 64 * j) = pk4_fp8(y.x * SC_H, y.y * SC_H, y.z * SC_H, y.w * SC_H); }
        }
    }
}

struct LruArgs { const bf16* XR; const bf16* GAR; const bf16* YB; bf16* MIX; const bf16* Wlru;
    const float *conv_w, *conv_b, *lru_ba, *lru_bx, *c8sp; };
__device__ __forceinline__ void lru_phase(Frame& F, const LruArgs& a) {
    typedef short bf16x8v __attribute__((ext_vector_type(8)));
    LAS unsigned char* L = F.lds;
    LAS unsigned char* At = L;
    LAS float* AGG = (LAS float*)(L + 36864);
    LAS unsigned char* HT = L + 38912;
    const int tid = F.tid, lane = F.lane, w = F.wave, fr = lane & 15, fq = lane >> 4, cp = tid & 31, sub = tid >> 5;
    for (int u = F.vcu; u < 256; u += F.G) {
        const int b = u >> 5, g = (u >> 1) & 15, hf = u & 1;
        bf16x8v bfr[4][2];
        { const bf16* wl = a.Wlru + (size_t)((g * 2 + hf) * 64) * 64;
#pragma unroll
          for (int nb = 0; nb < 4; ++nb)
#pragma unroll
              for (int kk = 0; kk < 2; ++kk) bfr[nb][kk] = *(const GAS bf16x8v*)(wl + (nb * 16 + fr) * 64 + kk * 32 + fq * 8); }
        const int chc = g * 64 + 2 * cp;
        float cw[4][2], cb[2];
#pragma unroll
        for (int tp = 0; tp < 4; ++tp) { cw[tp][0] = a.conv_w[tp * 1024 + chc]; cw[tp][1] = a.conv_w[tp * 1024 + chc + 1]; }
        cb[0] = a.conv_b[chc]; cb[1] = a.conv_b[chc + 1];
        float ba2[2], bx2[2], c8[2];
#pragma unroll
        for (int nbp = 0; nbp < 2; ++nbp) { const int ch = g * 64 + hf * 32 + 16 * nbp + fr; ba2[nbp] = a.lru_ba[ch]; bx2[nbp] = a.lru_bx[ch]; c8[nbp] = a.c8sp[ch] * 1.4426950408889634f; }
        float carry[2] = {0.f, 0.f};
        const bf16* xr = a.XR + (size_t)b * SEQ * D + chc;
        unsigned xraw[19];
#pragma unroll
        for (int j = 0; j < 19; ++j) { const int t = 16 * sub - 3 + j; xraw[j] = (t >= 0) ? *(const GAS unsigned*)(xr + (size_t)t * D) : 0u; }
        const int part = tid & 3;
        for (int it = 0; it < 16; ++it) {
            const int t0 = it * 256;
            { float x0[19], x1[19];
#pragma unroll
              for (int j = 0; j < 19; ++j) { x0[j] = bflo(xraw[j]); x1[j] = bfhi(xraw[j]); }
#pragma unroll
              for (int j = 0; j < 16; ++j) {
                  const float y0 = cb[0] + cw[0][0] * x0[j] + cw[1][0] * x0[j + 1] + cw[2][0] * x0[j + 2] + cw[3][0] * x0[j + 3];
                  const float y1 = cb[1] + cw[0][1] * x1[j] + cw[1][1] * x1[j + 1] + cw[2][1] * x1[j + 2] + cw[3][1] * x1[j + 3];
                  *(LAS unsigned*)(At + (16 * sub + j) * 144 + 4 * cp) = pk2(y0, y1); } }
            if (it + 1 < 16) {
#pragma unroll
                for (int j = 0; j < 19; ++j) { const int t = t0 + 256 + 16 * sub - 3 + j; xraw[j] = *(const GAS unsigned*)(xr + (size_t)t * D); } }
            v4u garv[2], ybv[2];
#pragma unroll
            for (int j = 0; j < 2; ++j) { const size_t go = (size_t)(b * SEQ + t0 + (tid >> 2) + 128 * j) * D + g * 64 + hf * 32 + part * 8; garv[j] = *(const GAS v4u*)(a.GAR + go); ybv[j] = *(const GAS v4u*)(a.YB + go); }
            LBAR();
            float hl[2][2][4], pl[2][2][4], Pw[2][2], Hw[2][2], Pe[2][2], He[2][2];
#pragma unroll
            for (int sb = 0; sb < 2; ++sb) {
                f32x4 acc[4];
                { const int row = 32 * w + 16 * sb + fr;
                  const bf16x8v a0 = *(const LAS bf16x8v*)(At + row * 144 + fq * 16), a1 = *(const LAS bf16x8v*)(At + row * 144 + 64 + fq * 16);
#pragma unroll
                  for (int nb = 0; nb < 4; ++nb) { acc[nb] = __builtin_amdgcn_mfma_f32_16x16x32_bf16(a0, bfr[nb][0], (f32x4){0.f, 0.f, 0.f, 0.f}, 0, 0, 0);
                      acc[nb] = __builtin_amdgcn_mfma_f32_16x16x32_bf16(a1, bfr[nb][1], acc[nb], 0, 0, 0); } }
#pragma unroll
                for (int nbp = 0; nbp < 2; ++nbp) { float h = 0.f, p = 1.f;
#pragma unroll
                    for (int rg = 0; rg < 4; ++rg) { const int tk = 32 * w + 16 * sb + 4 * fq + rg;
                        const float xcv = bf2f(*(const LAS unsigned short*)(At + tk * 144 + (hf * 32 + 16 * nbp + fr) * 2));
                        const float r = sigm(acc[nbp][rg] + ba2[nbp]), ig = sigm(acc[2 + nbp][rg] + bx2[nbp]);
                        const float av = __builtin_amdgcn_exp2f(-r * c8[nbp]), mu = __builtin_amdgcn_sqrtf(__builtin_fmaf(-av, av, 1.0f)), uu = mu * ig * xcv;
                        h = av * h + uu; p = p * av; hl[sb][nbp][rg] = h; pl[sb][nbp][rg] = p; }
                    float Pp = __shfl(p, lane - 16), Hp = __shfl(h, lane - 16);
                    if (fq >= 1) { h = p * Hp + h; p = p * Pp; }
                    Pp = __shfl(p, lane - 32); Hp = __shfl(h, lane - 32);
                    if (fq >= 2) { h = p * Hp + h; p = p * Pp; }
                    Pw[sb][nbp] = __shfl(p, 48 + fr); Hw[sb][nbp] = __shfl(h, 48 + fr);
                    Pp = __shfl(p, lane - 16); Hp = __shfl(h, lane - 16);
                    Pe[sb][nbp] = fq >= 1 ? Pp : 1.f; He[sb][nbp] = fq >= 1 ? Hp : 0.f; } }
            if (fq == 3) {
#pragma unroll
                for (int nbp = 0; nbp < 2; ++nbp) { AGG[(w * 32 + 16 * nbp + fr) * 2] = Pw[0][nbp] * Pw[1][nbp]; AGG[(w * 32 + 16 * nbp + fr) * 2 + 1] = Pw[1][nbp] * Hw[0][nbp] + Hw[1][nbp]; } }
            LBAR();
#pragma unroll
            for (int nbp = 0; nbp < 2; ++nbp) { float c = carry[nbp], cwv = 0.f;
#pragma unroll
                for (int w2 = 0; w2 < 8; ++w2) { const float Pa = AGG[(w2 * 32 + 16 * nbp + fr) * 2], Ha = AGG[(w2 * 32 + 16 * nbp + fr) * 2 + 1]; if (w2 == w) cwv = c; c = Pa * c + Ha; }
                carry[nbp] = c;
#pragma unroll
                for (int sb = 0; sb < 2; ++sb) { const float cin = sb == 0 ? cwv : Pw[0][nbp] * cwv + Hw[0][nbp]; const float hent = He[sb][nbp] + Pe[sb][nbp] * cin;
#pragma unroll
                    for (int rg = 0; rg < 4; ++rg) { const float hf_ = hl[sb][nbp][rg] + pl[sb][nbp][rg] * hent;
                        *(LAS unsigned short*)(HT + (32 * w + 16 * sb + 4 * fq + rg) * 80 + (16 * nbp + fr) * 2) = (unsigned short)f2bf(hf_); } } }
            LBAR();
#pragma unroll
            for (int j = 0; j < 2; ++j) { const int tk = (tid >> 2) + 128 * j; const v4u hv = *(const LAS v4u*)(HT + tk * 80 + part * 16); const v4u gv = garv[j], yv = ybv[j]; v4u o;
#pragma unroll
              for (int k = 0; k < 4; ++k) o[k] = pk2(bflo(hv[k]) * bflo(gv[k]) + bflo(yv[k]), bfhi(hv[k]) * bfhi(gv[k]) + bfhi(yv[k]));
              *(GAS v4u*)(a.MIX + (size_t)(b * SEQ + t0 + tk) * D + g * 64 + hf * 32 + part * 8) = o; }
        }
        LBAR();
    }
}

struct MixArgs { const bf16 *O0, *O1, *GB; bf16* MIX; const float *lq1, *lk1, *lq2, *lk2, *subln_g; };
__device__ __forceinline__ void mix_phase(Frame& F, const MixArgs& a) {
    const int gw = F.vcu * NWAVES + F.wave, NGW = F.G * NWAVES, lane = F.lane;
    const float lam = __expf(wave_sum(a.lq1[lane] * a.lk1[lane])) - __expf(wave_sum(a.lq2[lane] * a.lk2[lane])) + 0.2f;
    float sg[16];
#pragma unroll
    for (int i = 0; i < 16; ++i) sg[i] = a.subln_g[16 * (lane & 7) + i] * 0.8f;
    for (int blk = gw; blk < T / 16; blk += NGW) {
        for (int r = 0; r < 16; ++r) {
            const size_t off = (size_t)(blk * 16 + r) * D + 16 * lane;
            v4u o0[2], o1[2], gb[2], mx[2];
#pragma unroll
            for (int q = 0; q < 2; ++q) { o0[q] = *(const GAS v4u*)(a.O0 + off + 8 * q); o1[q] = *(const GAS v4u*)(a.O1 + off + 8 * q); gb[q] = *(const GAS v4u*)(a.GB + off + 8 * q); mx[q] = *(const GAS v4u*)(a.MIX + off + 8 * q); }
            float o[16]; float ss = 0.f;
#pragma unroll
            for (int q = 0; q < 2; ++q)
#pragma unroll
                for (int k = 0; k < 4; ++k) { const float lo = bflo(o0[q][k]) - lam * bflo(o1[q][k]), hi = bfhi(o0[q][k]) - lam * bfhi(o1[q][k]); o[8 * q + 2 * k] = lo; o[8 * q + 2 * k + 1] = hi; ss += lo * lo + hi * hi; }
            ss += __shfl_xor(ss, 1); ss += __shfl_xor(ss, 2); ss += __shfl_xor(ss, 4);
            const float rstd = 1.0f / sqrtf(ss * (1.0f / 128.0f) + EPS);
            v4u out[2];
#pragma unroll
            for (int q = 0; q < 2; ++q)
#pragma unroll
                for (int k = 0; k < 4; ++k) { const int i0 = 8 * q + 2 * k;
                    const float lo = bflo(mx[q][k]) + sigm(bflo(gb[q][k])) * (o[i0] * rstd * sg[i0]), hi = bfhi(mx[q][k]) + sigm(bfhi(gb[q][k])) * (o[i0 + 1] * rstd * sg[i0 + 1]);
                    out[q][k] = pk2(lo, hi); }
#pragma unroll
            for (int q = 0; q < 2; ++q) *(GAS v4u*)(a.MIX + off + 8 * q) = out[q];
        }
    }
}

__device__ __forceinline__ unsigned wave_max_u32(unsigned v) {
    unsigned t;
    t = (unsigned)__builtin_amdgcn_update_dpp(0, (int)v, 0xB1, 0xF, 0xF, false); v = v > t ? v : t;
    t = (unsigned)__builtin_amdgcn_update_dpp(0, (int)v, 0x4E, 0xF, 0xF, false); v = v > t ? v : t;
    t = (unsigned)__builtin_amdgcn_update_dpp(0, (int)v, 0x141, 0xF, 0xF, false); v = v > t ? v : t;
    t = (unsigned)__builtin_amdgcn_update_dpp(0, (int)v, 0x140, 0xF, 0xF, false); v = v > t ? v : t;
    t = (unsigned)__builtin_amdgcn_update_dpp(0, (int)v, 0x142, 0xA, 0xF, false); v = v > t ? v : t;
    t = (unsigned)__builtin_amdgcn_update_dpp(0, (int)v, 0x143, 0xC, 0xF, false); v = v > t ? v : t;
    return (unsigned)__builtin_amdgcn_readlane((int)v, 63);
}
__device__ __forceinline__ void topk_phase(Frame& F, const float* logits, const float* rbias, v4u* rec, int* posm, gu32* cnt) {
    LAS unsigned* hist = (LAS unsigned*)F.lds;
    LAS unsigned* baseL = hist + 256;
    LAS int* ek = (LAS int*)(hist + 512);
    LAS int* rk = ek + 1024;
    LAS float* gk = (LAS float*)(rk + 1024);
    const int lane = F.lane;
    const f32x4 bias = *(const GAS f32x4*)(rbias + 4 * lane);
    for (int tb = F.vcu; tb < T / 128; tb += F.G) {
        for (int i = F.tid; i < 256; i += 512) hist[i] = 0u;
        __syncthreads();
        f32x4 lgn = *(const GAS f32x4*)(logits + (size_t)(tb * 128 + F.wave * 16) * 256 + 4 * lane);
        for (int tl = F.wave * 16; tl < F.wave * 16 + 16; ++tl) {
            const int tok = tb * 128 + tl;
            const f32x4 lg = lgn;
            if (tl + 1 < F.wave * 16 + 16) lgn = *(const GAS f32x4*)(logits + (size_t)(tok + 1) * 256 + 4 * lane);
            const float s0 = sigm(lg.x), s1 = sigm(lg.y), s2 = sigm(lg.z), s3 = sigm(lg.w);
            unsigned k0, k1, k2, k3;
            { const unsigned e0 = 255u - 4u * (unsigned)lane;
#define TK_KEY(S, B, E) ({ const unsigned u_ = __float_as_uint((S) + (B)); (((u_ & 0x80000000u) ? ~u_ : (u_ | 0x80000000u)) & 0xFFFFFF00u) | (E); })
              k0 = TK_KEY(s0, bias.x, e0); k1 = TK_KEY(s1, bias.y, e0 - 1u); k2 = TK_KEY(s2, bias.z, e0 - 2u); k3 = TK_KEY(s3, bias.w, e0 - 3u);
#undef TK_KEY
            }
            int my_e = 0; float my_s = 0.f, ssum = 0.f;
#pragma unroll
            for (int k = 0; k < 8; ++k) {
                const unsigned m01 = k0 > k1 ? k0 : k1, m23 = k2 > k3 ? k2 : k3, ml = m01 > m23 ? m01 : m23;
                const unsigned win = wave_max_u32(ml);
                const int e = 255 - (int)(win & 255u), own = e >> 2, j = e & 3;
                const float sj = j == 0 ? s0 : j == 1 ? s1 : j == 2 ? s2 : s3;
                const float sv = __builtin_bit_cast(float, __builtin_amdgcn_readlane(__builtin_bit_cast(int, sj), own));
                k0 = k0 == win ? 0u : k0; k1 = k1 == win ? 0u : k1; k2 = k2 == win ? 0u : k2; k3 = k3 == win ? 0u : k3;
                ssum += sv;
                if (lane == k) { my_e = e; my_s = sv; }
            }
            if (lane < 8) { const float gte = my_s / ssum * 2.5f; gk[tl * 8 + lane] = gte;
                const unsigned rank = __hip_atomic_fetch_add(&hist[my_e], 1u, __ATOMIC_RELAXED, __HIP_MEMORY_SCOPE_WORKGROUP); ek[tl * 8 + lane] = my_e; rk[tl * 8 + lane] = (int)rank; }
        }
        __syncthreads();
        if (F.tid < 256) { const unsigned h = hist[F.tid]; baseL[F.tid] = h ? __hip_atomic_fetch_add(cnt + F.tid, h, RLX_AGENT) : 0u; }
        __syncthreads();
        for (int i = F.tid; i < 1024; i += 512) { const int e = ek[i], ps = (int)baseL[e] + rk[i], tok = tb * 128 + (i >> 3);
            ((GAS v4u*)rec)[(size_t)e * REC_CAP + ps] = (v4u){0u, __float_as_uint(gk[i]), (unsigned)tok, 0u}; ((GAS int*)posm)[(size_t)tb * 1024 + i] = (e << 16) | ps; }
        if (F.tid < 128) { const int tok = tb * 128 + F.tid; ((GAS v4u*)rec)[(size_t)NEXP * REC_CAP + tok] = (v4u){0u, __float_as_uint(1.0f), (unsigned)tok, 0u}; }
        __syncthreads();
    }
}
__device__ __forceinline__ void expert_prefix(Frame& F, gu32* cnt) {
    LAS int* startL = (LAS int*)(F.lds + PFX_OFF); LAS int* tsL = startL + 258;
    if (__builtin_amdgcn_readfirstlane((int)F.MISC[12]) != 0) return;
    int tid = (int)threadIdx.x; asm volatile("" : "+v"(tid));
    LAS int* cntL = (LAS int*)F.lds; LAS int* segC = cntL + 320; LAS int* segT = segC + 16;
    __syncthreads();
    if (tid < 256) cntL[tid] = (int)__hip_atomic_load(cnt + tid, RLX_AGENT); else if (tid == 256) cntL[256] = T;
    __syncthreads();
    if (tid < 8) { int sc = 0, st = 0; for (int e = 32 * tid; e < 32 * tid + 32; ++e) { sc += cntL[e]; st += (cntL[e] + 255) >> 8; } segC[tid] = sc; segT[tid] = st; }
    __syncthreads();
    if (tid < 258) { const int e = tid, sg = e >> 5; int s = 0, ts = 0;
        for (int w = 0; w < sg && w < 8; ++w) { s += segC[w]; ts += segT[w]; }
        for (int q = (sg < 8 ? sg : 8) * 32; q < e; ++q) { s += cntL[q]; ts += (cntL[q] + 255) >> 8; }
        startL[e] = s; tsL[e] = ts; }
    __syncthreads();
    if (tid == 0) F.MISC[12] = 1u;
    __syncthreads();
}

template <bool GATHER> struct MoeOrder {
    const void* A; const void* Bt; int Kb; int rowsB;
    const LAS int* utab; const LAS int* toktab; int nun, reps;
    __device__ __forceinline__ bool next(int i, pg8::Unit& u) const {
        if (i >= nun * reps) return false; i %= nun;
        u.e = __builtin_amdgcn_readfirstlane(utab[4 * i]); u.row0 = __builtin_amdgcn_readfirstlane(utab[4 * i + 1]); u.nrows = __builtin_amdgcn_readfirstlane(utab[4 * i + 2]); u.pn = __builtin_amdgcn_readfirstlane(utab[4 * i + 3]); u.pm = i; return true; }
    __device__ __forceinline__ const char* a_base(const pg8::Unit& u) const { return GATHER ? (const char*)A : (const char*)A + (size_t)u.row0 * Kb; }
    __device__ __forceinline__ const char* b_base(const pg8::Unit& u) const { return (const char*)Bt + ((size_t)u.e * rowsB + (size_t)u.pn * 256) * Kb; }
    __device__ __forceinline__ void a_voff(const pg8::Unit&, int ui, const int (&R)[2], const int (&C)[2], unsigned (&v)[2][2]) const {
#pragma unroll
        for (int h = 0; h < 2; ++h)
#pragma unroll
            for (int i = 0; i < 2; ++i) v[h][i] = GATHER ? (unsigned)toktab[(ui % nun) * 256 + h * 128 + R[i]] * (unsigned)Kb + (unsigned)(C[i] * 2) : (unsigned)((h * 128 + R[i]) * Kb + C[i] * 2);
    }
    __device__ __forceinline__ void a_ready(const pg8::Unit&) const {}
    __device__ __forceinline__ void done(const pg8::Unit&) const {}
};
struct SharedGU {
    const void* A; const void* Bt; int Kb; int first, stride, n;
    __device__ __forceinline__ bool next(int i, pg8::Unit& u) const { if (i >= n) return false; const int idx = first + i * stride; u.e = NEXP; u.row0 = T * TOPK + 256 * (idx >> 1); u.nrows = 256; u.pn = idx & 1; u.pm = 0; return true; }
    __device__ __forceinline__ const char* a_base(const pg8::Unit& u) const { return (const char*)A + (size_t)(u.row0 - T * TOPK) * Kb; }
    __device__ __forceinline__ const char* b_base(const pg8::Unit& u) const { return (const char*)Bt + ((size_t)NEXP * 512 + (size_t)u.pn * 256) * Kb; }
    __device__ __forceinline__ void a_voff(const pg8::Unit&, int, const int (&R)[2], const int (&C)[2], unsigned (&v)[2][2]) const {
#pragma unroll
        for (int h = 0; h < 2; ++h)
#pragma unroll
            for (int i = 0; i < 2; ++i) v[h][i] = (unsigned)((h * 128 + R[i]) * Kb + C[i] * 2);
    }
    __device__ __forceinline__ void a_ready(const pg8::Unit&) const {}
    __device__ __forceinline__ void done(const pg8::Unit&) const {}
};
template <bool GATHER> __device__ __forceinline__ int moe_tables(Frame& F, gu32* cnt, const v4u* rec, int shift, int skip_tail = 0) {
    LAS int* utab = (LAS int*)(F.lds + UT_OFF); LAS int* toktab = (LAS int*)(F.lds + TOK_OFF); LAS int* bkt = (LAS int*)(F.lds + PFX_OFF + 2064);
    expert_prefix(F, cnt);
    const LAS int* startL = (const LAS int*)(F.lds + PFX_OFF); const LAS int* tsL = startL + 258;
    const int total = (__builtin_amdgcn_readfirstlane(tsL[257]) - skip_tail) << shift;
    int nun = total > F.vcu ? (total - F.vcu + F.G - 1) / F.G : 0;
    const int cap = GATHER ? MAXU_TOK : MAXU_GT; if (nun > cap) nun = cap;
    __syncthreads();
    if (F.tid < nun) { const int Lu = F.tid * F.G + F.vcu, t = Lu >> shift;
        int lo = 0, hi = 257;
        while (lo < hi) { const int mid = (lo + hi + 1) >> 1; if (tsL[mid] <= t) lo = mid; else hi = mid - 1; }
        const int e = lo, j = t - tsL[e], n = startL[e + 1] - startL[e] - 256 * j;
        utab[4 * F.tid] = e; utab[4 * F.tid + 1] = startL[e] + 256 * j; utab[4 * F.tid + 2] = n < 256 ? n : 256; utab[4 * F.tid + 3] = Lu & ((1 << shift) - 1); bkt[F.tid] = e * REC_CAP + 256 * j; }
    __syncthreads();
    if (GATHER) { for (int idx = F.tid; idx < nun * 256; idx += 512) { const int i = idx >> 8, r = idx & 255, nr = utab[4 * i + 2]; toktab[idx] = (int)((const GAS v4u*)rec)[(size_t)bkt[i] + (r < nr ? r : nr - 1)].z; }
        __syncthreads(); }
    else { LAS unsigned short* gtab = (LAS unsigned short*)(F.lds + TOK_OFF);
        for (int idx = F.tid; idx < nun * 256; idx += 512) { const int i = idx >> 8, r = idx & 255, nr = utab[4 * i + 2];
            const unsigned gb = ((const GAS v4u*)rec)[(size_t)bkt[i] + (r < nr ? r : nr - 1)].y; gtab[idx] = __builtin_bit_cast(unsigned short, (_Float16)__uint_as_float(gb)); }
        __syncthreads(); }
    return nun;
}

__device__ __forceinline__ void combine_phase(Frame& F, const unsigned char* ys, const int* posm, gu32* cnt, const float* mod, float* out) {
    expert_prefix(F, cnt); const LAS int* startL = (const LAS int*)(F.lds + PFX_OFF);
    typedef float f32x2c __attribute__((ext_vector_type(2))); typedef unsigned u32x2c __attribute__((ext_vector_type(2)));
    const int gw = F.vcu * NWAVES + F.wave, NGW = F.G * NWAVES, lane = F.lane;
    for (int blk = gw; blk < T / 16; blk += NGW) {
        const int b = (blk * 16) >> 12; const float* gp = mod + (size_t)b * 6144 + 5120;
        const int pv0 = ((const GAS int*)posm)[(size_t)blk * 128 + lane], pv1 = ((const GAS int*)posm)[(size_t)blk * 128 + 64 + lane];
        f32x4 g2[2][2];
#pragma unroll
        for (int j = 0; j < 2; ++j)
#pragma unroll
            for (int q = 0; q < 2; ++q) g2[j][q] = *(const GAS f32x4*)(gp + 512 * j + 8 * lane + 4 * q) * (1.0f / SC_Y);
        for (int r = 0; r < 16; ++r) { const int tok = blk * 16 + r; const int pvr = r < 8 ? pv0 : pv1;
            float acc[2][8];
#pragma unroll
            for (int j = 0; j < 2; ++j)
#pragma unroll
                for (int i = 0; i < 8; ++i) acc[j][i] = 0.f;
#pragma unroll
            for (int s = 0; s < NSLOT; ++s) { int p = T * TOPK + tok; if (s < TOPK) { const int pk = __builtin_amdgcn_readlane(pvr, (r & 7) * 8 + s); p = startL[pk >> 16] + (pk & 0xFFFF); }
#pragma unroll
                for (int j = 0; j < 2; ++j) { const u32x2c v = *(const GAS u32x2c*)(ys + (size_t)p * D + 512 * j + 8 * lane);
#pragma unroll
                    for (int k = 0; k < 2; ++k) { const f32x2c lo = __builtin_amdgcn_cvt_pk_f32_fp8(v[k], false), hi = __builtin_amdgcn_cvt_pk_f32_fp8(v[k], true);
                        acc[j][4 * k] += lo[0]; acc[j][4 * k + 1] += lo[1]; acc[j][4 * k + 2] += hi[0]; acc[j][4 * k + 3] += hi[1]; } } }
            float* orow = out + (size_t)tok * D;
#pragma unroll
            for (int j = 0; j < 2; ++j)
#pragma unroll
                for (int q = 0; q < 2; ++q) { GAS f32x4* p = (GAS f32x4*)(orow + 512 * j + 8 * lane + 4 * q); const f32x4 x1 = *p;
                    const f32x4 av = {acc[j][4 * q], acc[j][4 * q + 1], acc[j][4 * q + 2], acc[j][4 * q + 3]}; *p = x1 + g2[j][q] * av; }
        }
    }
}
#ifndef MK_N_LAUNCHES
#define MK_N_LAUNCHES 1
#endif
constexpr int NPH = 14;
constexpr int N_LAUNCHES = MK_N_LAUNCHES;
struct Args { const void* in[31]; float* out; unsigned char* ws; int ph_lo, ph_hi; };
#ifndef PHMASK
#define PHMASK 0xFFFF
#endif
#ifndef REPMASK
#define REPMASK 0
#endif
#define REPN(k) (1 + ((REPMASK >> (k)) & 1))
constexpr int PTR_OFF = LDSCTL_OFF + 1536;
__device__ __forceinline__ void* ldptr(LAS unsigned char* lds, int i) {
    const volatile LAS unsigned* p = (const volatile LAS unsigned*)(lds + PTR_OFF) + 2 * i;
    const unsigned lo = __builtin_amdgcn_readfirstlane(p[0]), hi = __builtin_amdgcn_readfirstlane(p[1]);
    return (void*)(GAS void*)(((unsigned long long)hi << 32) | lo);
}
__global__ void __launch_bounds__(NWAVES * 64, 2) fwd_kernel(Args args) {
    extern __shared__ __attribute__((aligned(16))) unsigned char lds[];
    Frame F;
    F.lds = (LAS unsigned char*)lds;
    F.MISC = (volatile LAS unsigned*)(F.lds + MISC_OFF);
    F.tid = threadIdx.x; F.lane = F.tid & 63; F.wave = __builtin_amdgcn_readfirstlane(F.tid >> 6);
    F.G = gridDim.x; { const int bx = blockIdx.x; F.vcu = (F.G % 8 == 0) ? (bx % 8) * (F.G / 8) + bx / 8 : bx; }
    F.ctl = (gu32*)(args.ws + WS_CTL);
    for (int u = F.tid; u < (LDS_BYTES - LDSCTL_OFF) / 4; u += NWAVES * 64) ((LAS unsigned*)(F.lds + LDSCTL_OFF))[u] = 0u;
    __syncthreads();
    if (F.tid < 33) { const void* pv = F.tid < 31 ? args.in[F.tid] : (F.tid == 31 ? (const void*)args.out : (const void*)args.ws);
        ((LAS unsigned long long*)(F.lds + PTR_OFF))[F.tid] = (unsigned long long)pv; }
    __syncthreads();
    XcdBarrier bar; bar.bar = (unsigned*)(F.ctl + CW_BAR); bar.x = 0; bar.st = nullptr;
    if (N_LAUNCHES == 1) bar = xcd_barrier_post((unsigned*)(F.ctl + CW_BAR), F.MISC + 8);
#define GRID_BAR() do { if (N_LAUNCHES == 1) { xcd_barrier(bar); } } while (0)
    const int lo = args.ph_lo, hi = args.ph_hi;
#if defined(PROBE_REGION)
    volatile LAS unsigned long long* const prbp = (blockIdx.x == PROBE_BLOCK && F.wave == PROBE_WAVE) ? (volatile LAS unsigned long long*)(F.lds + MISC_OFF + 96) : nullptr;
#define PRBARG(ph) , (PROBE_PHASE == (ph) ? prbp : nullptr)
#else
#define PRBARG(ph)
#endif
#define IN(k) (((PHMASK >> (k)) & 1) && lo <= (k) && (k) < hi)
#if defined(PROBE_CUM)
    const unsigned long long prb_tstart = __builtin_amdgcn_s_memrealtime(); unsigned long long prb_cum = 0;
#define PRB_CUM(k) do { if (PROBE_CUM == (k)) prb_cum = __builtin_amdgcn_s_memrealtime() - prb_tstart; } while (0)
#else
#define PRB_CUM(k) do {} while (0)
#endif
#define BOTH(k) (IN(k) && IN((k) + 1))
#define INP(i) ((const float*)ldptr(F.lds, (i)))
#define OUTP ((float*)ldptr(F.lds, 31))
#define WSP ((unsigned char*)ldptr(F.lds, 32))

    if (IN(0)) { asm volatile("" : "+v"(F.tid), "+v"(F.lane));
        P0Args a{INP(1), INP(3), INP(4), INP(6), INP(21), INP(23), INP(25), INP(26), INP(27), INP(28), INP(29), INP(30), INP(9), INP(11), INP(13), (const int*)INP(2)};
        unsigned char* ws = WSP;
        for (int rep = 0; rep < REPN(0); ++rep) p0_prologue(F, a, ws, 0);
        if (BOTH(0)) GRID_BAR();
    }
    PRB_CUM(1);
    if (IN(1)) { asm volatile("" : "+v"(F.tid), "+v"(F.lane)); unsigned char* ws = WSP;
        { P0Args a{INP(1), INP(3), INP(4), INP(6), INP(21), INP(23), INP(25), INP(26), INP(27), INP(28), INP(29), INP(30), INP(9), INP(11), INP(13), (const int*)INP(2)}; p0_prologue(F, a, ws, 1); __syncthreads(); }
        for (int rep = 0; rep < REPN(1); ++rep) norm_mod_phase(F, INP(0), INP(5), (const float*)(ws + WS_MOD), 0, 1024, nullptr, (unsigned char*)OUTP); if (BOTH(1)) GRID_BAR(); }
    PRB_CUM(2);
    if (IN(2)) { asm volatile("" : "+v"(F.tid), "+v"(F.lane));
        unsigned char* ws = WSP;
        pg8::DenseOrder S; S.init(OUTP, ws + WS_WIN, T, INW, D, F.G, (int)blockIdx.x, REPN(2));
        epi::EpiInProj E{(bf16*)(ws + WS_XR), (bf16*)(ws + WS_GAR), (bf16*)(ws + WS_Q), (bf16*)(ws + WS_K), (bf16*)(ws + WS_V), (bf16*)(ws + WS_GB), INP(14), INP(15), (const float*)(ws + WS_CST), 0.125f * 1.4426950408889634f, 1.0f / (SC_H * SC_W)};
        pg8::gemm_phase<epi::EpiInProj, pg8::DenseOrder, true, true>(F.lds + RING_OFF, D, S, E PRBARG(2));
        if (BOTH(2)) GRID_BAR();
    }
    PRB_CUM(3);
    if (IN(4)) { asm volatile("" : "+v"(F.tid), "+v"(F.lane));
        unsigned char* ws = WSP; attn_body::bf16* O0 = (attn_body::bf16*)OUTP;
        const float lam = __expf(wave_sum(INP(16)[F.lane] * INP(17)[F.lane])) - __expf(wave_sum(INP(18)[F.lane] * INP(19)[F.lane])) + 0.2f;
        const attn_body::AttnTensors AT{(const attn_body::bf16*)(ws + WS_Q), (const attn_body::bf16*)(ws + WS_K), (const attn_body::bf16*)(ws + WS_V), O0, O0 + (size_t)T * D, (const attn_body::bf16*)(ws + WS_GB), INP(20), lam};
        const attn_body::PairOrder S((int)F.G, F.vcu);
        const ExpertConvHook H{F.lds}; attn_body::attn_phase<attn_body::PairOrder, ExpertConvHook>((char*)lds + RING_OFF, AT, S, H, REPN(4));
        GRID_BAR();
    }
    PRB_CUM(4);
    if (IN(3)) { asm volatile("" : "+v"(F.tid), "+v"(F.lane));
        unsigned char* ws = WSP;
        LruArgs a{(const bf16*)(ws + WS_XR), (const bf16*)(ws + WS_GAR), (const bf16*)OUTP + (size_t)T * D, (bf16*)(ws + WS_MIX), (const bf16*)(ws + WS_WLRU), INP(7), INP(8), INP(10), INP(12), (const float*)(ws + WS_C8SP)};
        for (int rep = 0; rep < REPN(3); ++rep) lru_phase(F, a);
        GRID_BAR();
    }
    PRB_CUM(5);
    if (IN(6)) { asm volatile("" : "+v"(F.tid), "+v"(F.lane));
        unsigned char* ws = WSP;
        pg8::DenseOrder S; S.init(ws + WS_MIX, ws + WS_WO, T, D, 2 * D, F.G, (int)blockIdx.x, REPN(6));
        epi::EpiWo E{INP(0), OUTP, (const float*)(ws + WS_MOD) + 2048};
        pg8::gemm_phase<epi::EpiWo, pg8::DenseOrder, true>(F.lds + RING_OFF, 2 * D, S, E);
        if (BOTH(6)) GRID_BAR();
    }
    PRB_CUM(6);
    if (IN(7)) { asm volatile("" : "+v"(F.tid), "+v"(F.lane)); unsigned char* ws = WSP; for (int rep = 0; rep < REPN(7); ++rep) norm_mod_phase(F, OUTP, INP(22), (const float*)(ws + WS_MOD), 3072, 4096, (bf16*)(ws + WS_H2), ws + WS_H28); if (BOTH(7)) GRID_BAR(); }
    PRB_CUM(7);
    if (IN(8)) { asm volatile("" : "+v"(F.tid), "+v"(F.lane));
        unsigned char* ws = WSP;
        pg8::DenseOrder S; S.init((const pg8::bf16_t*)(ws + WS_H2), (const pg8::bf16_t*)(ws + WS_WR), T, NEXP, 2 * D, F.G, (int)blockIdx.x, REPN(8));
        epi::EpiF32 E{(float*)(ws + WS_LOGIT)};
        const bool sh_here = (int)F.G > 128;
        if (!sh_here || (int)blockIdx.x < 128) pg8::gemm_phase<epi::EpiF32, pg8::DenseOrder, false>(F.lds + RING_OFF, 2 * D, S, E);
        if (sh_here && (int)blockIdx.x >= 128) { const int nw = (int)F.G - 128, me = (int)blockIdx.x - 128;
            SharedGU S2{ws + WS_H28, ws + WS_WEGU, D, me, nw, (256 - me + nw - 1) / nw};
            epi::EpiGateUp E2{ws + WS_ACT, ws + WS_DUMP, 1.0f / (SC_H * SC_W), SC_A};
            pg8::gemm_phase<epi::EpiGateUp, SharedGU, true, true>(F.lds + RING_OFF, D, S2, E2); }
        if (BOTH(8)) GRID_BAR();
    }
    PRB_CUM(8);
    if (IN(9)) { asm volatile("" : "+v"(F.tid), "+v"(F.lane)); unsigned char* ws = WSP; topk_phase(F, (const float*)(ws + WS_LOGIT), INP(24), (v4u*)(ws + WS_REC), (int*)(ws + WS_POSM), F.ctl + CW_CNT); if (BOTH(9)) GRID_BAR(); }
    PRB_CUM(9);
    PRB_CUM(10);
    if (IN(11)) { asm volatile("" : "+v"(F.tid), "+v"(F.lane));
        unsigned char* ws = WSP;
        const int nun = moe_tables<true>(F, F.ctl + CW_CNT, (const v4u*)(ws + WS_REC), 1, (int)F.G > 128 ? T / 256 : 0);
        MoeOrder<true> S{ws + WS_H28, ws + WS_WEGU, D, 512, (const LAS int*)(F.lds + UT_OFF), (const LAS int*)(F.lds + TOK_OFF), nun, REPN(11)};
        epi::EpiGateUp E{ws + WS_ACT, ws + WS_DUMP, 1.0f / (SC_H * SC_W), SC_A};
        pg8::gemm_phase<epi::EpiGateUp, MoeOrder<true>, true, true>(F.lds + RING_OFF, D, S, E PRBARG(11));
        if (BOTH(11)) GRID_BAR();
    }
    PRB_CUM(11);
    if (IN(12)) { asm volatile("" : "+v"(F.tid), "+v"(F.lane));
        unsigned char* ws = WSP;
        const int nun = moe_tables<false>(F, F.ctl + CW_CNT, (const v4u*)(ws + WS_REC), 2);
        MoeOrder<false> S{ws + WS_ACT, ws + WS_WED, DEXP, 1024, (const LAS int*)(F.lds + UT_OFF), (const LAS int*)(F.lds + TOK_OFF), nun, REPN(12)};
        epi::EpiDown E{ws + WS_YS, (const LAS unsigned short*)(F.lds + TOK_OFF), ws + WS_DUMP, SC_Y / (SC_A * SC_W)};
        if (F.vcu & 1) __builtin_amdgcn_s_sleep(127);
        pg8::gemm_phase<epi::EpiDown, MoeOrder<false>, true, true>(F.lds + RING_OFF, DEXP, S, E PRBARG(12));
        if (BOTH(12)) GRID_BAR();
    }
    PRB_CUM(12);
    if (IN(13)) { asm volatile("" : "+v"(F.tid), "+v"(F.lane)); unsigned char* ws = WSP; combine_phase(F, ws + WS_YS, (const int*)(ws + WS_POSM), F.ctl + CW_CNT, (const float*)(ws + WS_MOD), OUTP); }
    PRB_CUM(13);
#if defined(PROBE_CUM)
    if (blockIdx.x == 0 && F.tid == 0) { const unsigned long long t0 = __builtin_amdgcn_s_memrealtime(), dl = prb_cum * PROBE_MULT; while (__builtin_amdgcn_s_memrealtime() - t0 < dl) __builtin_amdgcn_s_sleep(32); }
#endif
#if defined(PROBE_REGION)
    if (prbp) { const unsigned long long t0 = __builtin_amdgcn_s_memrealtime(), dl = *prbp * PROBE_MULT; while (__builtin_amdgcn_s_memrealtime() - t0 < dl) __builtin_amdgcn_s_sleep(32); }
#endif
#undef IN
#undef BOTH
}

extern "C" void kernel_launch(void* const* d_in, const int* in_sizes, int n_in, void* d_out, int out_size, void* d_ws, size_t ws_size, hipStream_t stream) {
    static int grid = 0;
    if (grid == 0) {
        if (n_in != 31 || in_sizes[0] != T * D || out_size != T * D || ws_size < WS_END) { fprintf(stderr, "kernel_launch: unexpected shapes: n_in %d in0 %d out %d ws %zu (need %zu); nothing launched\n", n_in, n_in > 0 ? in_sizes[0] : -1, out_size, ws_size, (size_t)WS_END); grid = -1; return; }
        int dev = 0, cus = 0, per_cu = 0;
        if (hipGetDevice(&dev) != hipSuccess || hipDeviceGetAttribute(&cus, hipDeviceAttributeMultiprocessorCount, dev) != hipSuccess) { fprintf(stderr, "kernel_launch: device query failed\n"); grid = -1; return; }
        if (hipFuncSetAttribute((const void*)fwd_kernel, hipFuncAttributeMaxDynamicSharedMemorySize, LDS_BYTES) != hipSuccess) { fprintf(stderr, "kernel_launch: hipFuncSetAttribute failed\n"); grid = -1; return; }
        if (hipOccupancyMaxActiveBlocksPerMultiprocessor(&per_cu, (const void*)fwd_kernel, NWAVES * 64, LDS_BYTES) != hipSuccess || per_cu < 1)
            fprintf(stderr, "kernel_launch: note: occupancy query reports %d workgroups per CU\n", per_cu);
        (void)hipGetLastError();
        grid = cus;
    }
    if (grid < 0) return;
    if (hipMemsetAsync((char*)d_ws + WS_CTL, 0, CTL_ZERO_BYTES, stream) != hipSuccess) { fprintf(stderr, "kernel_launch: hipMemsetAsync failed\n"); return; }
    Args a{};
    for (int i = 0; i < 31; ++i) a.in[i] = d_in[i];
    a.out = (float*)d_out; a.ws = (unsigned char*)d_ws;
    for (int li = 0; li < N_LAUNCHES; ++li) {
        a.ph_lo = (N_LAUNCHES == 1) ? 0 : li; a.ph_hi = (N_LAUNCHES == 1) ? NPH : li + 1;
        hipLaunchKernelGGL(fwd_kernel, dim3(grid), dim3(NWAVES * 64), LDS_BYTES, stream, a);
        const hipError_t le = hipPeekAtLastError();
        if (le != hipSuccess) { fprintf(stderr, "kernel_launch: launch %d failed: %s\n", li, hipGetErrorName(le)); break; }
    }
}
```
